# Optimizing an MI355X kernel written in HIP

```python
import jax
import jax.numpy as jnp
from jax import lax
import numpy as np

D_MODEL = 2048
BATCH = 4
SEQ = 4096
DEPTH = 4

GRID_W = 64
CTX_LEN = 256
EPS = 1e-6
N_BRANCH = 4
BR_W = 512
NA_HEADS = 4
NA_HEAD_DIM = BR_W // NA_HEADS
NA_ROWS = 8
NA_COLS = 16
POOL_WINDOWS = (2, 4, 8, 16)
POOL_GROUP = BR_W // len(POOL_WINDOWS)
MLA_HEADS = 4
MLA_NOPE = 128
MLA_ROPE = 64
MLA_V = BR_W // MLA_HEADS
MLA_Q_LORA = 512
MLA_KV_LORA = 512
ROPE_THETA = 10000.0
ATTN_BLOCK = 128
ML_HEADS = 4
ML_HEAD_DIM = BR_W // ML_HEADS
ML_CHUNK = 64
CONV_K = 4

IN_SPLITS = (
    ('a_qkv', 3 * BR_W), ('a_gate', BR_W),
    ('b_in', BR_W), ('b_gate', BR_W),
    ('c_q', MLA_Q_LORA), ('c_kv', MLA_KV_LORA), ('c_kr', MLA_ROPE), ('c_gate', BR_W),
    ('d_qkv', 3 * BR_W), ('d_o', BR_W), ('d_if', 4 * ML_HEADS), ('d_gate', BR_W),
    ('merge', N_BRANCH * D_MODEL),
)
IN_NAMES = tuple(name for name, _ in IN_SPLITS)
IN_OFFSETS = tuple(int(o) for o in np.cumsum([w for _, w in IN_SPLITS])[:-1])
D_IN = sum(w for _, w in IN_SPLITS)

kernel_name = 'hybrid_gated_branch_diffusion_trunk'

F32 = jnp.float32


def rmsnorm(x, g):
    xf = x.astype(F32)
    y = xf * lax.rsqrt(jnp.mean(xf * xf, axis=-1, keepdims=True) + EPS)
    return (y * g.astype(F32)).astype(x.dtype)


def split_heads(t, h):
    b, n, _ = t.shape
    return t.reshape(b, n, h, -1).transpose(0, 2, 1, 3)


def merge_heads(t):
    b, h, n, d = t.shape
    return t.transpose(0, 2, 1, 3).reshape(b, n, h * d)


def modulate_project(h, cond, norm_g, w_mod, b_mod, w_in):
    mod = jax.nn.silu(cond) @ w_mod + b_mod
    shift, scale, gate = jnp.split(mod, 3, axis=-1)
    hn = rmsnorm(h, norm_g) * (1 + scale) + shift
    parts = jnp.split(hn @ w_in, list(IN_OFFSETS), axis=-1)
    return dict(zip(IN_NAMES, parts)), gate


def dense_attention(q, k, v, scale):
    s = jnp.einsum('bhqd,bhkd->bhqk', q, k).astype(F32) * scale
    p = jax.nn.softmax(s, axis=-1).astype(v.dtype)
    return jnp.einsum('bhqk,bhkd->bhqd', p, v)


def blocked_joint_attention(q_a, q_b, k_a, v_a, k_b, v_b, scale):
    b, h, t, _ = q_a.shape
    nb = t // ATTN_BLOCK

    def to_blocks(a):
        return a.reshape(b, h, nb, ATTN_BLOCK, a.shape[-1]).transpose(2, 0, 1, 3, 4)

    def one_block(args):
        qa, qb = args
        s = jnp.concatenate([jnp.einsum('bhqd,bhkd->bhqk', qa, k_a),
                             jnp.einsum('bhqd,bhkd->bhqk', qb, k_b)], axis=-1).astype(F32) * scale
        p = jax.nn.softmax(s, axis=-1).astype(v_a.dtype)
        return (jnp.einsum('bhqk,bhkd->bhqd', p[..., :t], v_a)
                + jnp.einsum('bhqk,bhkd->bhqd', p[..., t:], v_b))

    out = lax.map(one_block, (to_blocks(q_a), to_blocks(q_b)))
    return out.transpose(1, 2, 0, 3, 4).reshape(b, h, t, -1)


def neighbourhood_attention(q, k, v, kc, vc, rpb):
    b, h, t, dh = q.shape
    rows = t // GRID_W
    kr = min(NA_ROWS, rows)
    scale = dh ** -0.5
    qg = q.reshape(b, h, rows, GRID_W, dh)
    r = jnp.arange(rows)
    ridx = jnp.clip(r - kr // 2, 0, rows - kr)[:, None] + jnp.arange(kr)[None, :]
    kb = jnp.take(k.reshape(b, h, rows, GRID_W, dh), ridx, axis=2)
    vb = jnp.take(v.reshape(b, h, rows, GRID_W, dh), ridx, axis=2)
    cq = jnp.arange(GRID_W)
    cstart = jnp.clip(cq - NA_COLS // 2, 0, GRID_W - NA_COLS)
    valid = (cq[None, :] >= cstart[:, None]) & (cq[None, :] < cstart[:, None] + NA_COLS)
    roff = ridx - r[:, None] + NA_ROWS - 1
    coff = jnp.clip(cq[None, :] - cq[:, None] + NA_COLS - 1, 0, 2 * NA_COLS - 2)
    bias = rpb[:, roff[:, None, :, None], coff[None, :, None, :]].astype(F32)
    s_loc = jnp.einsum('bhrqd,bhrkcd->bhrqkc', qg, kb).astype(F32) * scale + bias[None]
    s_loc = jnp.where(valid[:, None, :], s_loc, -jnp.inf)
    s_ctx = jnp.einsum('bhrqd,bhnd->bhrqn', qg, kc).astype(F32) * scale
    n_loc = kr * GRID_W
    p = jax.nn.softmax(jnp.concatenate([s_loc.reshape(b, h, rows, GRID_W, n_loc), s_ctx], axis=-1),
                       axis=-1).astype(v.dtype)
    out = (jnp.einsum('bhrqkc,bhrkcd->bhrqd', p[..., :n_loc].reshape(b, h, rows, GRID_W, kr, GRID_W), vb)
           + jnp.einsum('bhrqn,bhnd->bhrqd', p[..., n_loc:], vc))
    return out.reshape(b, h, t, dh)


def mixer_neighbourhood(pl, pc, rpb, need_ctx):
    qc, kc, vc = (split_heads(a, NA_HEADS) for a in jnp.split(pc['a_qkv'], 3, axis=-1))
    q, k, v = (split_heads(a, NA_HEADS) for a in jnp.split(pl['a_qkv'], 3, axis=-1))
    y = merge_heads(neighbourhood_attention(q, k, v, kc, vc, rpb)) * jax.nn.silu(pl['a_gate'])
    y_c = None
    if need_ctx:
        y_c = merge_heads(dense_attention(qc, kc, vc, NA_HEAD_DIM ** -0.5)) * jax.nn.silu(pc['a_gate'])
    return y, y_c


def multiscale_pool_diff(u):
    b, n, ch = u.shape
    uf = u.astype(F32)
    csum = jnp.concatenate([jnp.zeros((b, 1, ch), F32), jnp.cumsum(uf, axis=1)], axis=1)
    t = jnp.arange(n)
    outs = []
    for gi, w in enumerate(POOL_WINDOWS):
        sl = slice(gi * POOL_GROUP, (gi + 1) * POOL_GROUP)
        lo = jnp.maximum(t - w // 2, 0)
        hi = jnp.minimum(t + (w - 1 - w // 2), n - 1)
        cnt = (hi - lo + 1).astype(F32)[:, None]
        mean = (csum[:, hi + 1, sl] - csum[:, lo, sl]) / cnt
        outs.append(mean - uf[:, :, sl])
    return jnp.concatenate(outs, axis=-1)


def pool_branch(p, pool_w, pool_scale):
    u = p['b_in']
    b, n, _ = u.shape
    d = multiscale_pool_diff(u).reshape(b, n, len(POOL_WINDOWS), POOL_GROUP)
    y = jnp.einsum('bngi,gio->bngo', d, pool_w.astype(F32)).reshape(b, n, BR_W)
    y = (y * pool_scale.astype(F32)).astype(u.dtype)
    return y * jax.nn.silu(p['b_gate'])


def mixer_pool(pl, pc, pool_w, pool_scale, need_ctx):
    y = pool_branch(pl, pool_w, pool_scale)
    y_c = pool_branch(pc, pool_w, pool_scale) if need_ctx else None
    return y, y_c


def rope_axis(x, pos):
    n = x.shape[-1] // 2
    inv = ROPE_THETA ** (-jnp.arange(n, dtype=F32) / n)
    ang = pos.astype(F32)[:, None] * inv
    cos, sin = jnp.cos(ang), jnp.sin(ang)
    x1, x2 = x[..., :n].astype(F32), x[..., n:].astype(F32)
    return jnp.concatenate([x1 * cos - x2 * sin, x1 * sin + x2 * cos], axis=-1)


def axial_rope(x, rows, cols):
    half = x.shape[-1] // 2
    out = jnp.concatenate([rope_axis(x[..., :half], rows), rope_axis(x[..., half:], cols)], axis=-1)
    return out.astype(x.dtype)


def mla_project(p, gq, gkv, w_uq, w_ukv):
    b, n, _ = p['c_q'].shape
    q = (rmsnorm(p['c_q'], gq) @ w_uq).reshape(b, n, MLA_HEADS, MLA_NOPE + MLA_ROPE).transpose(0, 2, 1, 3)
    kv = (rmsnorm(p['c_kv'], gkv) @ w_ukv).reshape(b, n, MLA_HEADS, MLA_NOPE + MLA_V).transpose(0, 2, 1, 3)
    k_rope = p['c_kr'][:, None]
    return q[..., :MLA_NOPE], q[..., MLA_NOPE:], kv[..., :MLA_NOPE], kv[..., MLA_NOPE:], k_rope


def mixer_mla(pl, pc, gq, gkv, w_uq, w_ukv, need_ctx):
    scale = (MLA_NOPE + MLA_ROPE) ** -0.5
    qn_c, qr_c, kn_c, v_c, kr_c = mla_project(pc, gq, gkv, w_uq, w_ukv)
    k_ctx = jnp.concatenate([kn_c, jnp.broadcast_to(kr_c, kn_c.shape[:-1] + (MLA_ROPE,))], axis=-1)
    qn, qr, kn, v, kr = mla_project(pl, gq, gkv, w_uq, w_ukv)
    t = qn.shape[2]
    pos = jnp.arange(t)
    rows, cols = pos // GRID_W, pos % GRID_W
    q_lat = jnp.concatenate([qn, axial_rope(qr, rows, cols)], axis=-1)
    q_for_ctx = jnp.concatenate([qn, qr], axis=-1)
    k_lat = jnp.concatenate([kn, jnp.broadcast_to(axial_rope(kr, rows, cols), kn.shape[:-1] + (MLA_ROPE,))], axis=-1)
    y = merge_heads(blocked_joint_attention(q_lat, q_for_ctx, k_lat, v, k_ctx, v_c, scale)) * jax.nn.silu(pl['c_gate'])
    y_c = None
    if need_ctx:
        q_c = jnp.concatenate([qn_c, qr_c], axis=-1)
        y_c = merge_heads(dense_attention(q_c, k_ctx, v_c, scale)) * jax.nn.silu(pc['c_gate'])
    return y, y_c


def short_conv(x, w):
    n = x.shape[1]
    xp = jnp.pad(x, ((0, 0), (CONV_K // 2, CONV_K - 1 - CONV_K // 2), (0, 0)))
    acc = xp[:, 0:n] * w[0]
    for j in range(1, CONV_K):
        acc = acc + xp[:, j:j + n] * w[j]
    return acc


def mlstm_inputs(p, conv_w, b_if):
    b, n, _ = p['d_qkv'].shape
    q_raw, k_raw, v = jnp.split(p['d_qkv'], 3, axis=-1)
    q, k = jnp.split(jax.nn.silu(short_conv(jnp.concatenate([q_raw, k_raw], axis=-1), conv_w)), 2, axis=-1)
    q = split_heads(q, ML_HEADS).astype(F32)
    k = split_heads(k, ML_HEADS).astype(F32) * (ML_HEAD_DIM ** -0.5)
    v = split_heads(v, ML_HEADS).astype(F32)
    g = (p['d_if'].astype(F32) + b_if.astype(F32)).reshape(b, n, 2, 2, ML_HEADS).transpose(2, 3, 0, 4, 1)
    li = g[:, 0]
    lf = jax.nn.log_sigmoid(g[:, 1])
    return q, k, v, li, lf


def mlstm_scan(q, k, v, li, lf, state):
    b, h, n, _ = q.shape
    nc = n // ML_CHUNK
    tril = jnp.tril(jnp.ones((ML_CHUNK, ML_CHUNK), dtype=bool))

    def chunks(a):
        return jnp.moveaxis(a.reshape(a.shape[:2] + (nc, ML_CHUNK) + a.shape[3:]), 2, 0)

    def step(carry, xs):
        C, nv, m = carry
        qc, kc, vc, lic, lfc = xs
        bc = jnp.cumsum(lfc, axis=-1)
        dmat = jnp.where(tril, bc[..., :, None] - bc[..., None, :] + lic[..., None, :], -jnp.inf)
        inter = bc + m[..., None]
        m_t = jnp.maximum(inter, jnp.max(dmat, axis=-1))
        s = jnp.einsum('bhtd,bhsd->bhts', qc, kc) * jnp.exp(dmat - m_t[..., None])
        a = jnp.exp(inter - m_t)
        num = a[..., None] * jnp.einsum('bhtd,bhde->bhte', qc, C) + jnp.einsum('bhts,bhse->bhte', s, vc)
        den = a * jnp.einsum('bhtd,bhd->bht', qc, nv) + jnp.sum(s, axis=-1)
        h_out = num / jnp.maximum(jnp.abs(den), jnp.exp(-m_t))[..., None]
        b_last = bc[..., -1]
        gk = b_last[..., None] - bc + lic
        m_new = jnp.maximum(b_last + m, jnp.max(gk, axis=-1))
        wk = jnp.exp(gk - m_new[..., None])
        decay = jnp.exp(b_last + m - m_new)
        C_new = decay[..., None, None] * C + jnp.einsum('bhsd,bhse->bhde', kc * wk[..., None], vc)
        n_new = decay[..., None] * nv + jnp.einsum('bhs,bhsd->bhd', wk, kc)
        return (C_new, n_new, m_new), h_out

    state, hs = lax.scan(step, state, tuple(chunks(a) for a in (q, k, v, li, lf)))
    return jnp.moveaxis(hs, 0, 2).reshape(b, h, n, -1), state


def mlstm_bidirectional(q, k, v, li, lf, states):
    h_f, s_f = mlstm_scan(q, k, v, li[0], lf[0], states[0])
    flip = lambda a: jnp.flip(a, axis=2)
    h_b, s_b = mlstm_scan(flip(q), flip(k), flip(v), flip(li[1]), flip(lf[1]), states[1])
    return h_f + flip(h_b), (s_f, s_b)


def mlstm_output(h, p, ml_gnorm):
    hn = h * lax.rsqrt(jnp.mean(h * h, axis=-1, keepdims=True) + EPS)
    y = merge_heads(hn) * ml_gnorm.astype(F32) * jax.nn.sigmoid(p['d_o'].astype(F32))
    return y.astype(p['d_gate'].dtype) * jax.nn.silu(p['d_gate'])


def mixer_mlstm(pl, pc, conv_w, b_if, ml_gnorm, need_ctx):
    q_c, k_c, v_c, li_c, lf_c = mlstm_inputs(pc, conv_w, b_if)
    b = q_c.shape[0]
    zero = (jnp.zeros((b, ML_HEADS, ML_HEAD_DIM, ML_HEAD_DIM), F32),
            jnp.zeros((b, ML_HEADS, ML_HEAD_DIM), F32),
            jnp.zeros((b, ML_HEADS), F32))
    h_c, ctx_states = mlstm_bidirectional(q_c, k_c, v_c, li_c, lf_c, (zero, zero))
    q, k, v, li, lf = mlstm_inputs(pl, conv_w, b_if)
    h, _ = mlstm_bidirectional(q, k, v, li, lf, ctx_states)
    y = mlstm_output(h, pl, ml_gnorm)
    y_c = mlstm_output(h_c, pc, ml_gnorm) if need_ctx else None
    return y, y_c


def merge_branches(merge_pre, ys, w_br, w_out):
    b, n, _ = merge_pre.shape
    g = jax.nn.sigmoid(merge_pre.reshape(b, n, N_BRANCH, D_MODEL))
    acc = g[:, :, 0] * (ys[0] @ w_br[0])
    for i in range(1, N_BRANCH):
        acc = acc + g[:, :, i] * (ys[i] @ w_br[i])
    return acc @ w_out


def hybrid_layer(x, xc, c, c_ctx, norm_g, w_mod, b_mod, w_in, na_rpb, pool_w, pool_scale,
                 mla_gq, mla_gkv, w_uq, w_ukv, conv_w, b_if, ml_gnorm, w_br, w_out, need_ctx):
    pl, gate = modulate_project(x, c[:, None, :], norm_g, w_mod, b_mod, w_in)
    pc, gate_c = modulate_project(xc, c_ctx[None, None, :], norm_g, w_mod, b_mod, w_in)
    ya, ya_c = mixer_neighbourhood(pl, pc, na_rpb, need_ctx)
    yb, yb_c = mixer_pool(pl, pc, pool_w, pool_scale, need_ctx)
    ym, ym_c = mixer_mla(pl, pc, mla_gq, mla_gkv, w_uq, w_ukv, need_ctx)
    yd, yd_c = mixer_mlstm(pl, pc, conv_w, b_if, ml_gnorm, need_ctx)
    x = x + gate * merge_branches(pl['merge'], (ya, yb, ym, yd), w_br, w_out)
    if need_ctx:
        xc = xc + gate_c * merge_branches(pc['merge'], (ya_c, yb_c, ym_c, yd_c), w_br, w_out)
    return x, xc


def setup_inputs(seed: int = 0) -> dict:
    key = jax.random.key(seed)
    ks = jax.random.split(key, 24)
    L = DEPTH

    def nrm(k, shape, s):
        return jax.random.normal(k, shape, F32) * s

    b_i = nrm(ks[8], (L, 2, 1, ML_HEADS), 0.1)
    b_f = jax.random.uniform(ks[9], (L, 2, 1, ML_HEADS), F32, 3.0, 6.0)
    return {
        'x': nrm(ks[0], (BATCH, SEQ, D_MODEL), 1.0),
        'c': nrm(ks[1], (BATCH, D_MODEL), 1.0),
        'ctx': nrm(ks[2], (BATCH, CTX_LEN, D_MODEL), 1.0),
        'c_ctx': nrm(ks[3], (D_MODEL,), 1.0),
        'norm_g': 1.0 + nrm(ks[4], (L, D_MODEL), 0.1),
        'w_mod': nrm(ks[5], (L, D_MODEL, 3 * D_MODEL), 0.5 * D_MODEL ** -0.5),
        'b_mod': nrm(ks[6], (L, 3 * D_MODEL), 0.02),
        'w_in': nrm(ks[7], (L, D_MODEL, D_IN), D_MODEL ** -0.5),
        'na_rpb': nrm(ks[10], (L, NA_HEADS, 2 * NA_ROWS - 1, 2 * NA_COLS - 1), 0.5),
        'pool_w': nrm(ks[11], (L, len(POOL_WINDOWS), POOL_GROUP, POOL_GROUP), POOL_GROUP ** -0.5),
        'pool_scale': 1.0 + nrm(ks[12], (L, BR_W), 0.1),
        'mla_gq': 1.0 + nrm(ks[13], (L, MLA_Q_LORA), 0.1),
        'mla_gkv': 1.0 + nrm(ks[14], (L, MLA_KV_LORA), 0.1),
        'w_uq': nrm(ks[15], (L, MLA_Q_LORA, MLA_HEADS * (MLA_NOPE + MLA_ROPE)), MLA_Q_LORA ** -0.5),
        'w_ukv': nrm(ks[16], (L, MLA_KV_LORA, MLA_HEADS * (MLA_NOPE + MLA_V)), MLA_KV_LORA ** -0.5),
        'conv_w': nrm(ks[17], (L, CONV_K, 2 * BR_W), CONV_K ** -0.5),
        'b_if': jnp.concatenate([b_i, b_f], axis=2).reshape(L, 4 * ML_HEADS),
        'ml_gnorm': 1.0 + nrm(ks[18], (L, BR_W), 0.1),
        'w_br': nrm(ks[19], (L, N_BRANCH, BR_W, D_MODEL), BR_W ** -0.5),
        'w_out': nrm(ks[20], (L, D_MODEL, D_MODEL), D_MODEL ** -0.5),
        'g_final': 1.0 + nrm(ks[21], (D_MODEL,), 0.1),
    }


def reference(x, c, ctx, c_ctx, norm_g, w_mod, b_mod, w_in, na_rpb, pool_w, pool_scale,
              mla_gq, mla_gkv, w_uq, w_ukv, conv_w, b_if, ml_gnorm, w_br, w_out, g_final):
    xc = ctx
    for l in range(DEPTH):
        x, xc = hybrid_layer(x, xc, c, c_ctx, norm_g[l], w_mod[l], b_mod[l], w_in[l], na_rpb[l],
                             pool_w[l], pool_scale[l], mla_gq[l], mla_gkv[l], w_uq[l], w_ukv[l],
                             conv_w[l], b_if[l], ml_gnorm[l], w_br[l], w_out[l],
                             need_ctx=(l < DEPTH - 1))
    return rmsnorm(x, g_final)
```

```cpp
#include <hip/hip_runtime.h>
#include <hip/hip_bf16.h>
#include <hip/hip_cooperative_groups.h>
#include <cstdio>
namespace cg = cooperative_groups;

typedef unsigned short u16;
using bf16x8 = __attribute__((ext_vector_type(8))) short;
using bf16x4 = __attribute__((ext_vector_type(4))) short;
using f32x4 = __attribute__((ext_vector_type(4))) float;
typedef unsigned u32x4 __attribute__((ext_vector_type(4)));
#define DEVI __device__ __forceinline__

constexpr int D = 2048, NBATCH = 4, SEQ = 4096, CTXL = 256, TPB = 4352, NTOK = 17408, DIN = 15440, NP = 7424;
constexpr int C_AQ = 0, C_AK = 512, C_AV = 1024, C_AG = 1536, C_BI = 2048, C_BG = 2560, C_CQ = 3072, C_CKV = 3584,
              C_CKR = 4096, C_CG = 4160, C_DQ = 4672, C_DK = 5184, C_DV = 5696, C_DO = 6208, C_DIF = 6720,
              C_DG = 6736, C_MG = 7248;
constexpr float EPS = 1e-6f;
constexpr int NTHR = 512;
#ifndef PROBE_ZB
#define PROBE_ZB (-1)
#endif
#ifndef PROBE_US
#define PROBE_US 1.f
#endif
#ifndef G8
#define G8 1
#endif
#define BNT (G8 ? 256 : 128)
#ifndef PROBE_DUP
#define PROBE_DUP 0
#endif
#ifndef PHM
#define PHM 0xFFFF
#endif
constexpr int SHM_BYTES = 131072;

constexpr size_t al(size_t x) { return (x + 255) & ~size_t(255); }
constexpr size_t O_WIN = 0;
constexpr size_t O_WBR = O_WIN + al((size_t)DIN * 2048 * 2);
constexpr size_t O_WOUT = O_WBR + al((size_t)4 * 2048 * 512 * 2);
constexpr size_t O_WUQ = O_WOUT + al((size_t)2048 * 2048 * 2);
constexpr size_t O_WUKV = O_WUQ + al((size_t)768 * 512 * 2);
constexpr size_t O_POOL = O_WUKV + al((size_t)1024 * 512 * 2);
constexpr size_t O_MODP = O_POOL + al((size_t)512 * 512 * 2);
constexpr size_t O_MOD = O_MODP + al((size_t)4 * 16 * 5 * 6144 * 4);
constexpr size_t O_ROPE = O_MOD + al((size_t)4 * 5 * 6144 * 4);
constexpr size_t O_XC = O_ROPE + al(64 * 16 * 8);
constexpr size_t O_HN = O_XC + al((size_t)1024 * 2048 * 4);
constexpr size_t O_PROJ = O_HN + al((size_t)NTOK * 2048 * 2);
constexpr size_t O_QH = O_PROJ + al((size_t)NTOK * NP * 2);
constexpr size_t O_KH = O_QH + al((size_t)NTOK * 768 * 2);
constexpr size_t O_VTC = O_KH + al((size_t)NTOK * 768 * 2);
constexpr size_t O_END1 = O_VTC + al((size_t)NTOK * 512 * 2);
constexpr size_t O_YBR = O_PROJ;
static_assert((size_t)NTOK * 8192 * 2 <= O_END1 - O_PROJ, "ybr alias");
constexpr size_t O_VTA = O_END1;
constexpr size_t O_DPOOL = O_VTA + al((size_t)NTOK * 512 * 2);
constexpr size_t O_QKC = O_DPOOL + al((size_t)NTOK * 512 * 2);
constexpr size_t O_GL = O_QKC + al((size_t)NTOK * 1024 * 2);
constexpr size_t O_RINV = O_GL + al((size_t)NTOK * 16 * 4);
constexpr size_t O_YS = O_RINV + al((size_t)NTOK * 2 * 4);
constexpr size_t O_ACC = O_YS + al((size_t)NTOK * 2048 * 2);
constexpr int NITEM = 32 * 68;
constexpr size_t O_KLOC = O_ACC + al((size_t)NTOK * 2048 * 2);
constexpr size_t O_NLOC = O_KLOC + al((size_t)NITEM * 16384 * 4);
constexpr size_t O_SC = O_NLOC + al((size_t)NITEM * 128 * 4);
constexpr size_t O_CIN = O_SC + al((size_t)NITEM * 2 * 4);
constexpr size_t O_NIN = O_CIN + al((size_t)NITEM * 16384 * 2);
constexpr size_t O_MIN = O_NIN + al((size_t)NITEM * 128 * 4);
constexpr size_t O_WINM1 = O_MIN + al((size_t)NITEM * 4);
constexpr size_t O_BAR = O_WINM1 + al((size_t)8192 * 2048 * 2);
constexpr size_t O_TOTAL = O_BAR + al(4096 * 4);
static_assert(O_TOTAL < 1000000000ull, "workspace budget");

struct P {
  const float *x, *c, *ctx, *c_ctx, *norm_g, *w_mod, *b_mod, *w_in, *na_rpb, *pool_w, *pool_scale, *mla_gq, *mla_gkv,
      *w_uq, *w_ukv, *conv_w, *b_if, *ml_gnorm, *w_br, *w_out, *g_final;
  float* out;
  char* ws;
};

extern __shared__ __attribute__((aligned(16))) char shm[];

DEVI u16 f2bf(float f) {
  unsigned u = __float_as_uint(f);
  u += 0x7fffu + ((u >> 16) & 1u);
  return (u16)(u >> 16);
}
typedef __bf16 bf2_t __attribute__((ext_vector_type(2)));
typedef float fl2_t __attribute__((ext_vector_type(2)));
DEVI unsigned pk2(float a, float b) {
  fl2_t v = {a, b};
  bf2_t r = __builtin_convertvector(v, bf2_t);
  return *(unsigned*)&r;
}
DEVI float bf2f(u16 h) { return __uint_as_float(((unsigned)h) << 16); }
DEVI float bfs(short h) { return __uint_as_float(((unsigned)(u16)h) << 16); }
DEVI float silu_f(float x) { return x / (1.f + __expf(-x)); }
DEVI float sigm_f(float x) { return 1.f / (1.f + __expf(-x)); }
DEVI int opqv(int x) { asm volatile("" : "+v"(x)); return x; }
DEVI int opqs(int x) { asm volatile("" : "+s"(x)); return x; }
DEVI size_t opqz() { size_t z = 0; asm volatile("" : "+s"(z)); return z; }
#define opqp(x) ((x) + opqz())
#define SHX(v, m) __int_as_float(__builtin_amdgcn_ds_bpermute(((LANE ^ (m)) << 2), __float_as_int(v)))
#define LDS_BAR() do { asm volatile("s_waitcnt lgkmcnt(0)" ::: "memory"); __builtin_amdgcn_s_barrier(); asm volatile("" ::: "memory"); } while (0)
#define OPQ_IDS const int TIDX = opqv((int)threadIdx.x); const int BIDX = opqs((int)blockIdx.x); const int LANE = TIDX & 63; (void)TIDX; (void)BIDX; (void)LANE;
#define wave_sum(v) wave_sum_l((v), LANE)
DEVI float wave_sum_l(float v, int LANE) {
#pragma unroll
  for (int o = 32; o > 0; o >>= 1) v += SHX(v, o);
  return v;
}

DEVI void ld8(const u16* ptr, float* f) {
  bf16x8 v = *(const bf16x8*)ptr;
#pragma unroll
  for (int i = 0; i < 8; ++i) f[i] = bfs(v[i]);
}
DEVI void st8(u16* ptr, const float* f) {
  bf16x8 v;
#pragma unroll
  for (int i = 0; i < 8; ++i) v[i] = (short)f2bf(f[i]);
  *(bf16x8*)ptr = v;
}
constexpr int BM = 256, BK = 64, HALF = 128, HT = HALF * BK;

DEVI int lds_byte(int r, int c) {
  int st = (r >> 4) * 2 + (c >> 5), rr = r & 15, cc = c & 31, ob = rr * 64 + cc * 2;
  return st * 1024 + (ob ^ (((ob >> 9) & 1) << 5));
}
DEVI void stage_rc(int b, int& R, int& C) {
  int st = b / 1024, sb = b % 1024, swz = sb ^ (((sb >> 9) & 1) << 5);
  R = (st >> 1) * 16 + swz / 64;
  C = (st & 1) * 32 + (swz % 64) / 2;
}

enum { M_G1A = 0, M_G2, M_G3, M_POOL, M_G4, M_G1B, M_G5 };

DEVI void gemm256(const P& p, const u16* A, int lda, const u16* Bt, int ldb, int K, int brow, int bcol, int mode,
                        int aux, int layer, int bmode) {
  OPQ_IDS
  if (!(PHM & 256)) return;
  u16* shmb = (u16*)shm;
#define SA(b, h) (shmb + ((b)*2 + (h)) * HT)
#if G8
#define SB(b, h) (shmb + (4 + (b)*2 + (h)) * HT)
#else
#define SB(b, h) (shmb + (4 + (b)) * HT)
#endif
#define LDSP(x) ((__attribute__((address_space(3))) void*)(x))
#define STAGEA(Pp, br, kt)                                                                                     \
  do {                                                                                                         \
    const int _so = ((br) * lda + (kt)*BK) * 2;                                                                \
    __builtin_amdgcn_raw_ptr_buffer_load_lds(rsA, LDSP((char*)(Pp) + TIDX * 16), 16, offA0, _so, 0, 0);       \
    __builtin_amdgcn_raw_ptr_buffer_load_lds(rsA, LDSP((char*)(Pp) + TIDX * 16 + 8192), 16, offA1, _so, 0, 0);\
  } while (0)
#define STAGEB(Pp, br, kt)                                                                                     \
  do {                                                                                                         \
    const int _so = ((br) * ldb + (kt)*BK) * 2;                                                                \
    __builtin_amdgcn_raw_ptr_buffer_load_lds(rsB, LDSP((char*)(Pp) + TIDX * 16), 16, offB0, _so, 0, 0);       \
    __builtin_amdgcn_raw_ptr_buffer_load_lds(rsB, LDSP((char*)(Pp) + TIDX * 16 + 8192), 16, offB1, _so, 0, 0);\
  } while (0)
#define LDA(dst, b, h)                                                                                         \
  for (int m = 0; m < 4; ++m)                                                                                  \
    for (int k = 0; k < 2; ++k)                                                                                \
  dst[m][k] = *reinterpret_cast<const bf16x8*>((char*)SA(b, h) + lds_byte(wr * 64 + m * 16 + fr, k * 32 + fq * 8))
#define LDB(dst, b, h)                                                                                         \
  for (int n = 0; n < 2; ++n)                                                                                  \
    for (int k = 0; k < 2; ++k)                                                                                \
  dst[n][k] = *reinterpret_cast<const bf16x8*>((char*)SB(b, h) + lds_byte(wc * 32 + n * 16 + fr, k * 32 + fq * 8))
#define MMA(ai, bj, At, Btf)                                                                                   \
  do {                                                                                                         \
    __builtin_amdgcn_s_setprio(1);                                                                             \
    for (int m = 0; m < 4; ++m)                                                                                \
      for (int n = 0; n < 2; ++n)                                                                              \
        for (int k = 0; k < 2; ++k)                                                                            \
          acc[ai][bj][m][n] = __builtin_amdgcn_mfma_f32_16x16x32_bf16(Btf[n][k], At[m][k], acc[ai][bj][m][n], 0, 0, 0); \
    __builtin_amdgcn_s_setprio(0);                                                                             \
  } while (0)
#define WAIT_V(n) asm volatile("s_waitcnt vmcnt(" #n ")" ::: "memory")
#define WAIT_L(n) asm volatile("s_waitcnt lgkmcnt(" #n ")" ::: "memory")
#define BAR __builtin_amdgcn_s_barrier()
#define SCHED __builtin_amdgcn_sched_barrier(0)

  int wid = TIDX >> 6, lane = TIDX & 63, wr = wid >> 2, wc = wid & 3, fr = lane & 15, fq = lane >> 4;
#if G8
  f32x4 acc[2][2][4][2] = {};
  bf16x8 At[4][2], B0[2][2], B1[2][2];
#else
  f32x4 acc[2][1][4][2] = {};
  bf16x8 At[4][2], B0[2][2];
#endif
  int nt = K / BK;
  const int bhalf = bmode ? 4096 : HALF;
  int offA0, offA1, offB0, offB1;
  __amdgpu_buffer_rsrc_t rsA = __builtin_amdgcn_make_buffer_rsrc((void*)A, 0, 0x7fffffff, 0x00020000);
  __amdgpu_buffer_rsrc_t rsB = __builtin_amdgcn_make_buffer_rsrc((void*)Bt, 0, 0x7fffffff, 0x00020000);
  {
    int r0, c0, r1, c1;
    stage_rc(TIDX * 16, r0, c0);
    stage_rc(TIDX * 16 + 8192, r1, c1);
    offA0 = (r0 * lda + c0) * 2; offA1 = (r1 * lda + c1) * 2;
    offB0 = (r0 * ldb + c0) * 2; offB1 = bmode ? offB0 + 2048 * ldb * 2 : (r1 * ldb + c1) * 2;
  }
#if G8
  STAGEB(SB(0, 0), bcol, 0);
  STAGEA(SA(0, 0), brow, 0);
  STAGEB(SB(0, 1), bcol + bhalf, 0);
  STAGEA(SA(0, 1), brow + HALF, 0);
  if (wr == 1) BAR;
  WAIT_V(4);
  BAR;
  STAGEB(SB(1, 0), bcol, 1);
  STAGEA(SA(1, 0), brow, 1);
  STAGEB(SB(1, 1), bcol + bhalf, 1);
  WAIT_V(6);
  BAR;
  for (int t = 0; t < nt - 2; t += 2) {
    LDB(B0, 0, 0); SCHED; LDA(At, 0, 0); STAGEA(SA(1, 1), brow + HALF, t + 1);
    WAIT_L(8); BAR; WAIT_L(0); MMA(0, 0, At, B0); BAR; SCHED;
    LDB(B1, 0, 1); STAGEB(SB(0, 0), bcol, t + 2);
    BAR; WAIT_L(0); MMA(0, 1, At, B1); BAR;
    LDA(At, 0, 1); STAGEA(SA(0, 0), brow, t + 2);
    BAR; WAIT_L(0); MMA(1, 0, At, B0); BAR; SCHED;
    STAGEB(SB(0, 1), bcol + bhalf, t + 2);
    WAIT_V(6); BAR; MMA(1, 1, At, B1); BAR;
    LDB(B0, 1, 0); SCHED; LDA(At, 1, 0); STAGEA(SA(0, 1), brow + HALF, t + 2);
    WAIT_L(8); BAR; WAIT_L(0); MMA(0, 0, At, B0); BAR; SCHED;
    LDB(B1, 1, 1); STAGEB(SB(1, 0), bcol, t + 3);
    BAR; WAIT_L(0); MMA(0, 1, At, B1); BAR;
    LDA(At, 1, 1); STAGEA(SA(1, 0), brow, t + 3);
    BAR; WAIT_L(0); MMA(1, 0, At, B0); BAR; SCHED;
    STAGEB(SB(1, 1), bcol + bhalf, t + 3);
    WAIT_V(6); BAR; MMA(1, 1, At, B1); BAR;
  }
  {
    LDB(B0, 0, 0); LDA(At, 0, 0); STAGEA(SA(1, 1), brow + HALF, nt - 1);
    BAR; WAIT_L(0); MMA(0, 0, At, B0); BAR;
    LDB(B1, 0, 1); BAR; WAIT_L(0); MMA(0, 1, At, B1); BAR;
    LDA(At, 0, 1); WAIT_V(4); BAR; WAIT_L(0); MMA(1, 0, At, B0); MMA(1, 1, At, B1); BAR;
  }
  {
    LDB(B0, 1, 0); LDA(At, 1, 0); WAIT_V(2); BAR; WAIT_L(0); MMA(0, 0, At, B0); BAR;
    LDB(B1, 1, 1); WAIT_V(0); BAR; WAIT_L(0); MMA(0, 1, At, B1); BAR;
    LDA(At, 1, 1); BAR; WAIT_L(0); MMA(1, 0, At, B0); MMA(1, 1, At, B1); BAR;
  }
  if (wr == 0) BAR;
#else
  STAGEB(SB(0, 0), bcol, 0);
  STAGEA(SA(0, 0), brow, 0);
  STAGEA(SA(0, 1), brow + HALF, 0);
  WAIT_V(0);
  BAR;
  for (int t = 0; t < nt; t += 2) {
    STAGEB(SB(1, 0), bcol, t + 1);
    STAGEA(SA(1, 0), brow, t + 1);
    STAGEA(SA(1, 1), brow + HALF, t + 1);
    LDB(B0, 0, 0); LDA(At, 0, 0); WAIT_L(0); MMA(0, 0, At, B0);
    LDA(At, 0, 1); WAIT_L(0); MMA(1, 0, At, B0);
    WAIT_V(0);
    BAR;
    if (t + 2 < nt) {
      STAGEB(SB(0, 0), bcol, t + 2);
      STAGEA(SA(0, 0), brow, t + 2);
      STAGEA(SA(0, 1), brow + HALF, t + 2);
    }
    LDB(B0, 1, 0); LDA(At, 1, 0); WAIT_L(0); MMA(0, 0, At, B0);
    LDA(At, 1, 1); WAIT_L(0); MMA(1, 0, At, B0);
    WAIT_V(0);
    BAR;
  }
#endif
  char* ws = opqp(p.ws);
  const int bb = brow / TPB;
  const int trow = brow - bb * TPB;
  u16* stg = (u16*)shm;
  const int tid = TIDX;
#define SWZ(r, c) ((c) ^ ((r)&15) ^ (((c)&1) << 4))
#pragma unroll
  for (int ai = 0; ai < 2; ++ai)
#pragma unroll
    for (int bj = 0; bj < (G8 ? 2 : 1); ++bj)
#pragma unroll
      for (int m = 0; m < 4; ++m)
#pragma unroll
        for (int n = 0; n < 2; ++n) {
          const int R = ai * HALF + wr * 64 + m * 16 + fr;
          const int chunk = bj * 16 + wc * 4 + n * 2 + (fq >> 1);
          f32x4 v = acc[ai][bj][m][n];
          uint2 pk = make_uint2(pk2(v[0], v[1]), pk2(v[2], v[3]));
          *(uint2*)(stg + R * 256 + SWZ(R, chunk) * 8 + (fq & 1) * 4) = pk;
        }
  LDS_BAR();
  if (mode == M_G1B) {
#pragma unroll
    for (int it = 0; it < 4; ++it) {
      const int R = it * 64 + (tid >> 3), co = tid & 7;
      const int row = brow + R, ocol = bcol + co * 8;
      float sum[8] = {0, 0, 0, 0, 0, 0, 0, 0};
#pragma unroll
      for (int br = 0; br < 4; ++br) {
        const int c = br * 8 + co;
        bf16x8 g = *(const bf16x8*)(stg + R * 256 + SWZ(R, c) * 8);
        float yb[8];
        ld8((const u16*)(ws + O_YBR) + (size_t)row * 8192 + br * 2048 + ocol, yb);
#pragma unroll
        for (int e = 0; e < 8; ++e) sum[e] += (br == PROBE_ZB) ? 0.f : sigm_f(bfs(g[e])) * yb[e];
      }
      st8((u16*)(ws + O_ACC) + (size_t)row * 2048 + ocol, sum);
    }
  } else {
    bool tr0 = false, tr1 = false;
    if (mode == M_G1A) { tr0 = bcol >= C_AV && bcol < C_AG; tr1 = bcol + HALF >= C_AV && bcol + HALF < C_AG; }
    else if (mode == M_G3) { tr1 = true; }
#pragma unroll 4
    for (int it = 0; it < 16; ++it) {
      const int R = it * 16 + (tid >> 5), c = tid & 31;
      if ((c < 16) ? tr0 : tr1) continue;
      const int row = brow + R, col = bcol + c * 8;
      bf16x8 raw = *(const bf16x8*)(stg + R * 256 + SWZ(R, c) * 8);
      if (mode == M_G1A) {
        *(bf16x8*)((u16*)(ws + O_PROJ) + (size_t)row * NP + col) = raw;
      } else if (mode == M_G4) {
        *(bf16x8*)((u16*)(ws + O_YBR) + (size_t)row * 8192 + aux * 2048 + col) = raw;
      } else {
        float v[8];
#pragma unroll
        for (int e = 0; e < 8; ++e) v[e] = bfs(raw[e]);
        if (mode == M_G2) {
          float rs = ((const float*)(ws + O_RINV))[row * 2];
#pragma unroll
          for (int e = 0; e < 8; ++e) v[e] *= rs;
          st8((u16*)(ws + O_QH) + (size_t)row * 768 + col, v);
        } else if (mode == M_G3) {
          float rs = ((const float*)(ws + O_RINV))[row * 2 + 1];
#pragma unroll
          for (int e = 0; e < 8; ++e) v[e] *= rs;
          st8((u16*)(ws + O_KH) + ((size_t)(bb * 4 + (col >> 8)) * TPB + (trow + R)) * 192 + (col & 255), v);
        } else if (mode == M_POOL) {
          float g[8];
          ld8((const u16*)(ws + O_PROJ) + (size_t)row * NP + C_BG + col, g);
#pragma unroll
          for (int e = 0; e < 8; ++e) {
            float y = bf2f(f2bf(v[e] * p.pool_scale[layer * 512 + col + e]));
            v[e] = y * silu_f(g[e]);
          }
          st8((u16*)(ws + O_YS) + (size_t)row * 2048 + 512 + col, v);
        } else {
          float* xb;
          const float* gv;
          const float* xs;
          if (trow == 0) {
            xb = (float*)(ws + O_XC) + ((size_t)bb * CTXL + R) * D + col;
            xs = (layer == 0) ? p.ctx + ((size_t)bb * CTXL + R) * D + col : xb;
            gv = (const float*)(ws + O_MOD) + ((size_t)layer * 5 + 4) * 6144 + 4096 + col;
          } else {
            xb = p.out + ((size_t)bb * SEQ + (trow - CTXL) + R) * D + col;
            xs = (layer == 0) ? p.x + ((size_t)bb * SEQ + (trow - CTXL) + R) * D + col : xb;
            gv = (const float*)(ws + O_MOD) + ((size_t)layer * 5 + bb) * 6144 + 4096 + col;
          }
          f32x4 x0 = *(const f32x4*)xs, x1 = *(const f32x4*)(xs + 4);
          f32x4 g0 = *(const f32x4*)gv, g1 = *(const f32x4*)(gv + 4);
#pragma unroll
          for (int e = 0; e < 4; ++e) { x0[e] += PROBE_US * g0[e] * v[e]; x1[e] += PROBE_US * g1[e] * v[4 + e]; }
          *(f32x4*)xb = x0;
          *(f32x4*)(xb + 4) = x1;
        }
      }
    }
#pragma unroll 1
    for (int hj = 0; hj < 2; ++hj) {
      if (!(hj ? tr1 : tr0)) continue;
      const int gc = bcol + hj * HALF;
      u16* tdst;
      if (mode == M_G1A) tdst = (u16*)(ws + O_VTA) + ((size_t)(bb * 512 + (gc - C_AV))) * TPB + trow;
      else tdst = (u16*)(ws + O_VTC) + ((size_t)((bb * 4 + (gc >> 8)) * 128)) * TPB + trow;
      const int cl = tid & 127, rg = tid >> 7;
      const int ct = hj * HALF + cl;
#pragma unroll 1
      for (int i = 0; i < 8; ++i) {
        const int r0 = rg * 64 + i * 8;
        float v[8];
#pragma unroll
        for (int e = 0; e < 8; ++e) {
          const int r = r0 + e;
          v[e] = bf2f(stg[r * 256 + SWZ(r, ct >> 3) * 8 + (ct & 7)]);
          if (mode == M_G3) v[e] *= ((const float*)(ws + O_RINV))[(brow + r) * 2 + 1];
        }
        st8(tdst + (size_t)cl * TPB + r0, v);
      }
    }
  }
  LDS_BAR();
#undef SWZ
}

DEVI int xcd_remap(int t, int bid, int nblk) {
  if (nblk != 256) return t;
  int r = t / 256;
  return r * 256 + (bid & 7) * 32 + (bid >> 3);
}
DEVI void tile_map(int v, int nM, int nN, int& pm, int& pn) {
  int per = 4 * nN, band = v / per, idx = v % per;
  pm = band * 4 + (idx & 3);
  pn = idx >> 2;
}

struct WItem {
  const float* src; const float* kscale; u16* dst;
  int ldsrc, K, N, k0, n0, kind;
};
DEVI WItem wdecode(const P& p, char* ws, int l, int t, int tend, u16* wmerge) {
  constexpr int T_WIN1 = 32 * 114, T_WIN2 = 32 * 128, T_WBR = 4 * 8 * 32, T_WUQ = 8 * 12, T_WUKV = 8 * 16, T_POOL = 64;
  WItem w;
  w.kscale = nullptr; w.kind = 0; w.src = nullptr; w.dst = nullptr; w.ldsrc = 0; w.K = 0; w.N = 0; w.k0 = 0; w.n0 = 0;
  if (t >= tend) { w.kind = -1; return w; }
  int i = t;
  if (i < T_WIN1) {
    w.src = p.w_in + (size_t)l * 2048 * DIN; w.ldsrc = DIN; w.K = 2048; w.N = C_MG; w.dst = (u16*)(ws + O_WIN);
    w.k0 = (i & 31) * 64; w.n0 = (i >> 5) * 64; return w;
  }
  i -= T_WIN1;
  if (i < T_WIN2) {
    w.src = p.w_in + (size_t)l * 2048 * DIN + C_MG; w.ldsrc = DIN; w.K = 2048; w.N = 8192; w.dst = wmerge;
    w.k0 = (i & 31) * 64; w.n0 = (i >> 5) * 64; return w;
  }
  i -= T_WIN2;
  if (i < T_WBR) {
    int br = i >> 8, r = i & 255;
    w.src = p.w_br + ((size_t)l * 4 + br) * 512 * 2048; w.ldsrc = 2048; w.K = 512; w.N = 2048;
    w.dst = (u16*)(ws + O_WBR) + (size_t)br * 2048 * 512; w.k0 = (r & 7) * 64; w.n0 = (r >> 3) * 64; return w;
  }
  i -= T_WBR;
  if (i < T_WUQ) {
    w.src = p.w_uq + (size_t)l * 512 * 768; w.ldsrc = 768; w.K = 512; w.N = 768; w.dst = (u16*)(ws + O_WUQ);
    w.kscale = p.mla_gq + l * 512; w.k0 = (i & 7) * 64; w.n0 = (i >> 3) * 64; return w;
  }
  i -= T_WUQ;
  if (i < T_WUKV) {
    w.src = p.w_ukv + (size_t)l * 512 * 1024; w.ldsrc = 1024; w.K = 512; w.N = 1024; w.dst = (u16*)(ws + O_WUKV);
    w.kscale = p.mla_gkv + l * 512; w.k0 = (i & 7) * 64; w.n0 = (i >> 3) * 64; return w;
  }
  i -= T_WUKV;
  if (i < T_POOL) { w.kind = 1; w.n0 = i; return w; }
  i -= T_POOL;
  w.src = p.w_out + (size_t)l * 2048 * 2048; w.ldsrc = 2048; w.K = 2048; w.N = 2048; w.dst = (u16*)(ws + O_WOUT);
  w.k0 = (i & 31) * 64; w.n0 = (i >> 5) * 64;
  return w;
}
DEVI void wload(const WItem& w, float4 (&v)[2], int tid) {
#pragma unroll
  for (int it = 0; it < 2; ++it) {
    int i = tid + it * NTHR, tr = i >> 4, c4 = (i & 15) * 4;
    float4 x = make_float4(0.f, 0.f, 0.f, 0.f);
    if (w.n0 + c4 < w.N) x = *(const float4*)(w.src + (size_t)(w.k0 + tr) * w.ldsrc + w.n0 + c4);
    if (w.kscale) { float sc = w.kscale[w.k0 + tr]; x.x *= sc; x.y *= sc; x.z *= sc; x.w *= sc; }
    v[it] = x;
  }
}

__device__ void phase_wprep(const P& p, int l, int wmode, int rank, int count, int mod, int lo, int width, int sub_lo,
                            int sub_hi) {
  OPQ_IDS
  char* ws = opqp(p.ws);
  constexpr int T_W1 = 32 * 114, T_W2 = 32 * 128;
  constexpr int T_A = T_W1 + T_W2 + 4 * 8 * 32 + 8 * 12 + 8 * 16 + 64, T_WOUT = 32 * 32;
  const int ubeg = (wmode == 2) ? T_A : (wmode == 3) ? sub_lo : 0;
  const int uend = (wmode == 1) ? T_A - T_W2 : (wmode == 3) ? sub_hi : (wmode == 4) ? T_A : T_A + T_WOUT;
  const int tend = T_A + T_WOUT;
#define WMAP(u) ((u) >= uend ? tend : (wmode == 1) ? ((u) < T_W1 ? (u) : (u) + T_W2) : (wmode == 3) ? T_W1 + (u) : (u))
  u16* wmerge = (l & 1) ? (u16*)(ws + O_WINM1) : (u16*)(ws + O_WIN) + (size_t)C_MG * 2048;
  float* tiles = (float*)shm;
  int g = rank, par = 0;
  WItem cur = wdecode(p, ws, l, WMAP(ubeg + (g / width) * mod + lo + g % width), tend, wmerge);
  float4 v[2] = {make_float4(0.f, 0.f, 0.f, 0.f), make_float4(0.f, 0.f, 0.f, 0.f)};
  __syncthreads();
  if (cur.kind == 0) wload(cur, v, TIDX);
  while (cur.kind >= 0) {
    g += count;
    WItem nxt = wdecode(p, ws, l, WMAP(ubeg + (g / width) * mod + lo + g % width), tend, wmerge);
    float4 vn[2] = {make_float4(0.f, 0.f, 0.f, 0.f), make_float4(0.f, 0.f, 0.f, 0.f)};
    if (nxt.kind == 0) wload(nxt, vn, TIDX);
    if (cur.kind == 0) {
      float* tile = tiles + par * (64 * 65);
      par ^= 1;
#pragma unroll
      for (int it = 0; it < 2; ++it) {
        int i = TIDX + it * NTHR, tr = i >> 4, c4 = (i & 15) * 4;
        float* tp = tile + tr * 65 + c4;
        tp[0] = v[it].x; tp[1] = v[it].y; tp[2] = v[it].z; tp[3] = v[it].w;
      }
      __syncthreads();
      int tn = TIDX & 63, tk = (TIDX >> 6) * 8;
      if (cur.n0 + tn < cur.N) {
        bf16x8 o;
#pragma unroll
        for (int e = 0; e < 8; ++e) o[e] = (short)f2bf(tile[(tk + e) * 65 + tn]);
        *(bf16x8*)(cur.dst + (size_t)(cur.n0 + tn) * cur.K + cur.k0 + tk) = o;
      }
    } else {
      u16* dst = (u16*)(ws + O_POOL);
      for (int e = TIDX; e < 4096; e += NTHR) {
        int idx = cur.n0 * 4096 + e, n = idx >> 9, k = idx & 511;
        int gg = n >> 7, g2 = k >> 7;
        float x = 0.f;
        if (gg == g2) x = p.pool_w[(((size_t)l * 4 + gg) * 128 + (k & 127)) * 128 + (n & 127)];
        dst[idx] = f2bf(x);
      }
    }
    cur = nxt;
    v[0] = vn[0];
    v[1] = vn[1];
  }
  __syncthreads();
}
#undef WMAP

__device__ void phase_mod_partial(const P& p) {
  OPQ_IDS
  float* sl = (float*)shm;
  float* modp = (float*)(p.ws + O_MODP);
  for (int t = BIDX; t < 4 * 24 * 16; t += gridDim.x) {
    int l = t / 384, r = t % 384, nb = r / 16, ks = r % 16;
    __syncthreads();
    for (int i = TIDX; i < 640; i += NTHR) {
      int v = i >> 7, k = i & 127;
      float cv = (v < 4) ? p.c[v * 2048 + ks * 128 + k] : p.c_ctx[ks * 128 + k];
      sl[i] = silu_f(cv);
    }
    __syncthreads();
    int col = TIDX & 255, kh = TIDX >> 8;
    float a[5] = {0, 0, 0, 0, 0};
    const float* w = p.w_mod + ((size_t)l * 2048 + ks * 128 + kh * 64) * 6144 + nb * 256 + col;
#pragma unroll 4
    for (int k = 0; k < 64; ++k) {
      float wv = w[(size_t)k * 6144];
#pragma unroll
      for (int v = 0; v < 5; ++v) a[v] += sl[v * 128 + kh * 64 + k] * wv;
    }
    __syncthreads();
    float* part = sl + 1024;
    if (kh == 1) {
#pragma unroll
      for (int v = 0; v < 5; ++v) part[v * 256 + col] = a[v];
    }
    __syncthreads();
    if (kh == 0) {
#pragma unroll
      for (int v = 0; v < 5; ++v)
        modp[(((size_t)l * 16 + ks) * 5 + v) * 6144 + nb * 256 + col] = a[v] + part[v * 256 + col];
    }
  }
  float2* rt = (float2*)(p.ws + O_ROPE);
  for (int i = BIDX * NTHR + TIDX; i < 1024; i += gridDim.x * NTHR) {
    int pos = i >> 4, j = i & 15;
    float inv = powf(10000.f, -(float)j / 16.f);
    float ang = (float)pos * inv;
    rt[i] = make_float2(cosf(ang), sinf(ang));
  }
}
__device__ void phase_mod_reduce(const P& p) {
  OPQ_IDS
  const float* modp = (const float*)(p.ws + O_MODP);
  float* mod = (float*)(p.ws + O_MOD);
  for (int i = BIDX * NTHR + TIDX; i < 4 * 5 * 6144; i += gridDim.x * NTHR) {
    int l = i / 30720, r = i % 30720, n = r % 6144;
    float s = p.b_mod[l * 6144 + n];
    for (int ks = 0; ks < 16; ++ks) s += modp[((size_t)l * 16 + ks) * 30720 + r];
    mod[i] = s;
  }
}

DEVI float* xrow_ptr(const P& p, int r) {
  int b = r / TPB, t = r - b * TPB;
  return (t < CTXL) ? (float*)(p.ws + O_XC) + ((size_t)b * CTXL + t) * D : p.out + ((size_t)b * SEQ + (t - CTXL)) * D;
}
__device__ void phase_norm(const P& p, int l) {
  OPQ_IDS
  int lane = TIDX & 63, gw = BIDX * 8 + (TIDX >> 6), nw = gridDim.x * 8;
  const float* mod = (const float*)(p.ws + O_MOD);
  u16* hn = (u16*)(p.ws + O_HN);
  for (int r = gw; r < NTOK; r += nw) {
    int b = r / TPB, t = r - b * TPB;
    float* xr = xrow_ptr(p, r);
    const float* src = xr;
    if (l == 0) src = (t < CTXL) ? p.ctx + ((size_t)b * CTXL + t) * D : p.x + ((size_t)b * SEQ + (t - CTXL)) * D;
    const float* mv = mod + ((size_t)l * 5 + (t < CTXL ? 4 : b)) * 6144;
    float4 v[8];
    float ss = 0.f;
#pragma unroll
    for (int i = 0; i < 8; ++i) {
      v[i] = *(const float4*)(src + i * 256 + lane * 4);
      ss += v[i].x * v[i].x + v[i].y * v[i].y + v[i].z * v[i].z + v[i].w * v[i].w;
    }
    ss = wave_sum(ss);
    float rs = rsqrtf(ss * (1.f / D) + EPS);
#pragma unroll
    for (int i = 0; i < 8; ++i) {
      int c0 = i * 256 + lane * 4;
      float4 g = *(const float4*)(p.norm_g + l * D + c0);
      float4 sh = *(const float4*)(mv + c0);
      float4 sc = *(const float4*)(mv + 2048 + c0);
      unsigned a0 = f2bf(v[i].x * rs * g.x * (1.f + sc.x) + sh.x), a1 = f2bf(v[i].y * rs * g.y * (1.f + sc.y) + sh.y);
      unsigned a2 = f2bf(v[i].z * rs * g.z * (1.f + sc.z) + sh.z), a3 = f2bf(v[i].w * rs * g.w * (1.f + sc.w) + sh.w);
      uint2 o = make_uint2(a0 | (a1 << 16), a2 | (a3 << 16));
      *(uint2*)(hn + (size_t)r * D + c0) = o;
    }
  }
}
__device__ void phase_final(const P& p) {
  OPQ_IDS
  int lane = TIDX & 63, gw = BIDX * 8 + (TIDX >> 6), nw = gridDim.x * 8;
  for (int r = gw; r < NBATCH * SEQ; r += nw) {
    float* xr = p.out + (size_t)r * D;
    float4 v[8];
    float ss = 0.f;
#pragma unroll
    for (int i = 0; i < 8; ++i) {
      v[i] = *(const float4*)(xr + i * 256 + lane * 4);
      ss += v[i].x * v[i].x + v[i].y * v[i].y + v[i].z * v[i].z + v[i].w * v[i].w;
    }
    ss = wave_sum(ss);
    float rs = rsqrtf(ss * (1.f / D) + EPS);
#pragma unroll
    for (int i = 0; i < 8; ++i) {
      int c0 = i * 256 + lane * 4;
      float4 g = *(const float4*)(p.g_final + c0);
      *(float4*)(xr + c0) = make_float4(v[i].x * rs * g.x, v[i].y * rs * g.y, v[i].z * rs * g.z, v[i].w * rs * g.w);
    }
  }
}

__device__ void phase_p2(const P& p, int l) {
  OPQ_IDS
  int lane = TIDX & 63, gw = xcd_remap(BIDX, BIDX, gridDim.x) * 8 + (TIDX >> 6), nw = gridDim.x * 8;
  char* ws = opqp(p.ws);
  const u16* proj = (const u16*)(ws + O_PROJ);
  float* rinv = (float*)(ws + O_RINV);
  const float2* rt = (const float2*)(ws + O_ROPE);
  float cw[2][4][8];
#pragma unroll
  for (int part = 0; part < 2; ++part)
#pragma unroll
    for (int j = 0; j < 4; ++j) {
      const float* cp = p.conv_w + ((size_t)l * 4 + j) * 1024 + part * 512 + lane * 8;
      f32x4 c0 = *(const f32x4*)cp, c1 = *(const f32x4*)(cp + 4);
#pragma unroll
      for (int i = 0; i < 4; ++i) { cw[part][j][i] = c0[i]; cw[part][j][4 + i] = c1[i]; }
    }
  const float bif = (lane < 16) ? p.b_if[l * 16 + lane] : 0.f;
  const bf16x8 z8 = {0, 0, 0, 0, 0, 0, 0, 0};
  for (int r = gw; r < NTOK; r += nw) {
    int b = r / TPB, t = r - b * TPB;
    const bool isctx = t < CTXL;
    const int pos = isctx ? t : t - CTXL;
    const int n = isctx ? CTXL : SEQ;
    const u16* pr = proj + (size_t)r * NP;
    const bf16x8 vq = *(const bf16x8*)(pr + C_CQ + lane * 8);
    const bf16x8 vkv = *(const bf16x8*)(pr + C_CKV + lane * 8);
    const u16 kro = pr[C_CKR + lane], krp = pr[C_CKR + (lane ^ 16)];
    const u16 dif = pr[C_DIF + (lane & 15)];
    const int g = lane >> 4, w = 2 << g;
    const int lo = max(pos - w / 2, 0), hi = min(pos + (w - 1 - w / 2), n - 1);
    bf16x8 wv[16];
#pragma unroll
    for (int k = 0; k < 16; ++k) {
      int u = pos + k - 8;
      wv[k] = z8;
      if (u >= lo && u <= hi) wv[k] = *(const bf16x8*)(pr + (ptrdiff_t)(k - 8) * NP + C_BI + lane * 8);
    }
    bf16x8 cv[2][4];
#pragma unroll
    for (int part = 0; part < 2; ++part)
#pragma unroll
      for (int j = 0; j < 4; ++j) {
        int u = pos + j - 2;
        cv[part][j] = z8;
        if (u >= 0 && u < n) cv[part][j] = *(const bf16x8*)(pr + (ptrdiff_t)(j - 2) * NP + C_DQ + part * 512 + lane * 8);
      }
    float sq = 0.f, skv = 0.f;
#pragma unroll
    for (int i = 0; i < 8; ++i) { float a = bfs(vq[i]), c = bfs(vkv[i]); sq += a * a; skv += c * c; }
    sq = wave_sum(sq);
    skv = wave_sum(skv);
    if (lane == 0) {
      rinv[r * 2] = rsqrtf(sq * (1.f / 512.f) + EPS);
      rinv[r * 2 + 1] = rsqrtf(skv * (1.f / 512.f) + EPS);
    }
    {
      float own = bf2f(kro);
      float o = own;
      if (!isctx) {
        float par = bf2f(krp);
        int half = lane >> 5, ii = lane & 31, j = ii & 15;
        int pp = half ? (pos & 63) : (pos >> 6);
        float2 cs = rt[pp * 16 + j];
        o = (ii < 16) ? own * cs.x - par * cs.y : own * cs.x + par * cs.y;
      }
      u16 ob = f2bf(o);
      u16* kh = (u16*)(ws + O_KH) + ((size_t)(b * 4) * TPB + t) * 192 + 128 + lane;
#pragma unroll
      for (int h = 0; h < 4; ++h) kh[(size_t)h * TPB * 192] = ob;
    }
    {
      float s[8] = {0, 0, 0, 0, 0, 0, 0, 0};
#pragma unroll
      for (int k = 0; k < 16; ++k)
#pragma unroll
        for (int i = 0; i < 8; ++i) s[i] += bfs(wv[k][i]);
      float ic = 1.f / (float)(hi - lo + 1);
#pragma unroll
      for (int i = 0; i < 8; ++i) s[i] = s[i] * ic - bfs(wv[8][i]);
      st8((u16*)(ws + O_DPOOL) + (size_t)r * 512 + lane * 8, s);
    }
#pragma unroll
    for (int part = 0; part < 2; ++part) {
      float a[8] = {0, 0, 0, 0, 0, 0, 0, 0};
#pragma unroll
      for (int j = 0; j < 4; ++j)
#pragma unroll
        for (int i = 0; i < 8; ++i) a[i] += bfs(cv[part][j][i]) * cw[part][j][i];
      const float ksc = part ? 0.08838834764831845f : 1.f;
#pragma unroll
      for (int i = 0; i < 8; ++i) a[i] = silu_f(a[i]) * ksc;
      st8((u16*)(ws + O_QKC) + (size_t)r * 1024 + part * 512 + lane * 8, a);
    }
    if (lane < 16) {
      float gg = bf2f(dif) + bif;
      if (lane & 4) gg = fminf(gg, 0.f) - __logf(1.f + __expf(-fabsf(gg)));
      ((float*)(ws + O_GL))[(size_t)r * 16 + lane] = gg;
    }
  }
}

struct AttnTile {
  const u16* kp;
  const u16* vp;
  int isctx;
  int kr;
};

template <int DQK, int QT, bool NA>
__device__ void attn_block(const P& p, int layer, int b, int h, int qrow0  , bool q_is_latent,
                           int ntile, int na_r0  , const u16* Kbase, int ldk,
                           const u16* Vtbase  , const u16* Qbase, int ldq, int gatecol,
                           int ycol, float scale) {
  OPQ_IDS
  constexpr int KS = DQK / 32;
  constexpr int KSTR = DQK + 8;
  const float scale2 = scale * 1.4426950408889634f;
  constexpr int KCH = 64 * DQK / 8 / NTHR;
  u16* Ks = (u16*)shm;
  u16* Vs = Ks + 64 * KSTR;
  float* rpb = (float*)(Vs + 128 * 72);
  const int wid = TIDX >> 6, lane = TIDX & 63, l15 = lane & 15, quad = lane >> 4;
  char* ws = opqp(p.ws);
  const float2* rt = (const float2*)(ws + O_ROPE);

  __syncthreads();
  if (NA) {
    for (int i = TIDX; i < 465; i += NTHR) rpb[i] = p.na_rpb[((size_t)layer * 4 + h) * 465 + i];
  }
  bf16x8 qf[QT][KS];
#pragma unroll
  for (int qt = 0; qt < QT; ++qt) {
    int ql = wid * 16 * QT + qt * 16 + l15;
    const u16* qp = Qbase + (size_t)(qrow0 + ql) * ldq;
#pragma unroll
    for (int ks = 0; ks < KS; ++ks) qf[qt][ks] = *(const bf16x8*)(qp + ks * 32 + quad * 8);
  }
  f32x4 o[8][QT];
  float mrun[QT], lrun[QT];
#pragma unroll
  for (int qt = 0; qt < QT; ++qt) {
    mrun[qt] = -1e30f;
    lrun[qt] = 0.f;
#pragma unroll
    for (int dt = 0; dt < 8; ++dt) o[dt][qt] = f32x4{0.f, 0.f, 0.f, 0.f};
  }
  int na_rq = 0, na_cq = 0, na_cs = 0, na_rs = 0;
  if (NA) {
    na_rq = na_r0 + (wid >> 2);
    na_cq = (wid & 3) * 16 + l15;
    na_cs = min(max(na_cq - 8, 0), 48);
    na_rs = min(max(na_rq - 4, 0), 56);
  }
  const int na_rlo = NA ? min(max(na_r0 - 4, 0), 56) : 0;

  bf16x8 kreg[KCH], vreg[2];
  auto tile_ptrs = [&](int ti, const u16*& kp, const u16*& vp, int& isctx, int& kr) {
    int tok0;
    if (ti < 4) {
      tok0 = ti * 64;
      isctx = 1;
      kr = -1;
    } else {
      isctx = 0;
      kr = NA ? (na_rlo + ti - 4) : (ti - 4);
      tok0 = CTXL + kr * 64;
    }
    kp = Kbase + (size_t)tok0 * ldk;
    vp = Vtbase + tok0;
  };
  auto gloadK = [&](int ti) {
    const u16 *kp, *vp;
    int ic, kr;
    tile_ptrs(ti, kp, vp, ic, kr);
#pragma unroll
    for (int i = 0; i < KCH; ++i) {
      int c = TIDX + i * NTHR, key = c / (DQK / 8), part = c % (DQK / 8);
      kreg[i] = *(const bf16x8*)(kp + (size_t)key * ldk + part * 8);
    }
  };
  auto gloadV = [&](int ti) {
    const u16 *kp, *vp;
    int ic, kr;
    tile_ptrs(ti, kp, vp, ic, kr);
#pragma unroll
    for (int i = 0; i < 2; ++i) {
      int c = TIDX + i * NTHR, dv = c >> 3, part = c & 7;
      vreg[i] = *(const bf16x8*)(vp + (size_t)dv * TPB + part * 8);
    }
  };
  auto sstoreK = [&]() {
#pragma unroll
    for (int i = 0; i < KCH; ++i) {
      int c = TIDX + i * NTHR, key = c / (DQK / 8), part = c % (DQK / 8);
      *(bf16x8*)(Ks + key * KSTR + part * 8) = kreg[i];
    }
  };
  auto sstoreV = [&]() {
#pragma unroll
    for (int i = 0; i < 2; ++i) {
      int c = TIDX + i * NTHR, dv = c >> 3, part = c & 7;
      *(bf16x8*)(Vs + dv * 72 + part * 8) = vreg[i];
    }
  };

  gloadK(0);
  gloadV(0);
  __syncthreads();
  sstoreK();
  sstoreV();
  if (ntile > 1) { gloadK(1); gloadV(1); }
  LDS_BAR();
  auto tile_iter = [&](int ti) {
    const int isctx = ti < 4;
    int kr = NA ? (na_rlo + ti - 4) : 0;
    bool active = true;
    if (NA && !isctx) active = (kr >= na_rs) && (kr < na_rs + 8);
    f32x4 s[4][QT];
    if (active) {
#pragma unroll
      for (int kt = 0; kt < 4; ++kt)
#pragma unroll
        for (int qt = 0; qt < QT; ++qt) s[kt][qt] = f32x4{0.f, 0.f, 0.f, 0.f};
#pragma unroll
      for (int ks = 0; ks < KS; ++ks) {
        bf16x8 a[4];
#pragma unroll
        for (int kt = 0; kt < 4; ++kt) a[kt] = *(const bf16x8*)(Ks + (kt * 16 + l15) * KSTR + ks * 32 + quad * 8);
#pragma unroll
        for (int qt = 0; qt < QT; ++qt) {
          bf16x8 q = qf[qt][ks];
#pragma unroll
          for (int kt = 0; kt < 4; ++kt) s[kt][qt] = __builtin_amdgcn_mfma_f32_16x16x32_bf16(a[kt], q, s[kt][qt], 0, 0, 0);
        }
      }
    }
    LDS_BAR();
    if (ti + 1 < ntile) sstoreK();
    if (ti + 2 < ntile) gloadK(ti + 2);
    if (active) {
      bf16x8 pf[QT][2];
#pragma unroll
      for (int qt = 0; qt < QT; ++qt) {
        float mx = -1e30f;
#pragma unroll
        for (int kt = 0; kt < 4; ++kt)
#pragma unroll
          for (int j = 0; j < 4; ++j) {
            float v = s[kt][qt][j] * scale2;
            if (NA && !isctx) {
              int ck = kt * 16 + quad * 4 + j;
              bool valid = (ck >= na_cs) && (ck < na_cs + 16);
              int bidx = (kr - na_rq + 7) * 31 + min(max(ck - na_cq + 15, 0), 30);
              v = valid ? v + rpb[bidx] * 1.4426950408889634f : -1e30f;
            }
            s[kt][qt][j] = v;
            mx = fmaxf(mx, v);
          }
        mx = fmaxf(mx, SHX(mx, 16));
        mx = fmaxf(mx, SHX(mx, 32));
        float mnew = fmaxf(mrun[qt], mx);
        float alpha = __builtin_amdgcn_exp2f(mrun[qt] - mnew);
        mrun[qt] = mnew;
        float ls = 0.f;
#pragma unroll
        for (int kt = 0; kt < 4; ++kt)
#pragma unroll
          for (int j = 0; j < 4; ++j) {
            float pv = __builtin_amdgcn_exp2f(s[kt][qt][j] - mnew);
            ls += pv;
            s[kt][qt][j] = pv;
          }
        lrun[qt] = lrun[qt] * alpha + ls;
        if (__builtin_amdgcn_ballot_w64(alpha != 1.f)) {
#pragma unroll
          for (int dt = 0; dt < 8; ++dt)
#pragma unroll
            for (int j = 0; j < 4; ++j) o[dt][qt][j] *= alpha;
        }
#pragma unroll
        for (int kk = 0; kk < 2; ++kk) {
          union { bf16x8 v; unsigned u[4]; } cv;
          cv.u[0] = pk2(s[2 * kk][qt][0], s[2 * kk][qt][1]);
          cv.u[1] = pk2(s[2 * kk][qt][2], s[2 * kk][qt][3]);
          cv.u[2] = pk2(s[2 * kk + 1][qt][0], s[2 * kk + 1][qt][1]);
          cv.u[3] = pk2(s[2 * kk + 1][qt][2], s[2 * kk + 1][qt][3]);
          pf[qt][kk] = cv.v;
        }
      }
#pragma unroll
      for (int kk = 0; kk < 2; ++kk)
#pragma unroll
        for (int dt = 0; dt < 8; ++dt) {
          const u16* vb = Vs + (dt * 16 + l15) * 72 + kk * 32 + quad * 4;
          bf16x4 v0 = *(const bf16x4*)vb, v1 = *(const bf16x4*)(vb + 16);
          bf16x8 va = {v0[0], v0[1], v0[2], v0[3], v1[0], v1[1], v1[2], v1[3]};
#pragma unroll
          for (int qt = 0; qt < QT; ++qt) o[dt][qt] = __builtin_amdgcn_mfma_f32_16x16x32_bf16(va, pf[qt][kk], o[dt][qt], 0, 0, 0);
        }
    }
    LDS_BAR();
    if (ti + 1 < ntile) sstoreV();
    if (ti + 2 < ntile) gloadV(ti + 2);
  };
  for (int ti = 0; ti < 4; ++ti) tile_iter(ti);
  if (ntile > 4) {
    if (!NA && DQK == 192) {
#pragma unroll
      for (int qt = 0; qt < QT; ++qt) {
        const int ql = wid * 16 * QT + qt * 16 + l15;
        const u16* qp = Qbase + (size_t)(qrow0 + ql) * ldq;
        const int tq = (qrow0 + ql) % TPB - CTXL;
#pragma unroll
        for (int hf = 0; hf < 2; ++hf) {
          bf16x8 own = qf[qt][KS - 2 + hf];
          bf16x8 par = *(const bf16x8*)(qp + 128 + hf * 32 + (quad ^ 2) * 8);
          int pp = hf ? (tq & 63) : (tq >> 6);
          bf16x8 ro;
#pragma unroll
          for (int e = 0; e < 8; ++e) {
            float2 cs = rt[pp * 16 + (quad & 1) * 8 + e];
            float ov = bfs(own[e]), pv = bfs(par[e]);
            float r = (quad < 2) ? ov * cs.x - pv * cs.y : ov * cs.x + pv * cs.y;
            ro[e] = (short)f2bf(r);
          }
          qf[qt][KS - 2 + hf] = ro;
        }
      }
    }
    for (int ti = 4; ti < ntile; ++ti) tile_iter(ti);
  }
  const u16* proj = (const u16*)(ws + O_PROJ);
  u16* ys = (u16*)(ws + O_YS);
#pragma unroll
  for (int qt = 0; qt < QT; ++qt) {
    float lt = lrun[qt];
    lt += SHX(lt, 16);
    lt += SHX(lt, 32);
    float il = 1.f / lt;
    int r = qrow0 + wid * 16 * QT + qt * 16 + l15;
#pragma unroll
    for (int dt = 0; dt < 8; ++dt) {
      int dv = dt * 16 + quad * 4;
      bf16x4 g = *(const bf16x4*)(proj + (size_t)r * NP + gatecol + h * 128 + dv);
      bf16x4 ov;
#pragma unroll
      for (int j = 0; j < 4; ++j) {
        float y = bf2f(f2bf(o[dt][qt][j] * il));
        ov[j] = (short)f2bf(y * silu_f(bfs(g[j])));
      }
      *(bf16x4*)(ys + (size_t)r * 2048 + ycol + h * 128 + dv) = ov;
    }
  }
}

__device__ void phase_attn(const P& p, int l) {
  OPQ_IDS
  char* ws = opqp(p.ws);
  const bool need_ctx = l < 3;
  const int n_mla_lat = 256, n_na_lat = 512;
  const int n_mla_ctx = need_ctx ? 16 : 0, n_na_ctx = need_ctx ? 32 : 0;
  const int total = n_mla_lat + n_na_lat + n_mla_ctx + n_na_ctx;
  const u16* proj = (const u16*)(ws + O_PROJ);
  for (int it0 = BIDX; it0 < (total + 255) / 256 * 256; it0 += gridDim.x) {
    const int it = xcd_remap(it0, BIDX, gridDim.x);
    if (it >= total) continue;
    int i = it;
    if (i < n_mla_lat) {
      int bh = i >> 4, qb = i & 15, b = bh >> 2, h = bh & 3;
      attn_block<192, 2, false>(p, l, b, h, b * TPB + CTXL + qb * 256, true, 68, 0,
                                (const u16*)(ws + O_KH) + (size_t)bh * TPB * 192, 192,
                                (const u16*)(ws + O_VTC) + (size_t)bh * 128 * TPB,
                                (const u16*)(ws + O_QH) + h * 192, 768, C_CG, 1024, 0.07216878364870322f);
      continue;
    }
    i -= n_mla_lat;
    if (i < n_na_lat) {
      int bh = i >> 5, rp = i & 31, b = bh >> 2, h = bh & 3;
      int r0 = rp * 2;
      int rlo = min(max(r0 - 4, 0), 56), rhi = min(max(r0 + 1 - 4, 0), 56) + 7;
      attn_block<128, 1, true>(p, l, b, h, b * TPB + CTXL + r0 * 64, true, 4 + (rhi - rlo + 1), r0,
                               proj + (size_t)b * TPB * NP + C_AK + h * 128, NP,
                               (const u16*)(ws + O_VTA) + (size_t)bh * 128 * TPB, proj + C_AQ + h * 128, NP, C_AG, 0,
                               0.08838834764831845f);
      continue;
    }
    i -= n_na_lat;
    if (i < n_mla_ctx) {
      int bh = i, b = bh >> 2, h = bh & 3;
      attn_block<192, 2, false>(p, l, b, h, b * TPB, false, 4, 0, (const u16*)(ws + O_KH) + (size_t)bh * TPB * 192, 192,
                                (const u16*)(ws + O_VTC) + (size_t)bh * 128 * TPB, (const u16*)(ws + O_QH) + h * 192,
                                768, C_CG, 1024, 0.07216878364870322f);
      continue;
    }
    i -= n_mla_ctx;
    {
      int bh = i >> 1, half = i & 1, b = bh >> 2, h = bh & 3;
      attn_block<128, 1, false>(p, l, b, h, b * TPB + half * 128, false, 4, 0,
                                proj + (size_t)b * TPB * NP + C_AK + h * 128, NP,
                                (const u16*)(ws + O_VTA) + (size_t)bh * 128 * TPB, proj + C_AQ + h * 128, NP, C_AG, 0,
                                0.08838834764831845f);
    }
  }
}

DEVI int chunk_index(int dir, int blk) {
  if (dir == 0) return blk;
  return blk < 4 ? 3 - blk : 4 + 63 - (blk - 4);
}
__device__ void mlstm_gates(const P& p, int b, int h, int blk, float* gs) {
  OPQ_IDS
  const float* gl = (const float*)(opqp(p.ws) + O_GL);
  int R0 = b * TPB + blk * 64;
  if (TIDX < 128) {
    const int dir = TIDX >> 6, L = LANE, t = dir ? 63 - L : L;
    const float li = gl[(size_t)(R0 + t) * 16 + dir * 8 + h];
    const float lf = gl[(size_t)(R0 + t) * 16 + dir * 8 + 4 + h];
    float bc = lf;
#pragma unroll
    for (int o = 1; o < 64; o <<= 1) {
      float n = __int_as_float(__builtin_amdgcn_ds_bpermute(((L - o) & 63) << 2, __float_as_int(bc)));
      if (L >= o) bc += n;
    }
    float pm = li - bc;
#pragma unroll
    for (int o = 1; o < 64; o <<= 1) {
      float n = __int_as_float(__builtin_amdgcn_ds_bpermute(((L - o) & 63) << 2, __float_as_int(pm)));
      if (L >= o) pm = fmaxf(pm, n);
    }
    gs[dir * 64 + t] = li;
    gs[128 + dir * 64 + t] = lf;
    gs[256 + dir * 64 + t] = bc;
    gs[384 + dir * 64 + t] = pm;
    if (L == 63) {
      gs[512 + dir * 4] = bc;
      gs[512 + dir * 4 + 1] = bc + pm;
    }
  }
  __syncthreads();
}

__device__ void phase_m1(const P& p) {
  OPQ_IDS
  char* ws = opqp(p.ws);
  u16* kwT = (u16*)shm;
  u16* vT = kwT + 2 * 128 * 72;
  float* gs = (float*)(vT + 128 * 72);
  const u16* qkc = (const u16*)(ws + O_QKC);
  const u16* proj = (const u16*)(ws + O_PROJ);
  const int wid = TIDX >> 6, lane = TIDX & 63, l15 = lane & 15, quad = lane >> 4;
  for (int it = BIDX; it < 16 * 68; it += gridDim.x) {
    int bh = it / 68, blk = it % 68, b = bh >> 2, h = bh & 3;
    int R0 = b * TPB + blk * 64;
    __syncthreads();
    mlstm_gates(p, b, h, blk, gs);
#pragma unroll
    for (int i = 0; i < 2; ++i) {
      int c = TIDX + i * NTHR, s = c & 63, part = c >> 6;
      float kf[8];
      ld8(qkc + (size_t)(R0 + s) * 1024 + 512 + h * 128 + part * 8, kf);
      bf16x8 vv = *(const bf16x8*)(proj + (size_t)(R0 + s) * NP + C_DV + h * 128 + part * 8);
#pragma unroll
      for (int dir = 0; dir < 2; ++dir) {
        float bl = gs[512 + dir * 4], ml = gs[512 + dir * 4 + 1];
        float w = __expf(bl - gs[256 + dir * 64 + s] + gs[dir * 64 + s] - ml);
#pragma unroll
        for (int e = 0; e < 8; ++e) kwT[(dir * 128 + part * 8 + e) * 72 + s] = f2bf(kf[e] * w);
      }
#pragma unroll
      for (int e = 0; e < 8; ++e) vT[(part * 8 + e) * 72 + s] = (u16)vv[e];
    }
    __syncthreads();
    int dir = wid >> 2;
    int item = (bh * 2 + dir) * 68 + chunk_index(dir, blk);
    f32x4 acc[2][8];
#pragma unroll
    for (int a = 0; a < 2; ++a)
#pragma unroll
      for (int e = 0; e < 8; ++e) acc[a][e] = f32x4{0.f, 0.f, 0.f, 0.f};
#pragma unroll
    for (int kk = 0; kk < 2; ++kk) {
      bf16x8 af[2];
#pragma unroll
      for (int a = 0; a < 2; ++a) {
        const u16* ab = kwT + (dir * 128 + ((wid & 3) * 2 + a) * 16 + l15) * 72 + kk * 32 + quad * 4;
        bf16x4 v0 = *(const bf16x4*)ab, v1 = *(const bf16x4*)(ab + 16);
        af[a] = bf16x8{v0[0], v0[1], v0[2], v0[3], v1[0], v1[1], v1[2], v1[3]};
      }
#pragma unroll
      for (int e = 0; e < 8; ++e) {
        const u16* bb = vT + (e * 16 + l15) * 72 + kk * 32 + quad * 4;
        bf16x4 v0 = *(const bf16x4*)bb, v1 = *(const bf16x4*)(bb + 16);
        bf16x8 bf = bf16x8{v0[0], v0[1], v0[2], v0[3], v1[0], v1[1], v1[2], v1[3]};
#pragma unroll
        for (int a = 0; a < 2; ++a) acc[a][e] = __builtin_amdgcn_mfma_f32_16x16x32_bf16(af[a], bf, acc[a][e], 0, 0, 0);
      }
    }
    float* kl = (float*)(ws + O_KLOC) + (size_t)item * 16384;
#pragma unroll
    for (int a = 0; a < 2; ++a)
#pragma unroll
      for (int e = 0; e < 8; ++e) {
        int d0 = ((wid & 3) * 2 + a) * 16 + quad * 4, ee = e * 16 + l15;
        *(f32x4*)(kl + ee * 128 + d0) = acc[a][e];
      }
    if (TIDX < 256) {
      int dr = TIDX >> 7, d = TIDX & 127;
      float s = 0.f;
      for (int u = 0; u < 64; ++u) s += bf2f(kwT[(dr * 128 + d) * 72 + u]);
      int itm = (bh * 2 + dr) * 68 + chunk_index(dr, blk);
      ((float*)(ws + O_NLOC))[(size_t)itm * 128 + d] = s;
      if (d < 2) ((float*)(ws + O_SC))[itm * 2 + d] = gs[512 + dr * 4 + d];
    }
  }
}

__device__ void phase_m2(const P& p) {
  OPQ_IDS
  char* ws = opqp(p.ws);
  const float* kloc = (const float*)(ws + O_KLOC);
  const float* nloc = (const float*)(ws + O_NLOC);
  const float* sc = (const float*)(ws + O_SC);
  u16* cin = (u16*)(ws + O_CIN);
  float* nin = (float*)(ws + O_NIN);
  float* minp = (float*)(ws + O_MIN);
  const int per = 4096 + 32;
  for (int idx = BIDX * NTHR + TIDX; idx < 32 * per; idx += gridDim.x * NTHR) {
    int seq = idx / per, q4 = idx % per;
    f32x4 C = {0.f, 0.f, 0.f, 0.f};
    float m = 0.f;
    const bool isn = q4 >= 4096;
    for (int j0 = 0; j0 < 68; j0 += 4) {
      f32x4 kv[4];
      float bl[4], ml[4];
#pragma unroll
      for (int u = 0; u < 4; ++u) {
        int item = seq * 68 + j0 + u;
        kv[u] = isn ? *(const f32x4*)(nloc + (size_t)item * 128 + (q4 - 4096) * 4)
                    : *(const f32x4*)(kloc + (size_t)item * 16384 + q4 * 4);
        bl[u] = sc[item * 2];
        ml[u] = sc[item * 2 + 1];
      }
#pragma unroll
      for (int u = 0; u < 4; ++u) {
        int item = seq * 68 + j0 + u;
        if (isn) {
          *(f32x4*)(nin + (size_t)item * 128 + (q4 - 4096) * 4) = C;
          if (q4 == 4096) minp[item] = m;
        } else {
          bf16x4 o;
#pragma unroll
          for (int e = 0; e < 4; ++e) o[e] = (short)f2bf(C[e]);
          *(bf16x4*)(cin + (size_t)item * 16384 + q4 * 4) = o;
        }
        float mn = fmaxf(bl[u] + m, ml[u]);
        float dec = __expf(bl[u] + m - mn), wl = __expf(ml[u] - mn);
#pragma unroll
        for (int e = 0; e < 4; ++e) C[e] = dec * C[e] + wl * kv[u][e];
        m = mn;
      }
    }
  }
}

__device__ void phase_m3(const P& p, int l) {
  OPQ_IDS
  char* ws = opqp(p.ws);
  u16* Qs = (u16*)shm;
  u16* Ks = Qs + 64 * 136;
  u16* vT = Ks + 64 * 136;
  float* gs = (float*)(vT + 128 * 72);
  float* qn = gs + 528;
  float* ninl = qn + 128;
  float* hbuf = ninl + 256;
  const u16* qkc = (const u16*)(ws + O_QKC);
  const u16* proj = (const u16*)(ws + O_PROJ);
  const int wid = TIDX >> 6, lane = TIDX & 63, l15 = lane & 15, quad = lane >> 4;
  const bool need_ctx = l < 3;
  for (int it = BIDX; it < 16 * 68; it += gridDim.x) {
    int bh = it / 68, blk = it % 68, b = bh >> 2, h = bh & 3;
    if (!need_ctx && blk < 4) continue;
    int R0 = b * TPB + blk * 64;
    int itemd[2];
    itemd[0] = (bh * 2 + 0) * 68 + chunk_index(0, blk);
    itemd[1] = (bh * 2 + 1) * 68 + chunk_index(1, blk);
    bf16x8 lq[2], lk[2], lv[2];
#pragma unroll
    for (int i = 0; i < 2; ++i) {
      int c = TIDX + i * NTHR, s = c >> 4, part = c & 15;
      lq[i] = *(const bf16x8*)(qkc + (size_t)(R0 + s) * 1024 + h * 128 + part * 8);
      lk[i] = *(const bf16x8*)(qkc + (size_t)(R0 + s) * 1024 + 512 + h * 128 + part * 8);
      int c2s = c & 63, c2p = c >> 6;
      lv[i] = *(const bf16x8*)(proj + (size_t)(R0 + c2s) * NP + C_DV + h * 128 + c2p * 8);
    }
    float lnin = 0.f;
    if (TIDX < 256) lnin = ((const float*)(ws + O_NIN))[(size_t)itemd[TIDX >> 7] * 128 + (TIDX & 127)];
    const float m_in = ((const float*)(ws + O_MIN))[itemd[wid >> 2]];
    bf16x8 ldo[2], ldg[2];
    f32x4 lgn[4];
    {
      const int tt = TIDX >> 3, ch0 = h * 128 + (TIDX & 7) * 16;
      const u16* pr = proj + (size_t)(R0 + tt) * NP;
      ldo[0] = *(const bf16x8*)(pr + C_DO + ch0);
      ldo[1] = *(const bf16x8*)(pr + C_DO + ch0 + 8);
      ldg[0] = *(const bf16x8*)(pr + C_DG + ch0);
      ldg[1] = *(const bf16x8*)(pr + C_DG + ch0 + 8);
#pragma unroll
      for (int e4 = 0; e4 < 4; ++e4) lgn[e4] = *(const f32x4*)(p.ml_gnorm + l * 512 + ch0 + e4 * 4);
    }
    __syncthreads();
    mlstm_gates(p, b, h, blk, gs);
#pragma unroll
    for (int i = 0; i < 2; ++i) {
      int c = TIDX + i * NTHR, s = c >> 4, part = c & 15;
      *(bf16x8*)(Qs + s * 136 + part * 8) = lq[i];
      *(bf16x8*)(Ks + s * 136 + part * 8) = lk[i];
      int c2s = c & 63, c2p = c >> 6;
#pragma unroll
      for (int e = 0; e < 8; ++e) vT[(c2p * 8 + e) * 72 + c2s] = (u16)lv[i][e];
    }
    if (TIDX < 256) ninl[TIDX] = lnin;
    __syncthreads();
    {
      const int dr = TIDX >> 8, t = (TIDX >> 2) & 63, pq = TIDX & 3;
      float s = 0.f;
#pragma unroll 8
      for (int d = pq * 32; d < pq * 32 + 32; ++d) s += bf2f(Qs[t * 136 + d]) * ninl[dr * 128 + d];
      s += SHX(s, 1);
      s += SHX(s, 2);
      if (pq == 0) qn[dr * 64 + t] = s;
    }
    __syncthreads();
    {
      const int dir = wid >> 2, tt = wid & 3;
      const int t = tt * 16 + l15;
      const float* li = gs + dir * 64;
      const float* bc = gs + 256 + dir * 64;
      const float bct = bc[t];
      const float mt = fmaxf(bct + m_in, bct + gs[384 + dir * 64 + t]);
      bf16x8 qf[4];
#pragma unroll
      for (int ks = 0; ks < 4; ++ks) qf[ks] = *(const bf16x8*)(Qs + t * 136 + ks * 32 + quad * 8);
      f32x4 s[4];
#pragma unroll
      for (int st = 0; st < 4; ++st) s[st] = f32x4{0.f, 0.f, 0.f, 0.f};
#pragma unroll
      for (int ks = 0; ks < 4; ++ks)
#pragma unroll
        for (int st = 0; st < 4; ++st) {
          bf16x8 a = *(const bf16x8*)(Ks + (st * 16 + l15) * 136 + ks * 32 + quad * 8);
          s[st] = __builtin_amdgcn_mfma_f32_16x16x32_bf16(a, qf[ks], s[st], 0, 0, 0);
        }
      float dsum = 0.f;
      bf16x8 pf[2];
#pragma unroll
      for (int st = 0; st < 4; ++st)
#pragma unroll
        for (int j = 0; j < 4; ++j) {
          int sp = st * 16 + quad * 4 + j;
          bool valid = dir == 0 ? (sp <= t) : (sp >= t);
          float dm = bct - bc[sp] + li[sp] - mt;
          float v = valid ? s[st][j] * __expf(dm) : 0.f;
          dsum += v;
          pf[st >> 1][(st & 1) * 4 + j] = (short)f2bf(v);
        }
      dsum += SHX(dsum, 16);
      dsum += SHX(dsum, 32);
      f32x4 hi[8], hx[8];
#pragma unroll
      for (int e = 0; e < 8; ++e) { hi[e] = f32x4{0.f, 0.f, 0.f, 0.f}; hx[e] = f32x4{0.f, 0.f, 0.f, 0.f}; }
#pragma unroll
      for (int kk = 0; kk < 2; ++kk)
#pragma unroll
        for (int e = 0; e < 8; ++e) {
          const u16* vb = vT + (e * 16 + l15) * 72 + kk * 32 + quad * 4;
          bf16x4 v0 = *(const bf16x4*)vb, v1 = *(const bf16x4*)(vb + 16);
          bf16x8 va = {v0[0], v0[1], v0[2], v0[3], v1[0], v1[1], v1[2], v1[3]};
          hi[e] = __builtin_amdgcn_mfma_f32_16x16x32_bf16(va, pf[kk], hi[e], 0, 0, 0);
        }
      const u16* cin = (const u16*)(ws + O_CIN) + (size_t)itemd[dir] * 16384;
#pragma unroll
      for (int ks = 0; ks < 4; ++ks)
#pragma unroll
        for (int e = 0; e < 8; ++e) {
          bf16x8 ca = *(const bf16x8*)(cin + (e * 16 + l15) * 128 + ks * 32 + quad * 8);
          hx[e] = __builtin_amdgcn_mfma_f32_16x16x32_bf16(ca, qf[ks], hx[e], 0, 0, 0);
        }
      float a = __expf(bct + m_in - mt);
      float den = a * qn[dir * 64 + t] + dsum;
      float idn = 1.f / fmaxf(fabsf(den), __expf(-mt));
#pragma unroll
      for (int e = 0; e < 8; ++e)
#pragma unroll
        for (int j = 0; j < 4; ++j) hbuf[(dir * 64 + t) * 129 + e * 16 + quad * 4 + j] = (a * hx[e][j] + hi[e][j]) * idn;
    }
    __syncthreads();
    {
      int t = TIDX >> 3, part = TIDX & 7;
      float hv[16], ss = 0.f;
#pragma unroll
      for (int e = 0; e < 16; ++e) {
        hv[e] = hbuf[t * 129 + part * 16 + e] + hbuf[(64 + t) * 129 + part * 16 + e];
        ss += hv[e] * hv[e];
      }
      ss += SHX(ss, 1);
      ss += SHX(ss, 2);
      ss += SHX(ss, 4);
      float rs = rsqrtf(ss * (1.f / 128.f) + EPS);
      int r = R0 + t;
      const u16* pr = proj + (size_t)r * NP;
      u16* ys = (u16*)(ws + O_YS) + (size_t)r * 2048 + 1536 + h * 128 + part * 16;
      const int ch0 = h * 128 + part * 16;
      float dox[16], dgx[16], gn[16];
#pragma unroll
      for (int e = 0; e < 8; ++e) {
        dox[e] = bfs(ldo[0][e]); dox[8 + e] = bfs(ldo[1][e]);
        dgx[e] = bfs(ldg[0][e]); dgx[8 + e] = bfs(ldg[1][e]);
      }
#pragma unroll
      for (int e4 = 0; e4 < 4; ++e4)
#pragma unroll
        for (int e = 0; e < 4; ++e) gn[e4 * 4 + e] = lgn[e4][e];
      float yo[16];
#pragma unroll
      for (int e = 0; e < 16; ++e) {
        float y = hv[e] * rs * gn[e] * sigm_f(dox[e]);
        yo[e] = bf2f(f2bf(y)) * silu_f(dgx[e]);
      }
      st8(ys, yo);
      st8(ys + 8, yo + 8);
    }
  }
}

__device__ void gemm_step(const P& p, int step, int l) {
  OPQ_IDS
  char* ws = opqp(p.ws);
  const int nM = NTOK / 256;
  const bool need_ctx = l < 3;
  int ntiles;
  const int nbr = 1;
  if (step == 1) ntiles = nM * (NP / BNT);
  else if (step == 3) ntiles = nM * (2304 / BNT);
  else if (step == 6) ntiles = 4 * nM * (2048 / BNT);
  else if (step == 7) ntiles = nM * 32;
  else ntiles = nM * (2048 / BNT);
  for (int t0 = BIDX; t0 < (ntiles + 255) / 256 * 256; t0 += gridDim.x) {
    const int t = xcd_remap(t0, BIDX, gridDim.x);
    if (t >= ntiles) continue;
    for (int br = 0; br < nbr; ++br) {
      const u16 *A, *Bt;
      int lda, ldb, K, pm, pn, mode, aux = 0, bmode = 0, ncol = BNT;
      if (step == 1) {
        tile_map(t, nM, NP / BNT, pm, pn);
        A = (const u16*)(ws + O_HN); lda = 2048; Bt = (const u16*)(ws + O_WIN); ldb = 2048; K = 2048; mode = M_G1A;
      } else if (step == 3) {
        const int c2 = 768 / BNT, c3 = 1024 / BNT, c4 = 512 / BNT; const int n2 = nM * c2, n3 = nM * c3;
        K = 512; ldb = 512;
        if (t < n2) {
          pm = t / c2; pn = t % c2; A = (const u16*)(ws + O_PROJ) + C_CQ; lda = NP; Bt = (const u16*)(ws + O_WUQ); mode = M_G2;
        } else if (t < n2 + n3) {
          int tt = t - n2; pm = tt / c3; pn = tt % c3; A = (const u16*)(ws + O_PROJ) + C_CKV; lda = NP; Bt = (const u16*)(ws + O_WUKV); mode = M_G3;
        } else {
          int tt = t - n2 - n3; pm = tt / c4; pn = tt % c4; A = (const u16*)(ws + O_DPOOL); lda = 512; Bt = (const u16*)(ws + O_POOL); mode = M_POOL;
        }
      } else if (step == 6) {
        aux = t / (nM * (2048 / BNT));
        tile_map(t % (nM * (2048 / BNT)), nM, 2048 / BNT, pm, pn);
        A = (const u16*)(ws + O_YS) + aux * 512; lda = 2048; Bt = (const u16*)(ws + O_WBR) + (size_t)aux * 2048 * 512; ldb = 512; K = 512; mode = M_G4;
      } else if (step == 7) {
        tile_map(t, nM, 32, pm, pn);
        A = (const u16*)(ws + O_HN); lda = 2048;
        Bt = (l & 1) ? (const u16*)(ws + O_WINM1) : (const u16*)(ws + O_WIN) + (size_t)C_MG * 2048;
        ldb = 2048; K = 2048; mode = M_G1B; bmode = 1; ncol = 64;
      } else {
        tile_map(t, nM, 2048 / BNT, pm, pn);
        A = (const u16*)(ws + O_ACC); lda = 2048; Bt = (const u16*)(ws + O_WOUT); ldb = 2048; K = 2048; mode = M_G5;
      }
      if (step >= 6 && !need_ctx && (pm % 17) == 0) continue;
      gemm256(p, A, lda, Bt, ldb, K, pm * 256, pn * ncol, mode, aux, l, bmode);
    }
  }
}


#define XB_TMO      128
#define XB_XCNT(j)  (256  + 64 * (j))
#define XB_XSUB(j)  (1280 + 64 * (j))
#define XB_XGEN(j)  (2304 + 64 * (j))
#define XB_TOP      3328
#define XB_TOPGEN   3392
#define XCD_BAR_WORDS 3456
#define XB_SPIN_CAP (1u << 18)
#define LAS __attribute__((address_space(3)))
DEVI unsigned xb_ld(unsigned* p) { return __hip_atomic_load(p, __ATOMIC_RELAXED, __HIP_MEMORY_SCOPE_AGENT); }
DEVI unsigned xb_add(unsigned* p, unsigned v) { return __hip_atomic_fetch_add(p, v, __ATOMIC_RELAXED, __HIP_MEMORY_SCOPE_AGENT); }
DEVI unsigned xb_xcc_id() { return (unsigned)__builtin_amdgcn_s_getreg((3 << 11) | 20) & 0xFu; }
#define XB_SPIN(cond, bar) do { unsigned _sp = 0; while (cond) { __builtin_amdgcn_s_sleep(1); \
    if ((++_sp & 255u) == 0u) { if (xb_ld(&(bar)[XB_TMO])) break; if (_sp > XB_SPIN_CAP) { atomicAdd(&(bar)[XB_TMO], 1u); break; } } } } while (0)
struct XcdBarrier { unsigned* bar; unsigned x; volatile LAS unsigned* st; };
DEVI XcdBarrier xcd_barrier_post(unsigned* bar, volatile LAS unsigned* st) {
  XcdBarrier b; b.bar = bar; b.x = xb_xcc_id(); b.st = st;
  if (threadIdx.x == 0) (void)xb_add(&bar[XB_XCNT(b.x)], 1u);
  return b;
}
DEVI void xcd_barrier_complete(unsigned* bar, unsigned x, unsigned& nloc, unsigned& nx) {
  const unsigned G = gridDim.x * gridDim.y * gridDim.z;
  unsigned sum, cnt, mine, sp = 0u;
  for (;;) {
    sum = 0u; cnt = 0u; mine = 0u;
#pragma unroll
    for (unsigned j = 0; j < 16; ++j) { const unsigned c = xb_ld(&bar[XB_XCNT(j)]); sum += c; cnt += (c > 0u) ? 1u : 0u; mine = (j == x) ? c : mine; }
    if (sum == G) break;
    __builtin_amdgcn_s_sleep(1);
    if ((++sp & 255u) == 0u) { if (xb_ld(&bar[XB_TMO])) break; if (sp > XB_SPIN_CAP) { atomicAdd(&bar[XB_TMO], 1u); break; } }
  }
  nloc = mine > 0u ? mine : 1u; nx = cnt > 0u ? cnt : 1u;
}
DEVI void xcd_barrier(const XcdBarrier& b) {
  asm volatile("s_waitcnt vmcnt(0)" ::: "memory");
  __syncthreads();
  if (threadIdx.x == 0) {
    unsigned* bar = b.bar;
    __builtin_amdgcn_s_waitcnt(0);
    unsigned nloc = b.st[0], nx = b.st[1];
    if (nloc == 0u) { xcd_barrier_complete(bar, b.x, nloc, nx); b.st[0] = nloc; b.st[1] = nx; }
    const unsigned old = xb_add(&bar[XB_XSUB(b.x)], 1u);
    const unsigned gen = old / nloc;
    if (old + 1u == (gen + 1u) * nloc) {
      __builtin_amdgcn_fence(__ATOMIC_RELEASE, "agent");
      asm volatile("s_waitcnt vmcnt(0)" ::: "memory");
      const unsigned og = xb_add(&bar[XB_TOP], 1u);
      const unsigned tg = og / nx;
      if (og + 1u == (tg + 1u) * nx) xb_add(&bar[XB_TOPGEN], 1u);
      else XB_SPIN(xb_ld(&bar[XB_TOPGEN]) == tg, bar);
      __builtin_amdgcn_fence(__ATOMIC_ACQUIRE, "agent");
      xb_add(&bar[XB_XGEN(b.x)], 1u);
      asm volatile("s_waitcnt vmcnt(0)" ::: "memory");
    } else {
      XB_SPIN(xb_ld(&bar[XB_XGEN(b.x)]) == gen, bar);
      __builtin_amdgcn_fence(__ATOMIC_ACQUIRE, "agent");
      asm volatile("s_waitcnt vmcnt(0)" ::: "memory");
    }
  }
  __syncthreads();
}

__global__ void __launch_bounds__(NTHR) mega(P p) {
  cg::grid_group grid = cg::this_grid();
  __shared__ uint4 xb_words;
  unsigned* bar = (unsigned*)(p.ws + O_BAR);
  if (threadIdx.x == 0) xb_words = make_uint4(0u, 0u, 0u, 0u);
  if (blockIdx.x == 0) {
    for (int i = threadIdx.x; i < 4096; i += NTHR) bar[i] = 0u;
  }
  __syncthreads();
  if (PHM & 1) phase_mod_partial(p);
  grid.sync();
  XcdBarrier xb = xcd_barrier_post(bar, (volatile LAS unsigned*)&xb_words);
  if (PHM & 1) phase_mod_reduce(p);
  grid.sync();
  for (int ls2 = 0; ls2 < 36 * 2; ++ls2) {
    const int ls = ls2 >> 1;
    const int l = ls / 9, step = ls % 9;
    if ((ls2 & 1) && !((PROBE_DUP >> step) & 1)) continue;
    if (step == 0) { if (PHM & 4) phase_norm(p, l); }
    if (step == 2) { if (PHM & 8) phase_p2(p, l); }
    if (step == 1 || step == 3 || step >= 6) gemm_step(p, step, l);
    {
      const int bid = blockIdx.x, nb = gridDim.x;
      int wl = -1, wmode = 0, rank = bid, count = nb, mod = 1, lo = 0, width = 1, sub_lo = 0, sub_hi = 0;
      if (!(ls2 & 1)) {
        if (step == 0) { wl = l; wmode = (l == 0) ? 0 : 2; }
        else if ((step == 1 || step == 3 || step == 6) && l < 3 && nb == 256) {
          const int ntl = (step == 1) ? 68 * 29 : (step == 3) ? 68 * 9 : 4 * 68 * 8;
          const int rem = ntl - ((ntl + 255) / 256 - 1) * 256;
          const int pos = (bid & 7) * 32 + (bid >> 3);
          if (pos >= rem) {
            wl = l + 1; wmode = 3; rank = pos - rem; count = 256 - rem;
            sub_lo = (step == 1) ? 0 : (step == 3) ? 1660 : 3000;
            sub_hi = (step == 1) ? 1660 : (step == 3) ? 3000 : 4096;
          }
        }
        else if (step == 7 && l < 3) {
          wl = l + 1; wmode = (nb == 256) ? 1 : 4;
          if (nb == 256) {
            count = 128; mod = 5;
            if ((bid & 7) >= 4) { rank = (bid >> 3) * 4 + (bid & 7) - 4; lo = 4; width = 1; }
            else wl = -1;
          }
        } else if (step == 8 && l < 3 && nb == 256 && (bid & 7) != 0) {
          wl = l + 1; wmode = 1; rank = (bid >> 3) * 7 + (bid & 7) - 1; count = 224; mod = 5; lo = 0; width = 4;
        }
      }
      if (wl >= 0 && (PHM & 2)) phase_wprep(p, wl, wmode, rank, count, mod, lo, width, sub_lo, sub_hi);
    }
    if (step == 3) { if (PHM & 16) phase_m1(p); }
    if (step == 4) {
      if (PHM & 32) phase_m2(p);
      if (PHM & 64) phase_attn(p, l);
    }
    if (step == 5) { if (PHM & 128) phase_m3(p, l); }
    xcd_barrier(xb);
  }
  if (PHM & 4) phase_final(p);
}

extern "C" void kernel_launch(void* const* d_in, const int* in_sizes, int n_in, void* d_out, int out_size, void* d_ws,
                              size_t ws_size, hipStream_t stream) {
  static int grid_blocks = 0;
  if (!grid_blocks) {
    int dev = 0, cus = 0, per_cu = 0;
    hipGetDevice(&dev);
    hipDeviceGetAttribute(&cus, hipDeviceAttributeMultiprocessorCount, dev);
    hipFuncSetAttribute((const void*)mega, hipFuncAttributeMaxDynamicSharedMemorySize, SHM_BYTES);
    hipOccupancyMaxActiveBlocksPerMultiprocessor(&per_cu, mega, NTHR, SHM_BYTES);
    if (per_cu < 1) per_cu = 1;
    grid_blocks = cus * per_cu;
  }
  P p{};
  const float** pp = (const float**)&p;
  for (int i = 0; i < 21; ++i) pp[i] = (const float*)d_in[i];
  p.out = (float*)d_out;
  p.ws = (char*)d_ws;
  if (ws_size < O_TOTAL) fprintf(stderr, "workspace too small: %zu < %zu\n", ws_size, (size_t)O_TOTAL);
  void* args[] = {&p};
  hipError_t e = hipLaunchCooperativeKernel((void*)mega, dim3(grid_blocks), dim3(NTHR), args, SHM_BYTES, stream);
  if (e != hipSuccess) fprintf(stderr, "cooperative launch failed: %s (grid %d)\n", hipGetErrorString(e), grid_blocks);
}
```

```cpp
#include <hip/hip_runtime.h>
#include <hip/hip_bf16.h>
#include <hip/hip_cooperative_groups.h>
#include <cstdio>
namespace cg = cooperative_groups;

typedef unsigned short u16;
using bf16x8 = __attribute__((ext_vector_type(8))) short;
using bf16x4 = __attribute__((ext_vector_type(4))) short;
using f32x4 = __attribute__((ext_vector_type(4))) float;
typedef unsigned u32x4 __attribute__((ext_vector_type(4)));
#define DEVI __device__ __forceinline__

constexpr int D = 2048, NBATCH = 4, SEQ = 4096, CTXL = 256, TPB = 4352, NTOK = 17408, DIN = 15440, NP = 7424;
constexpr int C_AQ = 0, C_AK = 512, C_AV = 1024, C_AG = 1536, C_BI = 2048, C_BG = 2560, C_CQ = 3072, C_CKV = 3584,
              C_CKR = 4096, C_CG = 4160, C_DQ = 4672, C_DK = 5184, C_DV = 5696, C_DO = 6208, C_DIF = 6720,
              C_DG = 6736, C_MG = 7248;
constexpr float EPS = 1e-6f;
constexpr int NTHR = 512;
#ifndef PROBE_ZB
#define PROBE_ZB (-1)
#endif
#ifndef PROBE_US
#define PROBE_US 1.f
#endif
#ifndef G8
#define G8 1
#endif
#define BNT (G8 ? 256 : 128)
#ifndef PROBE_DUP
#define PROBE_DUP 0
#endif
#ifndef PHM
#define PHM 0xFFFF
#endif
constexpr int SHM_BYTES = 131072;

constexpr size_t al(size_t x) { return (x + 255) & ~size_t(255); }
constexpr size_t O_WIN = 0;
constexpr size_t O_WBR = O_WIN + al((size_t)DIN * 2048 * 2);
constexpr size_t O_WOUT = O_WBR + al((size_t)4 * 2048 * 512 * 2);
constexpr size_t O_WUQ = O_WOUT + al((size_t)2048 * 2048 * 2);
constexpr size_t O_WUKV = O_WUQ + al((size_t)768 * 512 * 2);
constexpr size_t O_POOL = O_WUKV + al((size_t)1024 * 512 * 2);
constexpr size_t O_MODP = O_POOL + al((size_t)512 * 512 * 2);
constexpr size_t O_MOD = O_MODP + al((size_t)4 * 16 * 5 * 6144 * 4);
constexpr size_t O_ROPE = O_MOD + al((size_t)4 * 5 * 6144 * 4);
constexpr size_t O_XC = O_ROPE + al(64 * 16 * 8);
constexpr size_t O_HN = O_XC + al((size_t)1024 * 2048 * 4);
constexpr size_t O_PROJ = O_HN + al((size_t)NTOK * 2048 * 2);
constexpr size_t O_QH = O_PROJ + al((size_t)NTOK * NP * 2);
constexpr size_t O_KH = O_QH + al((size_t)NTOK * 768 * 2);
constexpr size_t O_VTC = O_KH + al((size_t)NTOK * 768 * 2);
constexpr size_t O_END1 = O_VTC + al((size_t)NTOK * 512 * 2);
constexpr size_t O_YBR = O_PROJ;
static_assert((size_t)NTOK * 8192 * 2 <= O_END1 - O_PROJ, "ybr alias");
constexpr size_t O_VTA = O_END1;
constexpr size_t O_DPOOL = O_VTA + al((size_t)NTOK * 512 * 2);
constexpr size_t O_QKC = O_DPOOL + al((size_t)NTOK * 512 * 2);
constexpr size_t O_GL = O_QKC + al((size_t)NTOK * 1024 * 2);
constexpr size_t O_RINV = O_GL + al((size_t)NTOK * 16 * 4);
constexpr size_t O_YS = O_RINV + al((size_t)NTOK * 2 * 4);
constexpr size_t O_ACC = O_YS + al((size_t)NTOK * 2048 * 2);
constexpr int NITEM = 32 * 68;
constexpr size_t O_KLOC = O_ACC + al((size_t)NTOK * 2048 * 2);
constexpr size_t O_NLOC = O_KLOC + al((size_t)NITEM * 16384 * 4);
constexpr size_t O_SC = O_NLOC + al((size_t)NITEM * 128 * 4);
constexpr size_t O_CIN = O_SC + al((size_t)NITEM * 2 * 4);
constexpr size_t O_NIN = O_CIN + al((size_t)NITEM * 16384 * 2);
constexpr size_t O_MIN = O_NIN + al((size_t)NITEM * 128 * 4);
constexpr size_t O_WINM1 = O_MIN + al((size_t)NITEM * 4);
constexpr size_t O_BAR = O_WINM1 + al((size_t)8192 * 2048 * 2);
constexpr size_t O_TOTAL = O_BAR + al(4096 * 4);
static_assert(O_TOTAL < 1000000000ull, "workspace budget");

struct P {
  const float *x, *c, *ctx, *c_ctx, *norm_g, *w_mod, *b_mod, *w_in, *na_rpb, *pool_w, *pool_scale, *mla_gq, *mla_gkv,
      *w_uq, *w_ukv, *conv_w, *b_if, *ml_gnorm, *w_br, *w_out, *g_final;
  float* out;
  char* ws;
};

extern __shared__ __attribute__((aligned(16))) char shm[];

DEVI u16 f2bf(float f) {
  unsigned u = __float_as_uint(f);
  u += 0x7fffu + ((u >> 16) & 1u);
  return (u16)(u >> 16);
}
typedef __bf16 bf2_t __attribute__((ext_vector_type(2)));
typedef float fl2_t __attribute__((ext_vector_type(2)));
DEVI unsigned pk2(float a, float b) {
  fl2_t v = {a, b};
  bf2_t r = __builtin_convertvector(v, bf2_t);
  return *(unsigned*)&r;
}
DEVI float bf2f(u16 h) { return __uint_as_float(((unsigned)h) << 16); }
DEVI float bfs(short h) { return __uint_as_float(((unsigned)(u16)h) << 16); }
DEVI float silu_f(float x) { return x / (1.f + __expf(-x)); }
DEVI float sigm_f(float x) { return 1.f / (1.f + __expf(-x)); }
DEVI int opqv(int x) { asm volatile("" : "+v"(x)); return x; }
DEVI int opqs(int x) { asm volatile("" : "+s"(x)); return x; }
DEVI size_t opqz() { size_t z = 0; asm volatile("" : "+s"(z)); return z; }
#define opqp(x) ((x) + opqz())
#define SHX(v, m) __int_as_float(__builtin_amdgcn_ds_bpermute(((LANE ^ (m)) << 2), __float_as_int(v)))
#define LDS_BAR() do { asm volatile("s_waitcnt lgkmcnt(0)" ::: "memory"); __builtin_amdgcn_s_barrier(); asm volatile("" ::: "memory"); } while (0)
#define OPQ_IDS const int TIDX = opqv((int)threadIdx.x); const int BIDX = opqs((int)blockIdx.x); const int LANE = TIDX & 63; (void)TIDX; (void)BIDX; (void)LANE;
#define wave_sum(v) wave_sum_l((v), LANE)
DEVI float wave_sum_l(float v, int LANE) {
#pragma unroll
  for (int o = 32; o > 0; o >>= 1) v += SHX(v, o);
  return v;
}

DEVI void ld8(const u16* ptr, float* f) {
  bf16x8 v = *(const bf16x8*)ptr;
#pragma unroll
  for (int i = 0; i < 8; ++i) f[i] = bfs(v[i]);
}
DEVI void st8(u16* ptr, const float* f) {
  bf16x8 v;
#pragma unroll
  for (int i = 0; i < 8; ++i) v[i] = (short)f2bf(f[i]);
  *(bf16x8*)ptr = v;
}
constexpr int BM = 256, BK = 64, HALF = 128, HT = HALF * BK;

DEVI int lds_byte(int r, int c) {
  int st = (r >> 4) * 2 + (c >> 5), rr = r & 15, cc = c & 31, ob = rr * 64 + cc * 2;
  return st * 1024 + (ob ^ (((ob >> 9) & 1) << 5));
}
DEVI void stage_rc(int b, int& R, int& C) {
  int st = b / 1024, sb = b % 1024, swz = sb ^ (((sb >> 9) & 1) << 5);
  R = (st >> 1) * 16 + swz / 64;
  C = (st & 1) * 32 + (swz % 64) / 2;
}

enum { M_G1A = 0, M_G2, M_G3, M_POOL, M_G4, M_G1B, M_G5 };

DEVI void gemm256(const P& p, const u16* A, int lda, const u16* Bt, int ldb, int K, int brow, int bcol, int mode,
                        int aux, int layer, int bmode) {
  OPQ_IDS
  if (!(PHM & 256)) return;
  u16* shmb = (u16*)shm;
#define SA(b, h) (shmb + ((b)*2 + (h)) * HT)
#if G8
#define SB(b, h) (shmb + (4 + (b)*2 + (h)) * HT)
#else
#define SB(b, h) (shmb + (4 + (b)) * HT)
#endif
#define LDSP(x) ((__attribute__((address_space(3))) void*)(x))
#define STAGEA(Pp, br, kt)                                                                                     \
  do {                                                                                                         \
    const int _so = ((br) * lda + (kt)*BK) * 2;                                                                \
    __builtin_amdgcn_raw_ptr_buffer_load_lds(rsA, LDSP((char*)(Pp) + TIDX * 16), 16, offA0, _so, 0, 0);       \
    __builtin_amdgcn_raw_ptr_buffer_load_lds(rsA, LDSP((char*)(Pp) + TIDX * 16 + 8192), 16, offA1, _so, 0, 0);\
  } while (0)
#define STAGEB(Pp, br, kt)                                                                                     \
  do {                                                                                                         \
    const int _so = ((br) * ldb + (kt)*BK) * 2;                                                                \
    __builtin_amdgcn_raw_ptr_buffer_load_lds(rsB, LDSP((char*)(Pp) + TIDX * 16), 16, offB0, _so, 0, 0);       \
    __builtin_amdgcn_raw_ptr_buffer_load_lds(rsB, LDSP((char*)(Pp) + TIDX * 16 + 8192), 16, offB1, _so, 0, 0);\
  } while (0)
#define LDA(dst, b, h)                                                                                         \
  for (int m = 0; m < 4; ++m)                                                                                  \
    for (int k = 0; k < 2; ++k)                                                                                \
  dst[m][k] = *reinterpret_cast<const bf16x8*>((char*)SA(b, h) + lds_byte(wr * 64 + m * 16 + fr, k * 32 + fq * 8))
#define LDB(dst, b, h)                                                                                         \
  for (int n = 0; n < 2; ++n)                                                                                  \
    for (int k = 0; k < 2; ++k)                                                                                \
  dst[n][k] = *reinterpret_cast<const bf16x8*>((char*)SB(b, h) + lds_byte(wc * 32 + n * 16 + fr, k * 32 + fq * 8))
#define MMA(ai, bj, At, Btf)                                                                                   \
  do {                                                                                                         \
    __builtin_amdgcn_s_setprio(1);                                                                             \
    for (int m = 0; m < 4; ++m)                                                                                \
      for (int n = 0; n < 2; ++n)                                                                              \
        for (int k = 0; k < 2; ++k)                                                                            \
          acc[ai][bj][m][n] = __builtin_amdgcn_mfma_f32_16x16x32_bf16(Btf[n][k], At[m][k], acc[ai][bj][m][n], 0, 0, 0); \
    __builtin_amdgcn_s_setprio(0);                                                                             \
  } while (0)
#define WAIT_V(n) asm volatile("s_waitcnt vmcnt(" #n ")" ::: "memory")
#define WAIT_L(n) asm volatile("s_waitcnt lgkmcnt(" #n ")" ::: "memory")
#define BAR __builtin_amdgcn_s_barrier()
#define SCHED __builtin_amdgcn_sched_barrier(0)

  int wid = TIDX >> 6, lane = TIDX & 63, wr = wid >> 2, wc = wid & 3, fr = lane & 15, fq = lane >> 4;
#if G8
  f32x4 acc[2][2][4][2] = {};
  bf16x8 At[4][2], B0[2][2], B1[2][2];
#else
  f32x4 acc[2][1][4][2] = {};
  bf16x8 At[4][2], B0[2][2];
#endif
  int nt = K / BK;
  const int bhalf = bmode ? 4096 : HALF;
  int offA0, offA1, offB0, offB1;
  __amdgpu_buffer_rsrc_t rsA = __builtin_amdgcn_make_buffer_rsrc((void*)A, 0, 0x7fffffff, 0x00020000);
  __amdgpu_buffer_rsrc_t rsB = __builtin_amdgcn_make_buffer_rsrc((void*)Bt, 0, 0x7fffffff, 0x00020000);
  {
    int r0, c0, r1, c1;
    stage_rc(TIDX * 16, r0, c0);
    stage_rc(TIDX * 16 + 8192, r1, c1);
    offA0 = (r0 * lda + c0) * 2; offA1 = (r1 * lda + c1) * 2;
    offB0 = (r0 * ldb + c0) * 2; offB1 = bmode ? offB0 + 2048 * ldb * 2 : (r1 * ldb + c1) * 2;
  }
#if G8
  STAGEB(SB(0, 0), bcol, 0);
  STAGEA(SA(0, 0), brow, 0);
  STAGEB(SB(0, 1), bcol + bhalf, 0);
  STAGEA(SA(0, 1), brow + HALF, 0);
  if (wr == 1) BAR;
  WAIT_V(4);
  BAR;
  STAGEB(SB(1, 0), bcol, 1);
  STAGEA(SA(1, 0), brow, 1);
  STAGEB(SB(1, 1), bcol + bhalf, 1);
  WAIT_V(6);
  BAR;
  for (int t = 0; t < nt - 2; t += 2) {
    LDB(B0, 0, 0); SCHED; LDA(At, 0, 0); STAGEA(SA(1, 1), brow + HALF, t + 1);
    WAIT_L(8); BAR; WAIT_L(0); MMA(0, 0, At, B0); BAR; SCHED;
    LDB(B1, 0, 1); STAGEB(SB(0, 0), bcol, t + 2);
    BAR; WAIT_L(0); MMA(0, 1, At, B1); BAR;
    LDA(At, 0, 1); STAGEA(SA(0, 0), brow, t + 2);
    BAR; WAIT_L(0); MMA(1, 0, At, B0); BAR; SCHED;
    STAGEB(SB(0, 1), bcol + bhalf, t + 2);
    WAIT_V(6); BAR; MMA(1, 1, At, B1); BAR;
    LDB(B0, 1, 0); SCHED; LDA(At, 1, 0); STAGEA(SA(0, 1), brow + HALF, t + 2);
    WAIT_L(8); BAR; WAIT_L(0); MMA(0, 0, At, B0); BAR; SCHED;
    LDB(B1, 1, 1); STAGEB(SB(1, 0), bcol, t + 3);
    BAR; WAIT_L(0); MMA(0, 1, At, B1); BAR;
    LDA(At, 1, 1); STAGEA(SA(1, 0), brow, t + 3);
    BAR; WAIT_L(0); MMA(1, 0, At, B0); BAR; SCHED;
    STAGEB(SB(1, 1), bcol + bhalf, t + 3);
    WAIT_V(6); BAR; MMA(1, 1, At, B1); BAR;
  }
  {
    LDB(B0, 0, 0); LDA(At, 0, 0); STAGEA(SA(1, 1), brow + HALF, nt - 1);
    BAR; WAIT_L(0); MMA(0, 0, At, B0); BAR;
    LDB(B1, 0, 1); BAR; WAIT_L(0); MMA(0, 1, At, B1); BAR;
    LDA(At, 0, 1); WAIT_V(4); BAR; WAIT_L(0); MMA(1, 0, At, B0); MMA(1, 1, At, B1); BAR;
  }
  {
    LDB(B0, 1, 0); LDA(At, 1, 0); WAIT_V(2); BAR; WAIT_L(0); MMA(0, 0, At, B0); BAR;
    LDB(B1, 1, 1); WAIT_V(0); BAR; WAIT_L(0); MMA(0, 1, At, B1); BAR;
    LDA(At, 1, 1); BAR; WAIT_L(0); MMA(1, 0, At, B0); MMA(1, 1, At, B1); BAR;
  }
  if (wr == 0) BAR;
#else
  STAGEB(SB(0, 0), bcol, 0);
  STAGEA(SA(0, 0), brow, 0);
  STAGEA(SA(0, 1), brow + HALF, 0);
  WAIT_V(0);
  BAR;
  for (int t = 0; t < nt; t += 2) {
    STAGEB(SB(1, 0), bcol, t + 1);
    STAGEA(SA(1, 0), brow, t + 1);
    STAGEA(SA(1, 1), brow + HALF, t + 1);
    LDB(B0, 0, 0); LDA(At, 0, 0); WAIT_L(0); MMA(0, 0, At, B0);
    LDA(At, 0, 1); WAIT_L(0); MMA(1, 0, At, B0);
    WAIT_V(0);
    BAR;
    if (t + 2 < nt) {
      STAGEB(SB(0, 0), bcol, t + 2);
      STAGEA(SA(0, 0), brow, t + 2);
      STAGEA(SA(0, 1), brow + HALF, t + 2);
    }
    LDB(B0, 1, 0); LDA(At, 1, 0); WAIT_L(0); MMA(0, 0, At, B0);
    LDA(At, 1, 1); WAIT_L(0); MMA(1, 0, At, B0);
    WAIT_V(0);
    BAR;
  }
#endif
  char* ws = opqp(p.ws);
  const int bb = brow / TPB;
  const int trow = brow - bb * TPB;
  u16* stg = (u16*)shm;
  const int tid = TIDX;
#define SWZ(r, c) ((c) ^ ((r)&15) ^ (((c)&1) << 4))
#pragma unroll
  for (int ai = 0; ai < 2; ++ai)
#pragma unroll
    for (int bj = 0; bj < (G8 ? 2 : 1); ++bj)
#pragma unroll
      for (int m = 0; m < 4; ++m)
#pragma unroll
        for (int n = 0; n < 2; ++n) {
          const int R = ai * HALF + wr * 64 + m * 16 + fr;
          const int chunk = bj * 16 + wc * 4 + n * 2 + (fq >> 1);
          f32x4 v = acc[ai][bj][m][n];
          uint2 pk = make_uint2(pk2(v[0], v[1]), pk2(v[2], v[3]));
          *(uint2*)(stg + R * 256 + SWZ(R, chunk) * 8 + (fq & 1) * 4) = pk;
        }
  LDS_BAR();
  if (mode == M_G1B) {
#pragma unroll 1
    for (int it = 0; it < 4; ++it) {
      const int R = it * 64 + (tid >> 3), co = tid & 7;
      const int row = brow + R, ocol = bcol + co * 8;
      float sum[8] = {0, 0, 0, 0, 0, 0, 0, 0};
#pragma unroll
      for (int br = 0; br < 4; ++br) {
        const int c = br * 8 + co;
        bf16x8 g = *(const bf16x8*)(stg + R * 256 + SWZ(R, c) * 8);
        float yb[8];
        ld8((const u16*)(ws + O_YBR) + (size_t)row * 8192 + br * 2048 + ocol, yb);
#pragma unroll
        for (int e = 0; e < 8; ++e) sum[e] += (br == PROBE_ZB) ? 0.f : sigm_f(bfs(g[e])) * yb[e];
      }
      st8((u16*)(ws + O_ACC) + (size_t)row * 2048 + ocol, sum);
    }
  } else {
    bool tr0 = false, tr1 = false;
    if (mode == M_G1A) { tr0 = bcol >= C_AV && bcol < C_AG; tr1 = bcol + HALF >= C_AV && bcol + HALF < C_AG; }
    else if (mode == M_G3) { tr1 = true; }
#pragma unroll 4
    for (int it = 0; it < 16; ++it) {
      const int R = it * 16 + (tid >> 5), c = tid & 31;
      if ((c < 16) ? tr0 : tr1) continue;
      const int row = brow + R, col = bcol + c * 8;
      bf16x8 raw = *(const bf16x8*)(stg + R * 256 + SWZ(R, c) * 8);
      if (mode == M_G1A) {
        *(bf16x8*)((u16*)(ws + O_PROJ) + (size_t)row * NP + col) = raw;
      } else if (mode == M_G4) {
        *(bf16x8*)((u16*)(ws + O_YBR) + (size_t)row * 8192 + aux * 2048 + col) = raw;
      } else {
        float v[8];
#pragma unroll
        for (int e = 0; e < 8; ++e) v[e] = bfs(raw[e]);
        if (mode == M_G2) {
          float rs = ((const float*)(ws + O_RINV))[row * 2];
#pragma unroll
          for (int e = 0; e < 8; ++e) v[e] *= rs;
          st8((u16*)(ws + O_QH) + (size_t)row * 768 + col, v);
        } else if (mode == M_G3) {
          float rs = ((const float*)(ws + O_RINV))[row * 2 + 1];
#pragma unroll
          for (int e = 0; e < 8; ++e) v[e] *= rs;
          st8((u16*)(ws + O_KH) + ((size_t)(bb * 4 + (col >> 8)) * TPB + (trow + R)) * 192 + (col & 255), v);
        } else if (mode == M_POOL) {
          float g[8];
          ld8((const u16*)(ws + O_PROJ) + (size_t)row * NP + C_BG + col, g);
#pragma unroll
          for (int e = 0; e < 8; ++e) {
            float y = bf2f(f2bf(v[e] * p.pool_scale[layer * 512 + col + e]));
            v[e] = y * silu_f(g[e]);
          }
          st8((u16*)(ws + O_YS) + (size_t)row * 2048 + 512 + col, v);
        } else {
          float* xb;
          const float* gv;
          const float* xs;
          if (trow == 0) {
            xb = (float*)(ws + O_XC) + ((size_t)bb * CTXL + R) * D + col;
            xs = (layer == 0) ? p.ctx + ((size_t)bb * CTXL + R) * D + col : xb;
            gv = (const float*)(ws + O_MOD) + ((size_t)layer * 5 + 4) * 6144 + 4096 + col;
          } else {
            xb = p.out + ((size_t)bb * SEQ + (trow - CTXL) + R) * D + col;
            xs = (layer == 0) ? p.x + ((size_t)bb * SEQ + (trow - CTXL) + R) * D + col : xb;
            gv = (const float*)(ws + O_MOD) + ((size_t)layer * 5 + bb) * 6144 + 4096 + col;
          }
          f32x4 x0 = *(const f32x4*)xs, x1 = *(const f32x4*)(xs + 4);
          f32x4 g0 = *(const f32x4*)gv, g1 = *(const f32x4*)(gv + 4);
#pragma unroll
          for (int e = 0; e < 4; ++e) { x0[e] += PROBE_US * g0[e] * v[e]; x1[e] += PROBE_US * g1[e] * v[4 + e]; }
          *(f32x4*)xb = x0;
          *(f32x4*)(xb + 4) = x1;
        }
      }
    }
#pragma unroll 1
    for (int hj = 0; hj < 2; ++hj) {
      if (!(hj ? tr1 : tr0)) continue;
      const int gc = bcol + hj * HALF;
      u16* tdst;
      if (mode == M_G1A) tdst = (u16*)(ws + O_VTA) + ((size_t)(bb * 512 + (gc - C_AV))) * TPB + trow;
      else tdst = (u16*)(ws + O_VTC) + ((size_t)((bb * 4 + (gc >> 8)) * 128)) * TPB + trow;
      const int cl = tid & 127, rg = tid >> 7;
      const int ct = hj * HALF + cl;
#pragma unroll 1
      for (int i = 0; i < 8; ++i) {
        const int r0 = rg * 64 + i * 8;
        float v[8];
#pragma unroll
        for (int e = 0; e < 8; ++e) {
          const int r = r0 + e;
          v[e] = bf2f(stg[r * 256 + SWZ(r, ct >> 3) * 8 + (ct & 7)]);
          if (mode == M_G3) v[e] *= ((const float*)(ws + O_RINV))[(brow + r) * 2 + 1];
        }
        st8(tdst + (size_t)cl * TPB + r0, v);
      }
    }
  }
  LDS_BAR();
#undef SWZ
}

DEVI int xcd_remap(int t, int bid, int nblk) {
  if (nblk != 256) return t;
  int r = t / 256;
  return r * 256 + (bid & 7) * 32 + (bid >> 3);
}
DEVI void tile_map(int v, int nM, int nN, int& pm, int& pn) {
  int per = 4 * nN, band = v / per, idx = v % per;
  pm = band * 4 + (idx & 3);
  pn = idx >> 2;
}

struct WItem {
  const float* src; const float* kscale; u16* dst;
  int ldsrc, K, N, k0, n0, kind;
};
DEVI WItem wdecode(const P& p, char* ws, int l, int t, int tend, u16* wmerge) {
  constexpr int T_WIN1 = 32 * 114, T_WIN2 = 32 * 128, T_WBR = 4 * 8 * 32, T_WUQ = 8 * 12, T_WUKV = 8 * 16, T_POOL = 64;
  WItem w;
  w.kscale = nullptr; w.kind = 0; w.src = nullptr; w.dst = nullptr; w.ldsrc = 0; w.K = 0; w.N = 0; w.k0 = 0; w.n0 = 0;
  if (t >= tend) { w.kind = -1; return w; }
  int i = t;
  if (i < T_WIN1) {
    w.src = p.w_in + (size_t)l * 2048 * DIN; w.ldsrc = DIN; w.K = 2048; w.N = C_MG; w.dst = (u16*)(ws + O_WIN);
    w.k0 = (i & 31) * 64; w.n0 = (i >> 5) * 64; return w;
  }
  i -= T_WIN1;
  if (i < T_WIN2) {
    w.src = p.w_in + (size_t)l * 2048 * DIN + C_MG; w.ldsrc = DIN; w.K = 2048; w.N = 8192; w.dst = wmerge;
    w.k0 = (i & 31) * 64; w.n0 = (i >> 5) * 64; return w;
  }
  i -= T_WIN2;
  if (i < T_WBR) {
    int br = i >> 8, r = i & 255;
    w.src = p.w_br + ((size_t)l * 4 + br) * 512 * 2048; w.ldsrc = 2048; w.K = 512; w.N = 2048;
    w.dst = (u16*)(ws + O_WBR) + (size_t)br * 2048 * 512; w.k0 = (r & 7) * 64; w.n0 = (r >> 3) * 64; return w;
  }
  i -= T_WBR;
  if (i < T_WUQ) {
    w.src = p.w_uq + (size_t)l * 512 * 768; w.ldsrc = 768; w.K = 512; w.N = 768; w.dst = (u16*)(ws + O_WUQ);
    w.kscale = p.mla_gq + l * 512; w.k0 = (i & 7) * 64; w.n0 = (i >> 3) * 64; return w;
  }
  i -= T_WUQ;
  if (i < T_WUKV) {
    w.src = p.w_ukv + (size_t)l * 512 * 1024; w.ldsrc = 1024; w.K = 512; w.N = 1024; w.dst = (u16*)(ws + O_WUKV);
    w.kscale = p.mla_gkv + l * 512; w.k0 = (i & 7) * 64; w.n0 = (i >> 3) * 64; return w;
  }
  i -= T_WUKV;
  if (i < T_POOL) { w.kind = 1; w.n0 = i; return w; }
  i -= T_POOL;
  w.src = p.w_out + (size_t)l * 2048 * 2048; w.ldsrc = 2048; w.K = 2048; w.N = 2048; w.dst = (u16*)(ws + O_WOUT);
  w.k0 = (i & 31) * 64; w.n0 = (i >> 5) * 64;
  return w;
}
DEVI void wload(const WItem& w, float4 (&v)[2], int tid) {
#pragma unroll
  for (int it = 0; it < 2; ++it) {
    int i = tid + it * NTHR, tr = i >> 4, c4 = (i & 15) * 4;
    float4 x = make_float4(0.f, 0.f, 0.f, 0.f);
    if (w.n0 + c4 < w.N) x = *(const float4*)(w.src + (size_t)(w.k0 + tr) * w.ldsrc + w.n0 + c4);
    if (w.kscale) { float sc = w.kscale[w.k0 + tr]; x.x *= sc; x.y *= sc; x.z *= sc; x.w *= sc; }
    v[it] = x;
  }
}

__device__ void phase_wprep(const P& p, int l, int wmode, int rank, int count, int mod, int lo, int width, int sub_lo,
                            int sub_hi) {
  OPQ_IDS
  char* ws = opqp(p.ws);
  constexpr int T_W1 = 32 * 114, T_W2 = 32 * 128;
  constexpr int T_A = T_W1 + T_W2 + 4 * 8 * 32 + 8 * 12 + 8 * 16 + 64, T_WOUT = 32 * 32;
  const int ubeg = (wmode == 2) ? T_A : (wmode == 3) ? sub_lo : 0;
  const int uend = (wmode == 1) ? T_A - T_W2 : (wmode == 3) ? sub_hi : (wmode == 4) ? T_A : T_A + T_WOUT;
  const int tend = T_A + T_WOUT;
#define WMAP(u) ((u) >= uend ? tend : (wmode == 1) ? ((u) < T_W1 ? (u) : (u) + T_W2) : (wmode == 3) ? T_W1 + (u) : (u))
  u16* wmerge = (l & 1) ? (u16*)(ws + O_WINM1) : (u16*)(ws + O_WIN) + (size_t)C_MG * 2048;
  float* tiles = (float*)shm;
  int g = rank, par = 0;
  WItem cur = wdecode(p, ws, l, WMAP(ubeg + (g / width) * mod + lo + g % width), tend, wmerge);
  float4 v[2] = {make_float4(0.f, 0.f, 0.f, 0.f), make_float4(0.f, 0.f, 0.f, 0.f)};
  __syncthreads();
  if (cur.kind == 0) wload(cur, v, TIDX);
  while (cur.kind >= 0) {
    g += count;
    WItem nxt = wdecode(p, ws, l, WMAP(ubeg + (g / width) * mod + lo + g % width), tend, wmerge);
    float4 vn[2] = {make_float4(0.f, 0.f, 0.f, 0.f), make_float4(0.f, 0.f, 0.f, 0.f)};
    if (nxt.kind == 0) wload(nxt, vn, TIDX);
    if (cur.kind == 0) {
      float* tile = tiles + par * (64 * 65);
      par ^= 1;
#pragma unroll
      for (int it = 0; it < 2; ++it) {
        int i = TIDX + it * NTHR, tr = i >> 4, c4 = (i & 15) * 4;
        float* tp = tile + tr * 65 + c4;
        tp[0] = v[it].x; tp[1] = v[it].y; tp[2] = v[it].z; tp[3] = v[it].w;
      }
      __syncthreads();
      int tn = TIDX & 63, tk = (TIDX >> 6) * 8;
      if (cur.n0 + tn < cur.N) {
        bf16x8 o;
#pragma unroll
        for (int e = 0; e < 8; ++e) o[e] = (short)f2bf(tile[(tk + e) * 65 + tn]);
        *(bf16x8*)(cur.dst + (size_t)(cur.n0 + tn) * cur.K + cur.k0 + tk) = o;
      }
    } else {
      u16* dst = (u16*)(ws + O_POOL);
      for (int e = TIDX; e < 4096; e += NTHR) {
        int idx = cur.n0 * 4096 + e, n = idx >> 9, k = idx & 511;
        int gg = n >> 7, g2 = k >> 7;
        float x = 0.f;
        if (gg == g2) x = p.pool_w[(((size_t)l * 4 + gg) * 128 + (k & 127)) * 128 + (n & 127)];
        dst[idx] = f2bf(x);
      }
    }
    cur = nxt;
    v[0] = vn[0];
    v[1] = vn[1];
  }
  __syncthreads();
}
#undef WMAP

__device__ void phase_mod_partial(const P& p) {
  OPQ_IDS
  float* sl = (float*)shm;
  float* modp = (float*)(p.ws + O_MODP);
  for (int t = BIDX; t < 4 * 24 * 16; t += gridDim.x) {
    int l = t / 384, r = t % 384, nb = r / 16, ks = r % 16;
    __syncthreads();
    for (int i = TIDX; i < 640; i += NTHR) {
      int v = i >> 7, k = i & 127;
      float cv = (v < 4) ? p.c[v * 2048 + ks * 128 + k] : p.c_ctx[ks * 128 + k];
      sl[i] = silu_f(cv);
    }
    __syncthreads();
    int col = TIDX & 255, kh = TIDX >> 8;
    float a[5] = {0, 0, 0, 0, 0};
    const float* w = p.w_mod + ((size_t)l * 2048 + ks * 128 + kh * 64) * 6144 + nb * 256 + col;
#pragma unroll 4
    for (int k = 0; k < 64; ++k) {
      float wv = w[(size_t)k * 6144];
#pragma unroll
      for (int v = 0; v < 5; ++v) a[v] += sl[v * 128 + kh * 64 + k] * wv;
    }
    __syncthreads();
    float* part = sl + 1024;
    if (kh == 1) {
#pragma unroll
      for (int v = 0; v < 5; ++v) part[v * 256 + col] = a[v];
    }
    __syncthreads();
    if (kh == 0) {
#pragma unroll
      for (int v = 0; v < 5; ++v)
        modp[(((size_t)l * 16 + ks) * 5 + v) * 6144 + nb * 256 + col] = a[v] + part[v * 256 + col];
    }
  }
  float2* rt = (float2*)(p.ws + O_ROPE);
  for (int i = BIDX * NTHR + TIDX; i < 1024; i += gridDim.x * NTHR) {
    int pos = i >> 4, j = i & 15;
    float inv = powf(10000.f, -(float)j / 16.f);
    float ang = (float)pos * inv;
    rt[i] = make_float2(cosf(ang), sinf(ang));
  }
}
__device__ void phase_mod_reduce(const P& p) {
  OPQ_IDS
  const float* modp = (const float*)(p.ws + O_MODP);
  float* mod = (float*)(p.ws + O_MOD);
  for (int i = BIDX * NTHR + TIDX; i < 4 * 5 * 6144; i += gridDim.x * NTHR) {
    int l = i / 30720, r = i % 30720, n = r % 6144;
    float s = p.b_mod[l * 6144 + n];
    for (int ks = 0; ks < 16; ++ks) s += modp[((size_t)l * 16 + ks) * 30720 + r];
    mod[i] = s;
  }
}

DEVI float* xrow_ptr(const P& p, int r) {
  int b = r / TPB, t = r - b * TPB;
  return (t < CTXL) ? (float*)(p.ws + O_XC) + ((size_t)b * CTXL + t) * D : p.out + ((size_t)b * SEQ + (t - CTXL)) * D;
}
__device__ void phase_norm(const P& p, int l) {
  OPQ_IDS
  int lane = TIDX & 63, gw = BIDX * 8 + (TIDX >> 6), nw = gridDim.x * 8;
  const float* mod = (const float*)(p.ws + O_MOD);
  u16* hn = (u16*)(p.ws + O_HN);
  for (int r = gw; r < NTOK; r += nw) {
    int b = r / TPB, t = r - b * TPB;
    float* xr = xrow_ptr(p, r);
    const float* src = xr;
    if (l == 0) src = (t < CTXL) ? p.ctx + ((size_t)b * CTXL + t) * D : p.x + ((size_t)b * SEQ + (t - CTXL)) * D;
    const float* mv = mod + ((size_t)l * 5 + (t < CTXL ? 4 : b)) * 6144;
    float4 v[8];
    float ss = 0.f;
#pragma unroll
    for (int i = 0; i < 8; ++i) {
      v[i] = *(const float4*)(src + i * 256 + lane * 4);
      ss += v[i].x * v[i].x + v[i].y * v[i].y + v[i].z * v[i].z + v[i].w * v[i].w;
    }
    ss = wave_sum(ss);
    float rs = rsqrtf(ss * (1.f / D) + EPS);
#pragma unroll
    for (int i = 0; i < 8; ++i) {
      int c0 = i * 256 + lane * 4;
      float4 g = *(const float4*)(p.norm_g + l * D + c0);
      float4 sh = *(const float4*)(mv + c0);
      float4 sc = *(const float4*)(mv + 2048 + c0);
      unsigned a0 = f2bf(v[i].x * rs * g.x * (1.f + sc.x) + sh.x), a1 = f2bf(v[i].y * rs * g.y * (1.f + sc.y) + sh.y);
      unsigned a2 = f2bf(v[i].z * rs * g.z * (1.f + sc.z) + sh.z), a3 = f2bf(v[i].w * rs * g.w * (1.f + sc.w) + sh.w);
      uint2 o = make_uint2(a0 | (a1 << 16), a2 | (a3 << 16));
      *(uint2*)(hn + (size_t)r * D + c0) = o;
    }
  }
}
__device__ void phase_final(const P& p) {
  OPQ_IDS
  int lane = TIDX & 63, gw = BIDX * 8 + (TIDX >> 6), nw = gridDim.x * 8;
  for (int r = gw; r < NBATCH * SEQ; r += nw) {
    float* xr = p.out + (size_t)r * D;
    float4 v[8];
    float ss = 0.f;
#pragma unroll
    for (int i = 0; i < 8; ++i) {
      v[i] = *(const float4*)(xr + i * 256 + lane * 4);
      ss += v[i].x * v[i].x + v[i].y * v[i].y + v[i].z * v[i].z + v[i].w * v[i].w;
    }
    ss = wave_sum(ss);
    float rs = rsqrtf(ss * (1.f / D) + EPS);
#pragma unroll
    for (int i = 0; i < 8; ++i) {
      int c0 = i * 256 + lane * 4;
      float4 g = *(const float4*)(p.g_final + c0);
      *(float4*)(xr + c0) = make_float4(v[i].x * rs * g.x, v[i].y * rs * g.y, v[i].z * rs * g.z, v[i].w * rs * g.w);
    }
  }
}

__device__ void phase_p2(const P& p, int l) {
  OPQ_IDS
  int lane = TIDX & 63, gw = xcd_remap(BIDX, BIDX, gridDim.x) * 8 + (TIDX >> 6), nw = gridDim.x * 8;
  char* ws = opqp(p.ws);
  const u16* proj = (const u16*)(ws + O_PROJ);
  float* rinv = (float*)(ws + O_RINV);
  const float2* rt = (const float2*)(ws + O_ROPE);
  float cw[2][4][8];
#pragma unroll
  for (int part = 0; part < 2; ++part)
#pragma unroll
    for (int j = 0; j < 4; ++j) {
      const float* cp = p.conv_w + ((size_t)l * 4 + j) * 1024 + part * 512 + lane * 8;
      f32x4 c0 = *(const f32x4*)cp, c1 = *(const f32x4*)(cp + 4);
#pragma unroll
      for (int i = 0; i < 4; ++i) { cw[part][j][i] = c0[i]; cw[part][j][4 + i] = c1[i]; }
    }
  const float bif = (lane < 16) ? p.b_if[l * 16 + lane] : 0.f;
  const bf16x8 z8 = {0, 0, 0, 0, 0, 0, 0, 0};
  for (int r = gw; r < NTOK; r += nw) {
    int b = r / TPB, t = r - b * TPB;
    const bool isctx = t < CTXL;
    const int pos = isctx ? t : t - CTXL;
    const int n = isctx ? CTXL : SEQ;
    const u16* pr = proj + (size_t)r * NP;
    const bf16x8 vq = *(const bf16x8*)(pr + C_CQ + lane * 8);
    const bf16x8 vkv = *(const bf16x8*)(pr + C_CKV + lane * 8);
    const u16 kro = pr[C_CKR + lane], krp = pr[C_CKR + (lane ^ 16)];
    const u16 dif = pr[C_DIF + (lane & 15)];
    const int g = lane >> 4, w = 2 << g;
    const int lo = max(pos - w / 2, 0), hi = min(pos + (w - 1 - w / 2), n - 1);
    bf16x8 wv[16];
#pragma unroll
    for (int k = 0; k < 16; ++k) {
      int u = pos + k - 8;
      wv[k] = z8;
      if (u >= lo && u <= hi) wv[k] = *(const bf16x8*)(pr + (ptrdiff_t)(k - 8) * NP + C_BI + lane * 8);
    }
    bf16x8 cv[2][4];
#pragma unroll
    for (int part = 0; part < 2; ++part)
#pragma unroll
      for (int j = 0; j < 4; ++j) {
        int u = pos + j - 2;
        cv[part][j] = z8;
        if (u >= 0 && u < n) cv[part][j] = *(const bf16x8*)(pr + (ptrdiff_t)(j - 2) * NP + C_DQ + part * 512 + lane * 8);
      }
    float sq = 0.f, skv = 0.f;
#pragma unroll
    for (int i = 0; i < 8; ++i) { float a = bfs(vq[i]), c = bfs(vkv[i]); sq += a * a; skv += c * c; }
    sq = wave_sum(sq);
    skv = wave_sum(skv);
    if (lane == 0) {
      rinv[r * 2] = rsqrtf(sq * (1.f / 512.f) + EPS);
      rinv[r * 2 + 1] = rsqrtf(skv * (1.f / 512.f) + EPS);
    }
    {
      float own = bf2f(kro);
      float o = own;
      if (!isctx) {
        float par = bf2f(krp);
        int half = lane >> 5, ii = lane & 31, j = ii & 15;
        int pp = half ? (pos & 63) : (pos >> 6);
        float2 cs = rt[pp * 16 + j];
        o = (ii < 16) ? own * cs.x - par * cs.y : own * cs.x + par * cs.y;
      }
      u16 ob = f2bf(o);
      u16* kh = (u16*)(ws + O_KH) + ((size_t)(b * 4) * TPB + t) * 192 + 128 + lane;
#pragma unroll
      for (int h = 0; h < 4; ++h) kh[(size_t)h * TPB * 192] = ob;
    }
    {
      float s[8] = {0, 0, 0, 0, 0, 0, 0, 0};
#pragma unroll
      for (int k = 0; k < 16; ++k)
#pragma unroll
        for (int i = 0; i < 8; ++i) s[i] += bfs(wv[k][i]);
      float ic = 1.f / (float)(hi - lo + 1);
#pragma unroll
      for (int i = 0; i < 8; ++i) s[i] = s[i] * ic - bfs(wv[8][i]);
      st8((u16*)(ws + O_DPOOL) + (size_t)r * 512 + lane * 8, s);
    }
#pragma unroll
    for (int part = 0; part < 2; ++part) {
      float a[8] = {0, 0, 0, 0, 0, 0, 0, 0};
#pragma unroll
      for (int j = 0; j < 4; ++j)
#pragma unroll
        for (int i = 0; i < 8; ++i) a[i] += bfs(cv[part][j][i]) * cw[part][j][i];
      const float ksc = part ? 0.08838834764831845f : 1.f;
#pragma unroll
      for (int i = 0; i < 8; ++i) a[i] = silu_f(a[i]) * ksc;
      st8((u16*)(ws + O_QKC) + (size_t)r * 1024 + part * 512 + lane * 8, a);
    }
    if (lane < 16) {
      float gg = bf2f(dif) + bif;
      if (lane & 4) gg = fminf(gg, 0.f) - __logf(1.f + __expf(-fabsf(gg)));
      ((float*)(ws + O_GL))[(size_t)r * 16 + lane] = gg;
    }
  }
}

struct AttnTile {
  const u16* kp;
  const u16* vp;
  int isctx;
  int kr;
};

template <int DQK, int QT, bool NA>
__device__ void attn_block(const P& p, int layer, int b, int h, int qrow0  , bool q_is_latent,
                           int ntile, int na_r0  , const u16* Kbase, int ldk,
                           const u16* Vtbase  , const u16* Qbase, int ldq, int gatecol,
                           int ycol, float scale) {
  OPQ_IDS
  constexpr int KS = DQK / 32;
  constexpr int KSTR = DQK + 8;
  const float scale2 = scale * 1.4426950408889634f;
  constexpr int KCH = 64 * DQK / 8 / NTHR;
  u16* Ks = (u16*)shm;
  u16* Vs = Ks + 64 * KSTR;
  float* rpb = (float*)(Vs + 128 * 72);
  const int wid = TIDX >> 6, lane = TIDX & 63, l15 = lane & 15, quad = lane >> 4;
  char* ws = opqp(p.ws);
  const float2* rt = (const float2*)(ws + O_ROPE);

  __syncthreads();
  if (NA) {
    for (int i = TIDX; i < 465; i += NTHR) rpb[i] = p.na_rpb[((size_t)layer * 4 + h) * 465 + i];
  }
  bf16x8 qf[QT][KS];
#pragma unroll
  for (int qt = 0; qt < QT; ++qt) {
    int ql = wid * 16 * QT + qt * 16 + l15;
    const u16* qp = Qbase + (size_t)(qrow0 + ql) * ldq;
#pragma unroll
    for (int ks = 0; ks < KS; ++ks) qf[qt][ks] = *(const bf16x8*)(qp + ks * 32 + quad * 8);
  }
  f32x4 o[8][QT];
  float mrun[QT], lrun[QT];
#pragma unroll
  for (int qt = 0; qt < QT; ++qt) {
    mrun[qt] = -1e30f;
    lrun[qt] = 0.f;
#pragma unroll
    for (int dt = 0; dt < 8; ++dt) o[dt][qt] = f32x4{0.f, 0.f, 0.f, 0.f};
  }
  int na_rq = 0, na_cq = 0, na_cs = 0, na_rs = 0;
  if (NA) {
    na_rq = na_r0 + (wid >> 2);
    na_cq = (wid & 3) * 16 + l15;
    na_cs = min(max(na_cq - 8, 0), 48);
    na_rs = min(max(na_rq - 4, 0), 56);
  }
  const int na_rlo = NA ? min(max(na_r0 - 4, 0), 56) : 0;

  bf16x8 kreg[KCH], vreg[2];
  auto tile_ptrs = [&](int ti, const u16*& kp, const u16*& vp, int& isctx, int& kr) {
    int tok0;
    if (ti < 4) {
      tok0 = ti * 64;
      isctx = 1;
      kr = -1;
    } else {
      isctx = 0;
      kr = NA ? (na_rlo + ti - 4) : (ti - 4);
      tok0 = CTXL + kr * 64;
    }
    kp = Kbase + (size_t)tok0 * ldk;
    vp = Vtbase + tok0;
  };
  auto gloadK = [&](int ti) {
    const u16 *kp, *vp;
    int ic, kr;
    tile_ptrs(ti, kp, vp, ic, kr);
#pragma unroll
    for (int i = 0; i < KCH; ++i) {
      int c = TIDX + i * NTHR, key = c / (DQK / 8), part = c % (DQK / 8);
      kreg[i] = *(const bf16x8*)(kp + (size_t)key * ldk + part * 8);
    }
  };
  auto gloadV = [&](int ti) {
    const u16 *kp, *vp;
    int ic, kr;
    tile_ptrs(ti, kp, vp, ic, kr);
#pragma unroll
    for (int i = 0; i < 2; ++i) {
      int c = TIDX + i * NTHR, dv = c >> 3, part = c & 7;
      vreg[i] = *(const bf16x8*)(vp + (size_t)dv * TPB + part * 8);
    }
  };
  auto sstoreK = [&]() {
#pragma unroll
    for (int i = 0; i < KCH; ++i) {
      int c = TIDX + i * NTHR, key = c / (DQK / 8), part = c % (DQK / 8);
      *(bf16x8*)(Ks + key * KSTR + part * 8) = kreg[i];
    }
  };
  auto sstoreV = [&]() {
#pragma unroll
    for (int i = 0; i < 2; ++i) {
      int c = TIDX + i * NTHR, dv = c >> 3, part = c & 7;
      *(bf16x8*)(Vs + dv * 72 + part * 8) = vreg[i];
    }
  };

  gloadK(0);
  gloadV(0);
  __syncthreads();
  sstoreK();
  sstoreV();
  if (ntile > 1) { gloadK(1); gloadV(1); }
  LDS_BAR();
  auto tile_iter = [&](int ti) {
    const int isctx = ti < 4;
    int kr = NA ? (na_rlo + ti - 4) : 0;
    bool active = true;
    if (NA && !isctx) active = (kr >= na_rs) && (kr < na_rs + 8);
    f32x4 s[4][QT];
    if (active) {
#pragma unroll
      for (int kt = 0; kt < 4; ++kt)
#pragma unroll
        for (int qt = 0; qt < QT; ++qt) s[kt][qt] = f32x4{0.f, 0.f, 0.f, 0.f};
#pragma unroll
      for (int ks = 0; ks < KS; ++ks) {
        bf16x8 a[4];
#pragma unroll
        for (int kt = 0; kt < 4; ++kt) a[kt] = *(const bf16x8*)(Ks + (kt * 16 + l15) * KSTR + ks * 32 + quad * 8);
#pragma unroll
        for (int qt = 0; qt < QT; ++qt) {
          bf16x8 q = qf[qt][ks];
#pragma unroll
          for (int kt = 0; kt < 4; ++kt) s[kt][qt] = __builtin_amdgcn_mfma_f32_16x16x32_bf16(a[kt], q, s[kt][qt], 0, 0, 0);
        }
      }
    }
    LDS_BAR();
    if (ti + 1 < ntile) sstoreK();
    if (ti + 2 < ntile) gloadK(ti + 2);
    if (active) {
      bf16x8 pf[QT][2];
#pragma unroll
      for (int qt = 0; qt < QT; ++qt) {
        float mx = -1e30f;
#pragma unroll
        for (int kt = 0; kt < 4; ++kt)
#pragma unroll
          for (int j = 0; j < 4; ++j) {
            float v = s[kt][qt][j] * scale2;
            if (NA && !isctx) {
              int ck = kt * 16 + quad * 4 + j;
              bool valid = (ck >= na_cs) && (ck < na_cs + 16);
              int bidx = (kr - na_rq + 7) * 31 + min(max(ck - na_cq + 15, 0), 30);
              v = valid ? v + rpb[bidx] * 1.4426950408889634f : -1e30f;
            }
            s[kt][qt][j] = v;
            mx = fmaxf(mx, v);
          }
        mx = fmaxf(mx, SHX(mx, 16));
        mx = fmaxf(mx, SHX(mx, 32));
        float mnew = fmaxf(mrun[qt], mx);
        float alpha = __builtin_amdgcn_exp2f(mrun[qt] - mnew);
        mrun[qt] = mnew;
        float ls = 0.f;
#pragma unroll
        for (int kt = 0; kt < 4; ++kt)
#pragma unroll
          for (int j = 0; j < 4; ++j) {
            float pv = __builtin_amdgcn_exp2f(s[kt][qt][j] - mnew);
            ls += pv;
            s[kt][qt][j] = pv;
          }
        lrun[qt] = lrun[qt] * alpha + ls;
        if (__builtin_amdgcn_ballot_w64(alpha != 1.f)) {
#pragma unroll
          for (int dt = 0; dt < 8; ++dt)
#pragma unroll
            for (int j = 0; j < 4; ++j) o[dt][qt][j] *= alpha;
        }
#pragma unroll
        for (int kk = 0; kk < 2; ++kk) {
          union { bf16x8 v; unsigned u[4]; } cv;
          cv.u[0] = pk2(s[2 * kk][qt][0], s[2 * kk][qt][1]);
          cv.u[1] = pk2(s[2 * kk][qt][2], s[2 * kk][qt][3]);
          cv.u[2] = pk2(s[2 * kk + 1][qt][0], s[2 * kk + 1][qt][1]);
          cv.u[3] = pk2(s[2 * kk + 1][qt][2], s[2 * kk + 1][qt][3]);
          pf[qt][kk] = cv.v;
        }
      }
#pragma unroll
      for (int kk = 0; kk < 2; ++kk)
#pragma unroll
        for (int dt = 0; dt < 8; ++dt) {
          const u16* vb = Vs + (dt * 16 + l15) * 72 + kk * 32 + quad * 4;
          bf16x4 v0 = *(const bf16x4*)vb, v1 = *(const bf16x4*)(vb + 16);
          bf16x8 va = {v0[0], v0[1], v0[2], v0[3], v1[0], v1[1], v1[2], v1[3]};
#pragma unroll
          for (int qt = 0; qt < QT; ++qt) o[dt][qt] = __builtin_amdgcn_mfma_f32_16x16x32_bf16(va, pf[qt][kk], o[dt][qt], 0, 0, 0);
        }
    }
    LDS_BAR();
    if (ti + 1 < ntile) sstoreV();
    if (ti + 2 < ntile) gloadV(ti + 2);
  };
  for (int ti = 0; ti < 4; ++ti) tile_iter(ti);
  if (ntile > 4) {
    if (!NA && DQK == 192) {
#pragma unroll
      for (int qt = 0; qt < QT; ++qt) {
        const int ql = wid * 16 * QT + qt * 16 + l15;
        const u16* qp = Qbase + (size_t)(qrow0 + ql) * ldq;
        const int tq = (qrow0 + ql) % TPB - CTXL;
#pragma unroll
        for (int hf = 0; hf < 2; ++hf) {
          bf16x8 own = qf[qt][KS - 2 + hf];
          bf16x8 par = *(const bf16x8*)(qp + 128 + hf * 32 + (quad ^ 2) * 8);
          int pp = hf ? (tq & 63) : (tq >> 6);
          bf16x8 ro;
#pragma unroll
          for (int e = 0; e < 8; ++e) {
            float2 cs = rt[pp * 16 + (quad & 1) * 8 + e];
            float ov = bfs(own[e]), pv = bfs(par[e]);
            float r = (quad < 2) ? ov * cs.x - pv * cs.y : ov * cs.x + pv * cs.y;
            ro[e] = (short)f2bf(r);
          }
          qf[qt][KS - 2 + hf] = ro;
        }
      }
    }
    for (int ti = 4; ti < ntile; ++ti) tile_iter(ti);
  }
  const u16* proj = (const u16*)(ws + O_PROJ);
  u16* ys = (u16*)(ws + O_YS);
#pragma unroll
  for (int qt = 0; qt < QT; ++qt) {
    float lt = lrun[qt];
    lt += SHX(lt, 16);
    lt += SHX(lt, 32);
    float il = 1.f / lt;
    int r = qrow0 + wid * 16 * QT + qt * 16 + l15;
#pragma unroll
    for (int dt = 0; dt < 8; ++dt) {
      int dv = dt * 16 + quad * 4;
      bf16x4 g = *(const bf16x4*)(proj + (size_t)r * NP + gatecol + h * 128 + dv);
      bf16x4 ov;
#pragma unroll
      for (int j = 0; j < 4; ++j) {
        float y = bf2f(f2bf(o[dt][qt][j] * il));
        ov[j] = (short)f2bf(y * silu_f(bfs(g[j])));
      }
      *(bf16x4*)(ys + (size_t)r * 2048 + ycol + h * 128 + dv) = ov;
    }
  }
}

__device__ void phase_attn(const P& p, int l) {
  OPQ_IDS
  char* ws = opqp(p.ws);
  const bool need_ctx = l < 3;
  const int n_mla_lat = 256, n_na_lat = 512;
  const int n_mla_ctx = need_ctx ? 16 : 0, n_na_ctx = need_ctx ? 32 : 0;
  const int total = n_mla_lat + n_na_lat + n_mla_ctx + n_na_ctx;
  const u16* proj = (const u16*)(ws + O_PROJ);
  for (int it0 = BIDX; it0 < (total + 255) / 256 * 256; it0 += gridDim.x) {
    const int it = xcd_remap(it0, BIDX, gridDim.x);
    if (it >= total) continue;
    int i = it;
    if (i < n_mla_lat) {
      int bh = i >> 4, qb = i & 15, b = bh >> 2, h = bh & 3;
      attn_block<192, 2, false>(p, l, b, h, b * TPB + CTXL + qb * 256, true, 68, 0,
                                (const u16*)(ws + O_KH) + (size_t)bh * TPB * 192, 192,
                                (const u16*)(ws + O_VTC) + (size_t)bh * 128 * TPB,
                                (const u16*)(ws + O_QH) + h * 192, 768, C_CG, 1024, 0.07216878364870322f);
      continue;
    }
    i -= n_mla_lat;
    if (i < n_na_lat) {
      int bh = i >> 5, rp = i & 31, b = bh >> 2, h = bh & 3;
      int r0 = rp * 2;
      int rlo = min(max(r0 - 4, 0), 56), rhi = min(max(r0 + 1 - 4, 0), 56) + 7;
      attn_block<128, 1, true>(p, l, b, h, b * TPB + CTXL + r0 * 64, true, 4 + (rhi - rlo + 1), r0,
                               proj + (size_t)b * TPB * NP + C_AK + h * 128, NP,
                               (const u16*)(ws + O_VTA) + (size_t)bh * 128 * TPB, proj + C_AQ + h * 128, NP, C_AG, 0,
                               0.08838834764831845f);
      continue;
    }
    i -= n_na_lat;
    if (i < n_mla_ctx) {
      int bh = i, b = bh >> 2, h = bh & 3;
      attn_block<192, 2, false>(p, l, b, h, b * TPB, false, 4, 0, (const u16*)(ws + O_KH) + (size_t)bh * TPB * 192, 192,
                                (const u16*)(ws + O_VTC) + (size_t)bh * 128 * TPB, (const u16*)(ws + O_QH) + h * 192,
                                768, C_CG, 1024, 0.07216878364870322f);
      continue;
    }
    i -= n_mla_ctx;
    {
      int bh = i >> 1, half = i & 1, b = bh >> 2, h = bh & 3;
      attn_block<128, 1, false>(p, l, b, h, b * TPB + half * 128, false, 4, 0,
                                proj + (size_t)b * TPB * NP + C_AK + h * 128, NP,
                                (const u16*)(ws + O_VTA) + (size_t)bh * 128 * TPB, proj + C_AQ + h * 128, NP, C_AG, 0,
                                0.08838834764831845f);
    }
  }
}

DEVI int chunk_index(int dir, int blk) {
  if (dir == 0) return blk;
  return blk < 4 ? 3 - blk : 4 + 63 - (blk - 4);
}
__device__ void mlstm_gates(const P& p, int b, int h, int blk, float* gs) {
  OPQ_IDS
  const float* gl = (const float*)(opqp(p.ws) + O_GL);
  int R0 = b * TPB + blk * 64;
  if (TIDX < 128) {
    const int dir = TIDX >> 6, L = LANE, t = dir ? 63 - L : L;
    const float li = gl[(size_t)(R0 + t) * 16 + dir * 8 + h];
    const float lf = gl[(size_t)(R0 + t) * 16 + dir * 8 + 4 + h];
    float bc = lf;
#pragma unroll
    for (int o = 1; o < 64; o <<= 1) {
      float n = __int_as_float(__builtin_amdgcn_ds_bpermute(((L - o) & 63) << 2, __float_as_int(bc)));
      if (L >= o) bc += n;
    }
    float pm = li - bc;
#pragma unroll
    for (int o = 1; o < 64; o <<= 1) {
      float n = __int_as_float(__builtin_amdgcn_ds_bpermute(((L - o) & 63) << 2, __float_as_int(pm)));
      if (L >= o) pm = fmaxf(pm, n);
    }
    gs[dir * 64 + t] = li;
    gs[128 + dir * 64 + t] = lf;
    gs[256 + dir * 64 + t] = bc;
    gs[384 + dir * 64 + t] = pm;
    if (L == 63) {
      gs[512 + dir * 4] = bc;
      gs[512 + dir * 4 + 1] = bc + pm;
    }
  }
  __syncthreads();
}

__device__ void phase_m1(const P& p) {
  OPQ_IDS
  char* ws = opqp(p.ws);
  u16* kwT = (u16*)shm;
  u16* vT = kwT + 2 * 128 * 72;
  float* gs = (float*)(vT + 128 * 72);
  const u16* qkc = (const u16*)(ws + O_QKC);
  const u16* proj = (const u16*)(ws + O_PROJ);
  const int wid = TIDX >> 6, lane = TIDX & 63, l15 = lane & 15, quad = lane >> 4;
  const int pos = (BIDX & 7) * 32 + (BIDX >> 3);
  const bool deal = gridDim.x == 256;
  const int nmine = !deal ? (16 * 68 - BIDX + (int)gridDim.x - 1) / (int)gridDim.x : (pos >= 100 ? 5 : (pos < 8 ? 4 : 3));
  for (int kk = 0; kk < nmine; ++kk) {
    int it;
    if (!deal) it = BIDX + kk * gridDim.x;
    else if (pos >= 100) it = (pos - 100) * 5 + kk;
    else if (kk < 3) it = 780 + pos * 3 + kk;
    else it = 1080 + pos;
    int bh = it / 68, blk = it % 68, b = bh >> 2, h = bh & 3;
    int R0 = b * TPB + blk * 64;
    __syncthreads();
    mlstm_gates(p, b, h, blk, gs);
#pragma unroll
    for (int i = 0; i < 2; ++i) {
      int c = TIDX + i * NTHR, s = c & 63, part = c >> 6;
      float kf[8];
      ld8(qkc + (size_t)(R0 + s) * 1024 + 512 + h * 128 + part * 8, kf);
      bf16x8 vv = *(const bf16x8*)(proj + (size_t)(R0 + s) * NP + C_DV + h * 128 + part * 8);
#pragma unroll
      for (int dir = 0; dir < 2; ++dir) {
        float bl = gs[512 + dir * 4], ml = gs[512 + dir * 4 + 1];
        float w = __expf(bl - gs[256 + dir * 64 + s] + gs[dir * 64 + s] - ml);
#pragma unroll
        for (int e = 0; e < 8; ++e) kwT[(dir * 128 + part * 8 + e) * 72 + s] = f2bf(kf[e] * w);
      }
#pragma unroll
      for (int e = 0; e < 8; ++e) vT[(part * 8 + e) * 72 + s] = (u16)vv[e];
    }
    __syncthreads();
    int dir = wid >> 2;
    int item = (bh * 2 + dir) * 68 + chunk_index(dir, blk);
    f32x4 acc[2][8];
#pragma unroll
    for (int a = 0; a < 2; ++a)
#pragma unroll
      for (int e = 0; e < 8; ++e) acc[a][e] = f32x4{0.f, 0.f, 0.f, 0.f};
#pragma unroll
    for (int kk = 0; kk < 2; ++kk) {
      bf16x8 af[2];
#pragma unroll
      for (int a = 0; a < 2; ++a) {
        const u16* ab = kwT + (dir * 128 + ((wid & 3) * 2 + a) * 16 + l15) * 72 + kk * 32 + quad * 4;
        bf16x4 v0 = *(const bf16x4*)ab, v1 = *(const bf16x4*)(ab + 16);
        af[a] = bf16x8{v0[0], v0[1], v0[2], v0[3], v1[0], v1[1], v1[2], v1[3]};
      }
#pragma unroll
      for (int e = 0; e < 8; ++e) {
        const u16* bb = vT + (e * 16 + l15) * 72 + kk * 32 + quad * 4;
        bf16x4 v0 = *(const bf16x4*)bb, v1 = *(const bf16x4*)(bb + 16);
        bf16x8 bf = bf16x8{v0[0], v0[1], v0[2], v0[3], v1[0], v1[1], v1[2], v1[3]};
#pragma unroll
        for (int a = 0; a < 2; ++a) acc[a][e] = __builtin_amdgcn_mfma_f32_16x16x32_bf16(af[a], bf, acc[a][e], 0, 0, 0);
      }
    }
    float* kl = (float*)(ws + O_KLOC) + (size_t)item * 16384;
#pragma unroll
    for (int a = 0; a < 2; ++a)
#pragma unroll
      for (int e = 0; e < 8; ++e) {
        int d0 = ((wid & 3) * 2 + a) * 16 + quad * 4, ee = e * 16 + l15;
        *(f32x4*)(kl + ee * 128 + d0) = acc[a][e];
      }
    if (TIDX < 256) {
      int dr = TIDX >> 7, d = TIDX & 127;
      float s = 0.f;
      for (int u = 0; u < 64; ++u) s += bf2f(kwT[(dr * 128 + d) * 72 + u]);
      int itm = (bh * 2 + dr) * 68 + chunk_index(dr, blk);
      ((float*)(ws + O_NLOC))[(size_t)itm * 128 + d] = s;
      if (d < 2) ((float*)(ws + O_SC))[itm * 2 + d] = gs[512 + dr * 4 + d];
    }
  }
}

__device__ void phase_m2(const P& p) {
  OPQ_IDS
  char* ws = opqp(p.ws);
  const float* kloc = (const float*)(ws + O_KLOC);
  const float* nloc = (const float*)(ws + O_NLOC);
  const float* sc = (const float*)(ws + O_SC);
  u16* cin = (u16*)(ws + O_CIN);
  float* nin = (float*)(ws + O_NIN);
  float* minp = (float*)(ws + O_MIN);
  const int per = 4096 + 32;
  for (int idx = BIDX * NTHR + TIDX; idx < 32 * per; idx += gridDim.x * NTHR) {
    int seq = idx / per, q4 = idx % per;
    f32x4 C = {0.f, 0.f, 0.f, 0.f};
    float m = 0.f;
    const bool isn = q4 >= 4096;
    for (int j0 = 0; j0 < 68; j0 += 4) {
      f32x4 kv[4];
      float bl[4], ml[4];
#pragma unroll
      for (int u = 0; u < 4; ++u) {
        int item = seq * 68 + j0 + u;
        kv[u] = isn ? *(const f32x4*)(nloc + (size_t)item * 128 + (q4 - 4096) * 4)
                    : *(const f32x4*)(kloc + (size_t)item * 16384 + q4 * 4);
        bl[u] = sc[item * 2];
        ml[u] = sc[item * 2 + 1];
      }
#pragma unroll
      for (int u = 0; u < 4; ++u) {
        int item = seq * 68 + j0 + u;
        if (isn) {
          *(f32x4*)(nin + (size_t)item * 128 + (q4 - 4096) * 4) = C;
          if (q4 == 4096) minp[item] = m;
        } else {
          bf16x4 o;
#pragma unroll
          for (int e = 0; e < 4; ++e) o[e] = (short)f2bf(C[e]);
          *(bf16x4*)(cin + (size_t)item * 16384 + q4 * 4) = o;
        }
        float mn = fmaxf(bl[u] + m, ml[u]);
        float dec = __expf(bl[u] + m - mn), wl = __expf(ml[u] - mn);
#pragma unroll
        for (int e = 0; e < 4; ++e) C[e] = dec * C[e] + wl * kv[u][e];
        m = mn;
      }
    }
  }
}

__device__ void phase_m3(const P& p, int l) {
  OPQ_IDS
  char* ws = opqp(p.ws);
  u16* Qs = (u16*)shm;
  u16* Ks = Qs + 64 * 136;
  u16* vT = Ks + 64 * 136;
  float* gs = (float*)(vT + 128 * 72);
  float* qn = gs + 528;
  float* ninl = qn + 128;
  float* hbuf = ninl + 256;
  const u16* qkc = (const u16*)(ws + O_QKC);
  const u16* proj = (const u16*)(ws + O_PROJ);
  const int wid = TIDX >> 6, lane = TIDX & 63, l15 = lane & 15, quad = lane >> 4;
  const bool need_ctx = l < 3;
  for (int it = BIDX; it < 16 * 68; it += gridDim.x) {
    int bh = it / 68, blk = it % 68, b = bh >> 2, h = bh & 3;
    if (!need_ctx && blk < 4) continue;
    int R0 = b * TPB + blk * 64;
    int itemd[2];
    itemd[0] = (bh * 2 + 0) * 68 + chunk_index(0, blk);
    itemd[1] = (bh * 2 + 1) * 68 + chunk_index(1, blk);
    bf16x8 lq[2], lk[2], lv[2];
#pragma unroll
    for (int i = 0; i < 2; ++i) {
      int c = TIDX + i * NTHR, s = c >> 4, part = c & 15;
      lq[i] = *(const bf16x8*)(qkc + (size_t)(R0 + s) * 1024 + h * 128 + part * 8);
      lk[i] = *(const bf16x8*)(qkc + (size_t)(R0 + s) * 1024 + 512 + h * 128 + part * 8);
      int c2s = c & 63, c2p = c >> 6;
      lv[i] = *(const bf16x8*)(proj + (size_t)(R0 + c2s) * NP + C_DV + h * 128 + c2p * 8);
    }
    float lnin = 0.f;
    if (TIDX < 256) lnin = ((const float*)(ws + O_NIN))[(size_t)itemd[TIDX >> 7] * 128 + (TIDX & 127)];
    const float m_in = ((const float*)(ws + O_MIN))[itemd[wid >> 2]];
    bf16x8 ldo[2], ldg[2];
    f32x4 lgn[4];
    {
      const int tt = TIDX >> 3, ch0 = h * 128 + (TIDX & 7) * 16;
      const u16* pr = proj + (size_t)(R0 + tt) * NP;
      ldo[0] = *(const bf16x8*)(pr + C_DO + ch0);
      ldo[1] = *(const bf16x8*)(pr + C_DO + ch0 + 8);
      ldg[0] = *(const bf16x8*)(pr + C_DG + ch0);
      ldg[1] = *(const bf16x8*)(pr + C_DG + ch0 + 8);
#pragma unroll
      for (int e4 = 0; e4 < 4; ++e4) lgn[e4] = *(const f32x4*)(p.ml_gnorm + l * 512 + ch0 + e4 * 4);
    }
    __syncthreads();
    mlstm_gates(p, b, h, blk, gs);
#pragma unroll
    for (int i = 0; i < 2; ++i) {
      int c = TIDX + i * NTHR, s = c >> 4, part = c & 15;
      *(bf16x8*)(Qs + s * 136 + part * 8) = lq[i];
      *(bf16x8*)(Ks + s * 136 + part * 8) = lk[i];
      int c2s = c & 63, c2p = c >> 6;
#pragma unroll
      for (int e = 0; e < 8; ++e) vT[(c2p * 8 + e) * 72 + c2s] = (u16)lv[i][e];
    }
    if (TIDX < 256) ninl[TIDX] = lnin;
    __syncthreads();
    {
      const int dr = TIDX >> 8, t = (TIDX >> 2) & 63, pq = TIDX & 3;
      float s = 0.f;
#pragma unroll 8
      for (int d = pq * 32; d < pq * 32 + 32; ++d) s += bf2f(Qs[t * 136 + d]) * ninl[dr * 128 + d];
      s += SHX(s, 1);
      s += SHX(s, 2);
      if (pq == 0) qn[dr * 64 + t] = s;
    }
    __syncthreads();
    {
      const int dir = wid >> 2, tt = wid & 3;
      const int t = tt * 16 + l15;
      const float* li = gs + dir * 64;
      const float* bc = gs + 256 + dir * 64;
      const float bct = bc[t];
      const float mt = fmaxf(bct + m_in, bct + gs[384 + dir * 64 + t]);
      bf16x8 qf[4];
#pragma unroll
      for (int ks = 0; ks < 4; ++ks) qf[ks] = *(const bf16x8*)(Qs + t * 136 + ks * 32 + quad * 8);
      f32x4 s[4];
#pragma unroll
      for (int st = 0; st < 4; ++st) s[st] = f32x4{0.f, 0.f, 0.f, 0.f};
#pragma unroll
      for (int ks = 0; ks < 4; ++ks)
#pragma unroll
        for (int st = 0; st < 4; ++st) {
          bf16x8 a = *(const bf16x8*)(Ks + (st * 16 + l15) * 136 + ks * 32 + quad * 8);
          s[st] = __builtin_amdgcn_mfma_f32_16x16x32_bf16(a, qf[ks], s[st], 0, 0, 0);
        }
      float dsum = 0.f;
      bf16x8 pf[2];
#pragma unroll
      for (int st = 0; st < 4; ++st)
#pragma unroll
        for (int j = 0; j < 4; ++j) {
          int sp = st * 16 + quad * 4 + j;
          bool valid = dir == 0 ? (sp <= t) : (sp >= t);
          float dm = bct - bc[sp] + li[sp] - mt;
          float v = valid ? s[st][j] * __expf(dm) : 0.f;
          dsum += v;
          pf[st >> 1][(st & 1) * 4 + j] = (short)f2bf(v);
        }
      dsum += SHX(dsum, 16);
      dsum += SHX(dsum, 32);
      f32x4 hi[8], hx[8];
#pragma unroll
      for (int e = 0; e < 8; ++e) { hi[e] = f32x4{0.f, 0.f, 0.f, 0.f}; hx[e] = f32x4{0.f, 0.f, 0.f, 0.f}; }
#pragma unroll
      for (int kk = 0; kk < 2; ++kk)
#pragma unroll
        for (int e = 0; e < 8; ++e) {
          const u16* vb = vT + (e * 16 + l15) * 72 + kk * 32 + quad * 4;
          bf16x4 v0 = *(const bf16x4*)vb, v1 = *(const bf16x4*)(vb + 16);
          bf16x8 va = {v0[0], v0[1], v0[2], v0[3], v1[0], v1[1], v1[2], v1[3]};
          hi[e] = __builtin_amdgcn_mfma_f32_16x16x32_bf16(va, pf[kk], hi[e], 0, 0, 0);
        }
      const u16* cin = (const u16*)(ws + O_CIN) + (size_t)itemd[dir] * 16384;
#pragma unroll
      for (int ks = 0; ks < 4; ++ks)
#pragma unroll
        for (int e = 0; e < 8; ++e) {
          bf16x8 ca = *(const bf16x8*)(cin + (e * 16 + l15) * 128 + ks * 32 + quad * 8);
          hx[e] = __builtin_amdgcn_mfma_f32_16x16x32_bf16(ca, qf[ks], hx[e], 0, 0, 0);
        }
      float a = __expf(bct + m_in - mt);
      float den = a * qn[dir * 64 + t] + dsum;
      float idn = 1.f / fmaxf(fabsf(den), __expf(-mt));
#pragma unroll
      for (int e = 0; e < 8; ++e)
#pragma unroll
        for (int j = 0; j < 4; ++j) hbuf[(dir * 64 + t) * 129 + e * 16 + quad * 4 + j] = (a * hx[e][j] + hi[e][j]) * idn;
    }
    __syncthreads();
    {
      int t = TIDX >> 3, part = TIDX & 7;
      float hv[16], ss = 0.f;
#pragma unroll
      for (int e = 0; e < 16; ++e) {
        hv[e] = hbuf[t * 129 + part * 16 + e] + hbuf[(64 + t) * 129 + part * 16 + e];
        ss += hv[e] * hv[e];
      }
      ss += SHX(ss, 1);
      ss += SHX(ss, 2);
      ss += SHX(ss, 4);
      float rs = rsqrtf(ss * (1.f / 128.f) + EPS);
      int r = R0 + t;
      const u16* pr = proj + (size_t)r * NP;
      u16* ys = (u16*)(ws + O_YS) + (size_t)r * 2048 + 1536 + h * 128 + part * 16;
      const int ch0 = h * 128 + part * 16;
      float dox[16], dgx[16], gn[16];
#pragma unroll
      for (int e = 0; e < 8; ++e) {
        dox[e] = bfs(ldo[0][e]); dox[8 + e] = bfs(ldo[1][e]);
        dgx[e] = bfs(ldg[0][e]); dgx[8 + e] = bfs(ldg[1][e]);
      }
#pragma unroll
      for (int e4 = 0; e4 < 4; ++e4)
#pragma unroll
        for (int e = 0; e < 4; ++e) gn[e4 * 4 + e] = lgn[e4][e];
      float yo[16];
#pragma unroll
      for (int e = 0; e < 16; ++e) {
        float y = hv[e] * rs * gn[e] * sigm_f(dox[e]);
        yo[e] = bf2f(f2bf(y)) * silu_f(dgx[e]);
      }
      st8(ys, yo);
      st8(ys + 8, yo + 8);
    }
  }
}

__device__ void gemm_step(const P& p, int step, int l) {
  OPQ_IDS
  char* ws = opqp(p.ws);
  const int nM = NTOK / 256;
  const bool need_ctx = l < 3;
  int ntiles;
  const int nbr = 1;
  if (step == 1) ntiles = nM * (NP / BNT);
  else if (step == 3) ntiles = nM * (2304 / BNT);
  else if (step == 6) ntiles = 4 * nM * (2048 / BNT);
  else if (step == 7) ntiles = nM * 32;
  else ntiles = nM * (2048 / BNT);
  for (int t0 = BIDX; t0 < (ntiles + 255) / 256 * 256; t0 += gridDim.x) {
    const int t = xcd_remap(t0, BIDX, gridDim.x);
    if (t >= ntiles) continue;
    for (int br = 0; br < nbr; ++br) {
      const u16 *A, *Bt;
      int lda, ldb, K, pm, pn, mode, aux = 0, bmode = 0, ncol = BNT;
      if (step == 1) {
        tile_map(t, nM, NP / BNT, pm, pn);
        A = (const u16*)(ws + O_HN); lda = 2048; Bt = (const u16*)(ws + O_WIN); ldb = 2048; K = 2048; mode = M_G1A;
      } else if (step == 3) {
        const int c2 = 768 / BNT, c3 = 1024 / BNT, c4 = 512 / BNT; const int n2 = nM * c2, n3 = nM * c3;
        K = 512; ldb = 512;
        if (t < n2) {
          pm = t / c2; pn = t % c2; A = (const u16*)(ws + O_PROJ) + C_CQ; lda = NP; Bt = (const u16*)(ws + O_WUQ); mode = M_G2;
        } else if (t < n2 + n3) {
          int tt = t - n2; pm = tt / c3; pn = tt % c3; A = (const u16*)(ws + O_PROJ) + C_CKV; lda = NP; Bt = (const u16*)(ws + O_WUKV); mode = M_G3;
        } else {
          int tt = t - n2 - n3; pm = tt / c4; pn = tt % c4; A = (const u16*)(ws + O_DPOOL); lda = 512; Bt = (const u16*)(ws + O_POOL); mode = M_POOL;
        }
      } else if (step == 6) {
        aux = t / (nM * (2048 / BNT));
        tile_map(t % (nM * (2048 / BNT)), nM, 2048 / BNT, pm, pn);
        A = (const u16*)(ws + O_YS) + aux * 512; lda = 2048; Bt = (const u16*)(ws + O_WBR) + (size_t)aux * 2048 * 512; ldb = 512; K = 512; mode = M_G4;
      } else if (step == 7) {
        tile_map(t, nM, 32, pm, pn);
        A = (const u16*)(ws + O_HN); lda = 2048;
        Bt = (l & 1) ? (const u16*)(ws + O_WINM1) : (const u16*)(ws + O_WIN) + (size_t)C_MG * 2048;
        ldb = 2048; K = 2048; mode = M_G1B; bmode = 1; ncol = 64;
      } else {
        tile_map(t, nM, 2048 / BNT, pm, pn);
        A = (const u16*)(ws + O_ACC); lda = 2048; Bt = (const u16*)(ws + O_WOUT); ldb = 2048; K = 2048; mode = M_G5;
      }
      if (step >= 6 && !need_ctx && (pm % 17) == 0) continue;
      gemm256(p, A, lda, Bt, ldb, K, pm * 256, pn * ncol, mode, aux, l, bmode);
    }
  }
}


#define XB_TMO      128
#define XB_XCNT(j)  (256  + 64 * (j))
#define XB_XSUB(j)  (1280 + 64 * (j))
#define XB_XGEN(j)  (2304 + 64 * (j))
#define XB_TOP      3328
#define XB_TOPGEN   3392
#define XCD_BAR_WORDS 3456
#define XB_SPIN_CAP (1u << 18)
#define LAS __attribute__((address_space(3)))
DEVI unsigned xb_ld(unsigned* p) { return __hip_atomic_load(p, __ATOMIC_RELAXED, __HIP_MEMORY_SCOPE_AGENT); }
DEVI unsigned xb_add(unsigned* p, unsigned v) { return __hip_atomic_fetch_add(p, v, __ATOMIC_RELAXED, __HIP_MEMORY_SCOPE_AGENT); }
DEVI unsigned xb_xcc_id() { return (unsigned)__builtin_amdgcn_s_getreg((3 << 11) | 20) & 0xFu; }
#define XB_SPIN(cond, bar) do { unsigned _sp = 0; while (cond) { __builtin_amdgcn_s_sleep(1); \
    if ((++_sp & 255u) == 0u) { if (xb_ld(&(bar)[XB_TMO])) break; if (_sp > XB_SPIN_CAP) { atomicAdd(&(bar)[XB_TMO], 1u); break; } } } } while (0)
struct XcdBarrier { unsigned* bar; unsigned x; volatile LAS unsigned* st; };
DEVI XcdBarrier xcd_barrier_post(unsigned* bar, volatile LAS unsigned* st) {
  XcdBarrier b; b.bar = bar; b.x = xb_xcc_id(); b.st = st;
  if (threadIdx.x == 0) (void)xb_add(&bar[XB_XCNT(b.x)], 1u);
  return b;
}
DEVI void xcd_barrier_complete(unsigned* bar, unsigned x, unsigned& nloc, unsigned& nx) {
  const unsigned G = gridDim.x * gridDim.y * gridDim.z;
  unsigned sum, cnt, mine, sp = 0u;
  for (;;) {
    sum = 0u; cnt = 0u; mine = 0u;
#pragma unroll
    for (unsigned j = 0; j < 16; ++j) { const unsigned c = xb_ld(&bar[XB_XCNT(j)]); sum += c; cnt += (c > 0u) ? 1u : 0u; mine = (j == x) ? c : mine; }
    if (sum == G) break;
    __builtin_amdgcn_s_sleep(1);
    if ((++sp & 255u) == 0u) { if (xb_ld(&bar[XB_TMO])) break; if (sp > XB_SPIN_CAP) { atomicAdd(&bar[XB_TMO], 1u); break; } }
  }
  nloc = mine > 0u ? mine : 1u; nx = cnt > 0u ? cnt : 1u;
}
DEVI void xcd_barrier(const XcdBarrier& b) {
  asm volatile("s_waitcnt vmcnt(0)" ::: "memory");
  __syncthreads();
  if (threadIdx.x == 0) {
    unsigned* bar = b.bar;
    __builtin_amdgcn_s_waitcnt(0);
    unsigned nloc = b.st[0], nx = b.st[1];
    if (nloc == 0u) { xcd_barrier_complete(bar, b.x, nloc, nx); b.st[0] = nloc; b.st[1] = nx; }
    const unsigned old = xb_add(&bar[XB_XSUB(b.x)], 1u);
    const unsigned gen = old / nloc;
    if (old + 1u == (gen + 1u) * nloc) {
      __builtin_amdgcn_fence(__ATOMIC_RELEASE, "agent");
      asm volatile("s_waitcnt vmcnt(0)" ::: "memory");
      const unsigned og = xb_add(&bar[XB_TOP], 1u);
      const unsigned tg = og / nx;
      if (og + 1u == (tg + 1u) * nx) xb_add(&bar[XB_TOPGEN], 1u);
      else XB_SPIN(xb_ld(&bar[XB_TOPGEN]) == tg, bar);
      __builtin_amdgcn_fence(__ATOMIC_ACQUIRE, "agent");
      xb_add(&bar[XB_XGEN(b.x)], 1u);
      asm volatile("s_waitcnt vmcnt(0)" ::: "memory");
    } else {
      XB_SPIN(xb_ld(&bar[XB_XGEN(b.x)]) == gen, bar);
      __builtin_amdgcn_fence(__ATOMIC_ACQUIRE, "agent");
      asm volatile("s_waitcnt vmcnt(0)" ::: "memory");
    }
  }
  __syncthreads();
}

__global__ void __launch_bounds__(NTHR) mega(P p) {
  cg::grid_group grid = cg::this_grid();
  __shared__ uint4 xb_words;
  unsigned* bar = (unsigned*)(p.ws + O_BAR);
  if (threadIdx.x == 0) xb_words = make_uint4(0u, 0u, 0u, 0u);
  if (blockIdx.x == 0) {
    for (int i = threadIdx.x; i < 4096; i += NTHR) bar[i] = 0u;
  }
  __syncthreads();
  if (PHM & 1) phase_mod_partial(p);
  grid.sync();
  XcdBarrier xb = xcd_barrier_post(bar, (volatile LAS unsigned*)&xb_words);
  if (PHM & 1) phase_mod_reduce(p);
  grid.sync();
  for (int ls2 = 0; ls2 < 36 * 2; ++ls2) {
    const int ls = ls2 >> 1;
    const int l = ls / 9, step = ls % 9;
    if ((ls2 & 1) && !((PROBE_DUP >> step) & 1)) continue;
    if (step == 0) { if (PHM & 4) phase_norm(p, l); }
    if (step == 2) { if (PHM & 8) phase_p2(p, l); }
    if (step == 1 || step == 3 || step >= 6) gemm_step(p, step, l);
    {
      const int bid = blockIdx.x, nb = gridDim.x;
      int wl = -1, wmode = 0, rank = bid, count = nb, mod = 1, lo = 0, width = 1, sub_lo = 0, sub_hi = 0;
      if (!(ls2 & 1)) {
        if (step == 0) { wl = l; wmode = (l == 0) ? 0 : 2; }
        else if ((step == 1 || step == 3 || step == 6) && l < 3 && nb == 256) {
          const int ntl = (step == 1) ? 68 * 29 : (step == 3) ? 68 * 9 : 4 * 68 * 8;
          const int rem = ntl - ((ntl + 255) / 256 - 1) * 256;
          const int pos = (bid & 7) * 32 + (bid >> 3);
          if (pos >= rem) {
            wl = l + 1; wmode = 3; rank = pos - rem; count = 256 - rem;
            sub_lo = (step == 1) ? 0 : (step == 3) ? 1660 : 3000;
            sub_hi = (step == 1) ? 1660 : (step == 3) ? 3000 : 4096;
          }
        }
        else if (step == 7 && l < 3) {
          wl = l + 1; wmode = (nb == 256) ? 1 : 4;
          if (nb == 256) {
            count = 128; mod = 5;
            if ((bid & 7) >= 4) { rank = (bid >> 3) * 4 + (bid & 7) - 4; lo = 4; width = 1; }
            else wl = -1;
          }
        } else if (step == 8 && l < 3 && nb == 256 && (bid & 7) != 0) {
          wl = l + 1; wmode = 1; rank = (bid >> 3) * 7 + (bid & 7) - 1; count = 224; mod = 5; lo = 0; width = 4;
        }
      }
      if (wl >= 0 && (PHM & 2)) phase_wprep(p, wl, wmode, rank, count, mod, lo, width, sub_lo, sub_hi);
    }
    if (step == 3) { if (PHM & 16) phase_m1(p); }
    if (step == 4) {
      if (PHM & 32) phase_m2(p);
      if (PHM & 64) phase_attn(p, l);
    }
    if (step == 5) { if (PHM & 128) phase_m3(p, l); }
    xcd_barrier(xb);
  }
  if (PHM & 4) phase_final(p);
}

extern "C" void kernel_launch(void* const* d_in, const int* in_sizes, int n_in, void* d_out, int out_size, void* d_ws,
                              size_t ws_size, hipStream_t stream) {
  static int grid_blocks = 0;
  if (!grid_blocks) {
    int dev = 0, cus = 0, per_cu = 0;
    hipGetDevice(&dev);
    hipDeviceGetAttribute(&cus, hipDeviceAttributeMultiprocessorCount, dev);
    hipFuncSetAttribute((const void*)mega, hipFuncAttributeMaxDynamicSharedMemorySize, SHM_BYTES);
    hipOccupancyMaxActiveBlocksPerMultiprocessor(&per_cu, mega, NTHR, SHM_BYTES);
    if (per_cu < 1) per_cu = 1;
    grid_blocks = cus * per_cu;
  }
  P p{};
  const float** pp = (const float**)&p;
  for (int i = 0; i < 21; ++i) pp[i] = (const float*)d_in[i];
  p.out = (float*)d_out;
  p.ws = (char*)d_ws;
  if (ws_size < O_TOTAL) fprintf(stderr, "workspace too small: %zu < %zu\n", ws_size, (size_t)O_TOTAL);
  void* args[] = {&p};
  hipError_t e = hipLaunchCooperativeKernel((void*)mega, dim3(grid_blocks), dim3(NTHR), args, SHM_BYTES, stream);
  if (e != hipSuccess) fprintf(stderr, "cooperative launch failed: %s (grid %d)\n", hipGetErrorString(e), grid_blocks);
}
```

```cpp
#include <hip/hip_runtime.h>
#include <hip/hip_bf16.h>
#include <hip/hip_cooperative_groups.h>
#include <cstdio>
namespace cg = cooperative_groups;

typedef unsigned short u16;
using bf16x8 = __attribute__((ext_vector_type(8))) short;
using bf16x4 = __attribute__((ext_vector_type(4))) short;
using f32x4 = __attribute__((ext_vector_type(4))) float;
typedef unsigned u32x4 __attribute__((ext_vector_type(4)));
#define DEVI __device__ __forceinline__

constexpr int D = 2048, NBATCH = 4, SEQ = 4096, CTXL = 256, TPB = 4352, NTOK = 17408, DIN = 15440, NP = 7424;
constexpr int C_AQ = 0, C_AK = 512, C_AV = 1024, C_AG = 1536, C_BI = 2048, C_BG = 2560, C_CQ = 3072, C_CKV = 3584,
              C_CKR = 4096, C_CG = 4160, C_DQ = 4672, C_DK = 5184, C_DV = 5696, C_DO = 6208, C_DIF = 6720,
              C_DG = 6736, C_MG = 7248;
constexpr float EPS = 1e-6f;
constexpr int NTHR = 512;
#ifndef PROBE_ZB
#define PROBE_ZB (-1)
#endif
#ifndef PROBE_US
#define PROBE_US 1.f
#endif
#ifndef G8
#define G8 1
#endif
#define BNT (G8 ? 256 : 128)
#ifndef PROBE_DUP
#define PROBE_DUP 0
#endif
#ifndef PHM
#define PHM 0xFFFF
#endif
constexpr int SHM_BYTES = 131072;

constexpr size_t al(size_t x) { return (x + 255) & ~size_t(255); }
constexpr size_t O_WIN = 0;
constexpr size_t O_WBR = O_WIN + al((size_t)DIN * 2048 * 2);
constexpr size_t O_WOUT = O_WBR + al((size_t)4 * 2048 * 512 * 2);
constexpr size_t O_WUQ = O_WOUT + al((size_t)2048 * 2048 * 2);
constexpr size_t O_WUKV = O_WUQ + al((size_t)768 * 512 * 2);
constexpr size_t O_POOL = O_WUKV + al((size_t)1024 * 512 * 2);
constexpr size_t O_MODP = O_POOL + al((size_t)512 * 512 * 2);
constexpr size_t O_MOD = O_MODP + al((size_t)4 * 16 * 5 * 6144 * 4);
constexpr size_t O_ROPE = O_MOD + al((size_t)4 * 5 * 6144 * 4);
constexpr size_t O_XC = O_ROPE + al(64 * 16 * 8);
constexpr size_t O_HN = O_XC + al((size_t)1024 * 2048 * 4);
constexpr size_t O_PROJ = O_HN + al((size_t)NTOK * 2048 * 2);
constexpr size_t O_QH = O_PROJ + al((size_t)NTOK * NP * 2);
constexpr size_t O_KH = O_QH + al((size_t)NTOK * 768 * 2);
constexpr size_t O_VTC = O_KH + al((size_t)NTOK * 768 * 2);
constexpr size_t O_END1 = O_VTC + al((size_t)NTOK * 512 * 2);
constexpr size_t O_YBR = O_PROJ;
static_assert((size_t)NTOK * 8192 * 2 <= O_END1 - O_PROJ, "ybr alias");
constexpr size_t O_VTA = O_END1;
constexpr size_t O_DPOOL = O_VTA + al((size_t)NTOK * 512 * 2);
constexpr size_t O_QKC = O_DPOOL + al((size_t)NTOK * 512 * 2);
constexpr size_t O_GL = O_QKC + al((size_t)NTOK * 1024 * 2);
constexpr size_t O_RINV = O_GL + al((size_t)NTOK * 16 * 4);
constexpr size_t O_YS = O_RINV + al((size_t)NTOK * 2 * 4);
constexpr size_t O_ACC = O_YS + al((size_t)NTOK * 2048 * 2);
constexpr int NITEM = 32 * 68;
constexpr size_t O_KLOC = O_ACC + al((size_t)NTOK * 2048 * 2);
constexpr size_t O_NLOC = O_KLOC + al((size_t)NITEM * 16384 * 4);
constexpr size_t O_SC = O_NLOC + al((size_t)NITEM * 128 * 4);
constexpr size_t O_CIN = O_SC + al((size_t)NITEM * 2 * 4);
constexpr size_t O_NIN = O_CIN + al((size_t)NITEM * 16384 * 2);
constexpr size_t O_MIN = O_NIN + al((size_t)NITEM * 128 * 4);
constexpr size_t O_WINM1 = O_MIN + al((size_t)NITEM * 4);
constexpr size_t O_BAR = O_WINM1 + al((size_t)8192 * 2048 * 2);
constexpr size_t O_TOTAL = O_BAR + al(4096 * 4);
static_assert(O_TOTAL < 1000000000ull, "workspace budget");

struct P {
  const float *x, *c, *ctx, *c_ctx, *norm_g, *w_mod, *b_mod, *w_in, *na_rpb, *pool_w, *pool_scale, *mla_gq, *mla_gkv,
      *w_uq, *w_ukv, *conv_w, *b_if, *ml_gnorm, *w_br, *w_out, *g_final;
  float* out;
  char* ws;
};

extern __shared__ __attribute__((aligned(16))) char shm[];

DEVI u16 f2bf(float f) {
  unsigned u = __float_as_uint(f);
  u += 0x7fffu + ((u >> 16) & 1u);
  return (u16)(u >> 16);
}
typedef __bf16 bf2_t __attribute__((ext_vector_type(2)));
typedef float fl2_t __attribute__((ext_vector_type(2)));
DEVI unsigned pk2(float a, float b) {
  fl2_t v = {a, b};
  bf2_t r = __builtin_convertvector(v, bf2_t);
  return *(unsigned*)&r;
}
DEVI float bf2f(u16 h) { return __uint_as_float(((unsigned)h) << 16); }
DEVI float bfs(short h) { return __uint_as_float(((unsigned)(u16)h) << 16); }
DEVI float silu_f(float x) { return x / (1.f + __expf(-x)); }
DEVI float sigm_f(float x) { return 1.f / (1.f + __expf(-x)); }
DEVI int opqv(int x) { asm volatile("" : "+v"(x)); return x; }
DEVI int opqs(int x) { asm volatile("" : "+s"(x)); return x; }
DEVI size_t opqz() { size_t z = 0; asm volatile("" : "+s"(z)); return z; }
#define opqp(x) ((x) + opqz())
#define SHX(v, m) __int_as_float(__builtin_amdgcn_ds_bpermute(((LANE ^ (m)) << 2), __float_as_int(v)))
#define LDS_BAR() do { asm volatile("s_waitcnt lgkmcnt(0)" ::: "memory"); __builtin_amdgcn_s_barrier(); asm volatile("" ::: "memory"); } while (0)
#define OPQ_IDS const int TIDX = opqv((int)threadIdx.x); const int BIDX = opqs((int)blockIdx.x); const int LANE = TIDX & 63; (void)TIDX; (void)BIDX; (void)LANE;
#define wave_sum(v) wave_sum_l((v), LANE)
DEVI float wave_sum_l(float v, int LANE) {
#pragma unroll
  for (int o = 32; o > 0; o >>= 1) v += SHX(v, o);
  return v;
}

DEVI void ld8(const u16* ptr, float* f) {
  bf16x8 v = *(const bf16x8*)ptr;
#pragma unroll
  for (int i = 0; i < 8; ++i) f[i] = bfs(v[i]);
}
DEVI void st8(u16* ptr, const float* f) {
  bf16x8 v;
#pragma unroll
  for (int i = 0; i < 8; ++i) v[i] = (short)f2bf(f[i]);
  *(bf16x8*)ptr = v;
}
constexpr int BM = 256, BK = 64, HALF = 128, HT = HALF * BK;

DEVI int lds_byte(int r, int c) {
  int st = (r >> 4) * 2 + (c >> 5), rr = r & 15, cc = c & 31, ob = rr * 64 + cc * 2;
  return st * 1024 + (ob ^ (((ob >> 9) & 1) << 5));
}
DEVI void stage_rc(int b, int& R, int& C) {
  int st = b / 1024, sb = b % 1024, swz = sb ^ (((sb >> 9) & 1) << 5);
  R = (st >> 1) * 16 + swz / 64;
  C = (st & 1) * 32 + (swz % 64) / 2;
}

enum { M_G1A = 0, M_G2, M_G3, M_POOL, M_G4, M_G1B, M_G5 };

DEVI void gemm256(const P& p, const u16* A, int lda, const u16* Bt, int ldb, int K, int brow, int bcol, int mode,
                        int aux, int layer, int bmode) {
  OPQ_IDS
  if (!(PHM & 256)) return;
  u16* shmb = (u16*)shm;
#define SA(b, h) (shmb + ((b)*2 + (h)) * HT)
#if G8
#define SB(b, h) (shmb + (4 + (b)*2 + (h)) * HT)
#else
#define SB(b, h) (shmb + (4 + (b)) * HT)
#endif
#define LDSP(x) ((__attribute__((address_space(3))) void*)(x))
#define STAGEA(Pp, br, kt)                                                                                     \
  do {                                                                                                         \
    const int _so = ((br) * lda + (kt)*BK) * 2;                                                                \
    __builtin_amdgcn_raw_ptr_buffer_load_lds(rsA, LDSP((char*)(Pp) + TIDX * 16), 16, offA0, _so, 0, 0);       \
    __builtin_amdgcn_raw_ptr_buffer_load_lds(rsA, LDSP((char*)(Pp) + TIDX * 16 + 8192), 16, offA1, _so, 0, 0);\
  } while (0)
#define STAGEB(Pp, br, kt)                                                                                     \
  do {                                                                                                         \
    const int _so = ((br) * ldb + (kt)*BK) * 2;                                                                \
    __builtin_amdgcn_raw_ptr_buffer_load_lds(rsB, LDSP((char*)(Pp) + TIDX * 16), 16, offB0, _so, 0, 0);       \
    __builtin_amdgcn_raw_ptr_buffer_load_lds(rsB, LDSP((char*)(Pp) + TIDX * 16 + 8192), 16, offB1, _so, 0, 0);\
  } while (0)
#define LDA(dst, b, h)                                                                                         \
  for (int m = 0; m < 4; ++m)                                                                                  \
    for (int k = 0; k < 2; ++k)                                                                                \
  dst[m][k] = *reinterpret_cast<const bf16x8*>((char*)SA(b, h) + lds_byte(wr * 64 + m * 16 + fr, k * 32 + fq * 8))
#define LDB(dst, b, h)                                                                                         \
  for (int n = 0; n < 2; ++n)                                                                                  \
    for (int k = 0; k < 2; ++k)                                                                                \
  dst[n][k] = *reinterpret_cast<const bf16x8*>((char*)SB(b, h) + lds_byte(wc * 32 + n * 16 + fr, k * 32 + fq * 8))
#define MMA(ai, bj, At, Btf)                                                                                   \
  do {                                                                                                         \
    __builtin_amdgcn_s_setprio(1);                                                                             \
    for (int m = 0; m < 4; ++m)                                                                                \
      for (int n = 0; n < 2; ++n)                                                                              \
        for (int k = 0; k < 2; ++k)                                                                            \
          acc[ai][bj][m][n] = __builtin_amdgcn_mfma_f32_16x16x32_bf16(Btf[n][k], At[m][k], acc[ai][bj][m][n], 0, 0, 0); \
    __builtin_amdgcn_s_setprio(0);                                                                             \
  } while (0)
#define WAIT_V(n) asm volatile("s_waitcnt vmcnt(" #n ")" ::: "memory")
#define WAIT_L(n) asm volatile("s_waitcnt lgkmcnt(" #n ")" ::: "memory")
#define BAR __builtin_amdgcn_s_barrier()
#define SCHED __builtin_amdgcn_sched_barrier(0)

  int wid = TIDX >> 6, lane = TIDX & 63, wr = wid >> 2, wc = wid & 3, fr = lane & 15, fq = lane >> 4;
#if G8
  f32x4 acc[2][2][4][2] = {};
  bf16x8 At[4][2], B0[2][2], B1[2][2];
#else
  f32x4 acc[2][1][4][2] = {};
  bf16x8 At[4][2], B0[2][2];
#endif
  int nt = K / BK;
  const int bhalf = bmode ? 4096 : HALF;
  int offA0, offA1, offB0, offB1;
  __amdgpu_buffer_rsrc_t rsA = __builtin_amdgcn_make_buffer_rsrc((void*)A, 0, 0x7fffffff, 0x00020000);
  __amdgpu_buffer_rsrc_t rsB = __builtin_amdgcn_make_buffer_rsrc((void*)Bt, 0, 0x7fffffff, 0x00020000);
  {
    int r0, c0, r1, c1;
    stage_rc(TIDX * 16, r0, c0);
    stage_rc(TIDX * 16 + 8192, r1, c1);
    offA0 = (r0 * lda + c0) * 2; offA1 = (r1 * lda + c1) * 2;
    offB0 = (r0 * ldb + c0) * 2; offB1 = bmode ? offB0 + 2048 * ldb * 2 : (r1 * ldb + c1) * 2;
  }
#if G8
  STAGEB(SB(0, 0), bcol, 0);
  STAGEA(SA(0, 0), brow, 0);
  STAGEB(SB(0, 1), bcol + bhalf, 0);
  STAGEA(SA(0, 1), brow + HALF, 0);
  if (wr == 1) BAR;
  WAIT_V(4);
  BAR;
  STAGEB(SB(1, 0), bcol, 1);
  STAGEA(SA(1, 0), brow, 1);
  STAGEB(SB(1, 1), bcol + bhalf, 1);
  WAIT_V(6);
  BAR;
  for (int t = 0; t < nt - 2; t += 2) {
    LDB(B0, 0, 0); SCHED; LDA(At, 0, 0); STAGEA(SA(1, 1), brow + HALF, t + 1);
    WAIT_L(8); BAR; WAIT_L(0); MMA(0, 0, At, B0); BAR; SCHED;
    LDB(B1, 0, 1); STAGEB(SB(0, 0), bcol, t + 2);
    BAR; WAIT_L(0); MMA(0, 1, At, B1); BAR;
    LDA(At, 0, 1); STAGEA(SA(0, 0), brow, t + 2);
    BAR; WAIT_L(0); MMA(1, 0, At, B0); BAR; SCHED;
    STAGEB(SB(0, 1), bcol + bhalf, t + 2);
    WAIT_V(6); BAR; MMA(1, 1, At, B1); BAR;
    LDB(B0, 1, 0); SCHED; LDA(At, 1, 0); STAGEA(SA(0, 1), brow + HALF, t + 2);
    WAIT_L(8); BAR; WAIT_L(0); MMA(0, 0, At, B0); BAR; SCHED;
    LDB(B1, 1, 1); STAGEB(SB(1, 0), bcol, t + 3);
    BAR; WAIT_L(0); MMA(0, 1, At, B1); BAR;
    LDA(At, 1, 1); STAGEA(SA(1, 0), brow, t + 3);
    BAR; WAIT_L(0); MMA(1, 0, At, B0); BAR; SCHED;
    STAGEB(SB(1, 1), bcol + bhalf, t + 3);
    WAIT_V(6); BAR; MMA(1, 1, At, B1); BAR;
  }
  {
    LDB(B0, 0, 0); LDA(At, 0, 0); STAGEA(SA(1, 1), brow + HALF, nt - 1);
    BAR; WAIT_L(0); MMA(0, 0, At, B0); BAR;
    LDB(B1, 0, 1); BAR; WAIT_L(0); MMA(0, 1, At, B1); BAR;
    LDA(At, 0, 1); WAIT_V(4); BAR; WAIT_L(0); MMA(1, 0, At, B0); MMA(1, 1, At, B1); BAR;
  }
  {
    LDB(B0, 1, 0); LDA(At, 1, 0); WAIT_V(2); BAR; WAIT_L(0); MMA(0, 0, At, B0); BAR;
    LDB(B1, 1, 1); WAIT_V(0); BAR; WAIT_L(0); MMA(0, 1, At, B1); BAR;
    LDA(At, 1, 1); BAR; WAIT_L(0); MMA(1, 0, At, B0); MMA(1, 1, At, B1); BAR;
  }
  if (wr == 0) BAR;
#else
  STAGEB(SB(0, 0), bcol, 0);
  STAGEA(SA(0, 0), brow, 0);
  STAGEA(SA(0, 1), brow + HALF, 0);
  WAIT_V(0);
  BAR;
  for (int t = 0; t < nt; t += 2) {
    STAGEB(SB(1, 0), bcol, t + 1);
    STAGEA(SA(1, 0), brow, t + 1);
    STAGEA(SA(1, 1), brow + HALF, t + 1);
    LDB(B0, 0, 0); LDA(At, 0, 0); WAIT_L(0); MMA(0, 0, At, B0);
    LDA(At, 0, 1); WAIT_L(0); MMA(1, 0, At, B0);
    WAIT_V(0);
    BAR;
    if (t + 2 < nt) {
      STAGEB(SB(0, 0), bcol, t + 2);
      STAGEA(SA(0, 0), brow, t + 2);
      STAGEA(SA(0, 1), brow + HALF, t + 2);
    }
    LDB(B0, 1, 0); LDA(At, 1, 0); WAIT_L(0); MMA(0, 0, At, B0);
    LDA(At, 1, 1); WAIT_L(0); MMA(1, 0, At, B0);
    WAIT_V(0);
    BAR;
  }
#endif
  char* ws = opqp(p.ws);
  const int bb = brow / TPB;
  const int trow = brow - bb * TPB;
  u16* stg = (u16*)shm;
  const int tid = TIDX;
#define SWZ(r, c) ((c) ^ ((r)&15) ^ (((c)&1) << 4))
#pragma unroll
  for (int ai = 0; ai < 2; ++ai)
#pragma unroll
    for (int bj = 0; bj < (G8 ? 2 : 1); ++bj)
#pragma unroll
      for (int m = 0; m < 4; ++m)
#pragma unroll
        for (int n = 0; n < 2; ++n) {
          const int R = ai * HALF + wr * 64 + m * 16 + fr;
          const int chunk = bj * 16 + wc * 4 + n * 2 + (fq >> 1);
          f32x4 v = acc[ai][bj][m][n];
          uint2 pk = make_uint2(pk2(v[0], v[1]), pk2(v[2], v[3]));
          *(uint2*)(stg + R * 256 + SWZ(R, chunk) * 8 + (fq & 1) * 4) = pk;
        }
  LDS_BAR();
  if (mode == M_G1B) {
#pragma unroll 1
    for (int it = 0; it < 4; ++it) {
      const int R = it * 64 + (tid >> 3), co = tid & 7;
      const int row = brow + R, ocol = bcol + co * 8;
      float sum[8] = {0, 0, 0, 0, 0, 0, 0, 0};
#pragma unroll
      for (int br = 0; br < 4; ++br) {
        const int c = br * 8 + co;
        bf16x8 g = *(const bf16x8*)(stg + R * 256 + SWZ(R, c) * 8);
        float yb[8];
        ld8((const u16*)(ws + O_YBR) + (size_t)row * 8192 + br * 2048 + ocol, yb);
#pragma unroll
        for (int e = 0; e < 8; ++e) sum[e] += (br == PROBE_ZB) ? 0.f : sigm_f(bfs(g[e])) * yb[e];
      }
      st8((u16*)(ws + O_ACC) + (size_t)row * 2048 + ocol, sum);
    }
  } else {
    bool tr0 = false, tr1 = false;
    if (mode == M_G1A) { tr0 = bcol >= C_AV && bcol < C_AG; tr1 = bcol + HALF >= C_AV && bcol + HALF < C_AG; }
    else if (mode == M_G3) { tr1 = true; }
#pragma unroll 4
    for (int it = 0; it < 16; ++it) {
      const int R = it * 16 + (tid >> 5), c = tid & 31;
      if ((c < 16) ? tr0 : tr1) continue;
      const int row = brow + R, col = bcol + c * 8;
      bf16x8 raw = *(const bf16x8*)(stg + R * 256 + SWZ(R, c) * 8);
      if (mode == M_G1A) {
        *(bf16x8*)((u16*)(ws + O_PROJ) + (size_t)row * NP + col) = raw;
      } else if (mode == M_G4) {
        *(bf16x8*)((u16*)(ws + O_YBR) + (size_t)row * 8192 + aux * 2048 + col) = raw;
      } else {
        float v[8];
#pragma unroll
        for (int e = 0; e < 8; ++e) v[e] = bfs(raw[e]);
        if (mode == M_G2) {
          float rs = ((const float*)(ws + O_RINV))[row * 2];
#pragma unroll
          for (int e = 0; e < 8; ++e) v[e] *= rs;
          st8((u16*)(ws + O_QH) + (size_t)row * 768 + col, v);
        } else if (mode == M_G3) {
          float rs = ((const float*)(ws + O_RINV))[row * 2 + 1];
#pragma unroll
          for (int e = 0; e < 8; ++e) v[e] *= rs;
          st8((u16*)(ws + O_KH) + ((size_t)(bb * 4 + (col >> 8)) * TPB + (trow + R)) * 192 + (col & 255), v);
        } else if (mode == M_POOL) {
          float g[8];
          ld8((const u16*)(ws + O_PROJ) + (size_t)row * NP + C_BG + col, g);
#pragma unroll
          for (int e = 0; e < 8; ++e) {
            float y = bf2f(f2bf(v[e] * p.pool_scale[layer * 512 + col + e]));
            v[e] = y * silu_f(g[e]);
          }
          st8((u16*)(ws + O_YS) + (size_t)row * 2048 + 512 + col, v);
        } else {
          float* xb;
          const float* gv;
          const float* xs;
          if (trow == 0) {
            xb = (float*)(ws + O_XC) + ((size_t)bb * CTXL + R) * D + col;
            xs = (layer == 0) ? p.ctx + ((size_t)bb * CTXL + R) * D + col : xb;
            gv = (const float*)(ws + O_MOD) + ((size_t)layer * 5 + 4) * 6144 + 4096 + col;
          } else {
            xb = p.out + ((size_t)bb * SEQ + (trow - CTXL) + R) * D + col;
            xs = (layer == 0) ? p.x + ((size_t)bb * SEQ + (trow - CTXL) + R) * D + col : xb;
            gv = (const float*)(ws + O_MOD) + ((size_t)layer * 5 + bb) * 6144 + 4096 + col;
          }
          f32x4 x0 = *(const f32x4*)xs, x1 = *(const f32x4*)(xs + 4);
          f32x4 g0 = *(const f32x4*)gv, g1 = *(const f32x4*)(gv + 4);
#pragma unroll
          for (int e = 0; e < 4; ++e) { x0[e] += PROBE_US * g0[e] * v[e]; x1[e] += PROBE_US * g1[e] * v[4 + e]; }
          *(f32x4*)xb = x0;
          *(f32x4*)(xb + 4) = x1;
        }
      }
    }
#pragma unroll 1
    for (int hj = 0; hj < 2; ++hj) {
      if (!(hj ? tr1 : tr0)) continue;
      const int gc = bcol + hj * HALF;
      u16* tdst;
      if (mode == M_G1A) tdst = (u16*)(ws + O_VTA) + ((size_t)(bb * 512 + (gc - C_AV))) * TPB + trow;
      else tdst = (u16*)(ws + O_VTC) + ((size_t)((bb * 4 + (gc >> 8)) * 128)) * TPB + trow;
      const int cl = tid & 127, rg = tid >> 7;
      const int ct = hj * HALF + cl;
#pragma unroll 1
      for (int i = 0; i < 8; ++i) {
        const int r0 = rg * 64 + i * 8;
        float v[8];
#pragma unroll
        for (int e = 0; e < 8; ++e) {
          const int r = r0 + e;
          v[e] = bf2f(stg[r * 256 + SWZ(r, ct >> 3) * 8 + (ct & 7)]);
          if (mode == M_G3) v[e] *= ((const float*)(ws + O_RINV))[(brow + r) * 2 + 1];
        }
        st8(tdst + (size_t)cl * TPB + r0, v);
      }
    }
  }
  LDS_BAR();
#undef SWZ
}

DEVI int xcd_remap(int t, int bid, int nblk) {
  if (nblk != 256) return t;
  int r = t / 256;
  return r * 256 + (bid & 7) * 32 + (bid >> 3);
}
DEVI void tile_map(int v, int nM, int nN, int& pm, int& pn) {
  int per = 4 * nN, band = v / per, idx = v % per;
  pm = band * 4 + (idx & 3);
  pn = idx >> 2;
}

struct WItem {
  const float* src; const float* kscale; u16* dst;
  int ldsrc, K, N, k0, n0, kind;
};
DEVI WItem wdecode(const P& p, char* ws, int l, int t, int tend, u16* wmerge) {
  constexpr int T_WIN1 = 32 * 114, T_WIN2 = 32 * 128, T_WBR = 4 * 8 * 32, T_WUQ = 8 * 12, T_WUKV = 8 * 16, T_POOL = 64;
  WItem w;
  w.kscale = nullptr; w.kind = 0; w.src = nullptr; w.dst = nullptr; w.ldsrc = 0; w.K = 0; w.N = 0; w.k0 = 0; w.n0 = 0;
  if (t >= tend) { w.kind = -1; return w; }
  int i = t;
  if (i < T_WIN1) {
    w.src = p.w_in + (size_t)l * 2048 * DIN; w.ldsrc = DIN; w.K = 2048; w.N = C_MG; w.dst = (u16*)(ws + O_WIN);
    w.k0 = (i & 31) * 64; w.n0 = (i >> 5) * 64; return w;
  }
  i -= T_WIN1;
  if (i < T_WIN2) {
    w.src = p.w_in + (size_t)l * 2048 * DIN + C_MG; w.ldsrc = DIN; w.K = 2048; w.N = 8192; w.dst = wmerge;
    w.k0 = (i & 31) * 64; w.n0 = (i >> 5) * 64; return w;
  }
  i -= T_WIN2;
  if (i < T_WBR) {
    int br = i >> 8, r = i & 255;
    w.src = p.w_br + ((size_t)l * 4 + br) * 512 * 2048; w.ldsrc = 2048; w.K = 512; w.N = 2048;
    w.dst = (u16*)(ws + O_WBR) + (size_t)br * 2048 * 512; w.k0 = (r & 7) * 64; w.n0 = (r >> 3) * 64; return w;
  }
  i -= T_WBR;
  if (i < T_WUQ) {
    w.src = p.w_uq + (size_t)l * 512 * 768; w.ldsrc = 768; w.K = 512; w.N = 768; w.dst = (u16*)(ws + O_WUQ);
    w.kscale = p.mla_gq + l * 512; w.k0 = (i & 7) * 64; w.n0 = (i >> 3) * 64; return w;
  }
  i -= T_WUQ;
  if (i < T_WUKV) {
    w.src = p.w_ukv + (size_t)l * 512 * 1024; w.ldsrc = 1024; w.K = 512; w.N = 1024; w.dst = (u16*)(ws + O_WUKV);
    w.kscale = p.mla_gkv + l * 512; w.k0 = (i & 7) * 64; w.n0 = (i >> 3) * 64; return w;
  }
  i -= T_WUKV;
  if (i < T_POOL) { w.kind = 1; w.n0 = i; return w; }
  i -= T_POOL;
  w.src = p.w_out + (size_t)l * 2048 * 2048; w.ldsrc = 2048; w.K = 2048; w.N = 2048; w.dst = (u16*)(ws + O_WOUT);
  w.k0 = (i & 31) * 64; w.n0 = (i >> 5) * 64;
  return w;
}
DEVI void wload(const WItem& w, float4 (&v)[2], int tid) {
#pragma unroll
  for (int it = 0; it < 2; ++it) {
    int i = tid + it * NTHR, tr = i >> 4, c4 = (i & 15) * 4;
    float4 x = make_float4(0.f, 0.f, 0.f, 0.f);
    if (w.n0 + c4 < w.N) x = *(const float4*)(w.src + (size_t)(w.k0 + tr) * w.ldsrc + w.n0 + c4);
    if (w.kscale) { float sc = w.kscale[w.k0 + tr]; x.x *= sc; x.y *= sc; x.z *= sc; x.w *= sc; }
    v[it] = x;
  }
}

__device__ void phase_wprep(const P& p, int l, int wmode, int rank, int count, int mod, int lo, int width, int sub_lo,
                            int sub_hi) {
  OPQ_IDS
  char* ws = opqp(p.ws);
  constexpr int T_W1 = 32 * 114, T_W2 = 32 * 128;
  constexpr int T_A = T_W1 + T_W2 + 4 * 8 * 32 + 8 * 12 + 8 * 16 + 64, T_WOUT = 32 * 32;
  const int ubeg = (wmode == 2) ? T_A : (wmode == 3) ? sub_lo : 0;
  const int uend = (wmode == 1) ? T_A - T_W2 : (wmode == 3) ? sub_hi : (wmode == 4) ? T_A : T_A + T_WOUT;
  const int tend = T_A + T_WOUT;
#define WMAP(u) ((u) >= uend ? tend : (wmode == 1) ? ((u) < T_W1 ? (u) : (u) + T_W2) : (wmode == 3) ? T_W1 + (u) : (u))
  u16* wmerge = (l & 1) ? (u16*)(ws + O_WINM1) : (u16*)(ws + O_WIN) + (size_t)C_MG * 2048;
  float* tiles = (float*)shm;
  int g = rank, par = 0;
  WItem cur = wdecode(p, ws, l, WMAP(ubeg + (g / width) * mod + lo + g % width), tend, wmerge);
  float4 v[2] = {make_float4(0.f, 0.f, 0.f, 0.f), make_float4(0.f, 0.f, 0.f, 0.f)};
  __syncthreads();
  if (cur.kind == 0) wload(cur, v, TIDX);
  while (cur.kind >= 0) {
    g += count;
    WItem nxt = wdecode(p, ws, l, WMAP(ubeg + (g / width) * mod + lo + g % width), tend, wmerge);
    float4 vn[2] = {make_float4(0.f, 0.f, 0.f, 0.f), make_float4(0.f, 0.f, 0.f, 0.f)};
    if (nxt.kind == 0) wload(nxt, vn, TIDX);
    if (cur.kind == 0) {
      float* tile = tiles + par * (64 * 65);
      par ^= 1;
#pragma unroll
      for (int it = 0; it < 2; ++it) {
        int i = TIDX + it * NTHR, tr = i >> 4, c4 = (i & 15) * 4;
        float* tp = tile + tr * 65 + c4;
        tp[0] = v[it].x; tp[1] = v[it].y; tp[2] = v[it].z; tp[3] = v[it].w;
      }
      __syncthreads();
      int tn = TIDX & 63, tk = (TIDX >> 6) * 8;
      if (cur.n0 + tn < cur.N) {
        bf16x8 o;
#pragma unroll
        for (int e = 0; e < 8; ++e) o[e] = (short)f2bf(tile[(tk + e) * 65 + tn]);
        *(bf16x8*)(cur.dst + (size_t)(cur.n0 + tn) * cur.K + cur.k0 + tk) = o;
      }
    } else {
      u16* dst = (u16*)(ws + O_POOL);
      for (int e = TIDX; e < 4096; e += NTHR) {
        int idx = cur.n0 * 4096 + e, n = idx >> 9, k = idx & 511;
        int gg = n >> 7, g2 = k >> 7;
        float x = 0.f;
        if (gg == g2) x = p.pool_w[(((size_t)l * 4 + gg) * 128 + (k & 127)) * 128 + (n & 127)];
        dst[idx] = f2bf(x);
      }
    }
    cur = nxt;
    v[0] = vn[0];
    v[1] = vn[1];
  }
  __syncthreads();
}
#undef WMAP

__device__ void phase_mod_partial(const P& p) {
  OPQ_IDS
  float* sl = (float*)shm;
  float* modp = (float*)(p.ws + O_MODP);
  for (int t = BIDX; t < 4 * 24 * 16; t += gridDim.x) {
    int l = t / 384, r = t % 384, nb = r / 16, ks = r % 16;
    __syncthreads();
    for (int i = TIDX; i < 640; i += NTHR) {
      int v = i >> 7, k = i & 127;
      float cv = (v < 4) ? p.c[v * 2048 + ks * 128 + k] : p.c_ctx[ks * 128 + k];
      sl[i] = silu_f(cv);
    }
    __syncthreads();
    int col = TIDX & 255, kh = TIDX >> 8;
    float a[5] = {0, 0, 0, 0, 0};
    const float* w = p.w_mod + ((size_t)l * 2048 + ks * 128 + kh * 64) * 6144 + nb * 256 + col;
#pragma unroll 4
    for (int k = 0; k < 64; ++k) {
      float wv = w[(size_t)k * 6144];
#pragma unroll
      for (int v = 0; v < 5; ++v) a[v] += sl[v * 128 + kh * 64 + k] * wv;
    }
    __syncthreads();
    float* part = sl + 1024;
    if (kh == 1) {
#pragma unroll
      for (int v = 0; v < 5; ++v) part[v * 256 + col] = a[v];
    }
    __syncthreads();
    if (kh == 0) {
#pragma unroll
      for (int v = 0; v < 5; ++v)
        modp[(((size_t)l * 16 + ks) * 5 + v) * 6144 + nb * 256 + col] = a[v] + part[v * 256 + col];
    }
  }
  float2* rt = (float2*)(p.ws + O_ROPE);
  for (int i = BIDX * NTHR + TIDX; i < 1024; i += gridDim.x * NTHR) {
    int pos = i >> 4, j = i & 15;
    float inv = powf(10000.f, -(float)j / 16.f);
    float ang = (float)pos * inv;
    rt[i] = make_float2(cosf(ang), sinf(ang));
  }
}
__device__ void phase_mod_reduce(const P& p) {
  OPQ_IDS
  const float* modp = (const float*)(p.ws + O_MODP);
  float* mod = (float*)(p.ws + O_MOD);
  for (int i = BIDX * NTHR + TIDX; i < 4 * 5 * 6144; i += gridDim.x * NTHR) {
    int l = i / 30720, r = i % 30720, n = r % 6144;
    float s = p.b_mod[l * 6144 + n];
    for (int ks = 0; ks < 16; ++ks) s += modp[((size_t)l * 16 + ks) * 30720 + r];
    mod[i] = s;
  }
}

DEVI float* xrow_ptr(const P& p, int r) {
  int b = r / TPB, t = r - b * TPB;
  return (t < CTXL) ? (float*)(p.ws + O_XC) + ((size_t)b * CTXL + t) * D : p.out + ((size_t)b * SEQ + (t - CTXL)) * D;
}
__device__ void phase_norm(const P& p, int l) {
  OPQ_IDS
  int lane = TIDX & 63, gw = BIDX * 8 + (TIDX >> 6), nw = gridDim.x * 8;
  const float* mod = (const float*)(p.ws + O_MOD);
  u16* hn = (u16*)(p.ws + O_HN);
  for (int r = gw; r < NTOK; r += nw) {
    int b = r / TPB, t = r - b * TPB;
    float* xr = xrow_ptr(p, r);
    const float* src = xr;
    if (l == 0) src = (t < CTXL) ? p.ctx + ((size_t)b * CTXL + t) * D : p.x + ((size_t)b * SEQ + (t - CTXL)) * D;
    const float* mv = mod + ((size_t)l * 5 + (t < CTXL ? 4 : b)) * 6144;
    float4 v[8];
    float ss = 0.f;
#pragma unroll
    for (int i = 0; i < 8; ++i) {
      v[i] = *(const float4*)(src + i * 256 + lane * 4);
      ss += v[i].x * v[i].x + v[i].y * v[i].y + v[i].z * v[i].z + v[i].w * v[i].w;
    }
    ss = wave_sum(ss);
    float rs = rsqrtf(ss * (1.f / D) + EPS);
#pragma unroll
    for (int i = 0; i < 8; ++i) {
      int c0 = i * 256 + lane * 4;
      float4 g = *(const float4*)(p.norm_g + l * D + c0);
      float4 sh = *(const float4*)(mv + c0);
      float4 sc = *(const float4*)(mv + 2048 + c0);
      unsigned a0 = f2bf(v[i].x * rs * g.x * (1.f + sc.x) + sh.x), a1 = f2bf(v[i].y * rs * g.y * (1.f + sc.y) + sh.y);
      unsigned a2 = f2bf(v[i].z * rs * g.z * (1.f + sc.z) + sh.z), a3 = f2bf(v[i].w * rs * g.w * (1.f + sc.w) + sh.w);
      uint2 o = make_uint2(a0 | (a1 << 16), a2 | (a3 << 16));
      *(uint2*)(hn + (size_t)r * D + c0) = o;
    }
  }
}
__device__ void phase_final(const P& p) {
  OPQ_IDS
  int lane = TIDX & 63, gw = BIDX * 8 + (TIDX >> 6), nw = gridDim.x * 8;
  for (int r = gw; r < NBATCH * SEQ; r += nw) {
    float* xr = p.out + (size_t)r * D;
    float4 v[8];
    float ss = 0.f;
#pragma unroll
    for (int i = 0; i < 8; ++i) {
      v[i] = *(const float4*)(xr + i * 256 + lane * 4);
      ss += v[i].x * v[i].x + v[i].y * v[i].y + v[i].z * v[i].z + v[i].w * v[i].w;
    }
    ss = wave_sum(ss);
    float rs = rsqrtf(ss * (1.f / D) + EPS);
#pragma unroll
    for (int i = 0; i < 8; ++i) {
      int c0 = i * 256 + lane * 4;
      float4 g = *(const float4*)(p.g_final + c0);
      *(float4*)(xr + c0) = make_float4(v[i].x * rs * g.x, v[i].y * rs * g.y, v[i].z * rs * g.z, v[i].w * rs * g.w);
    }
  }
}

__device__ void phase_p2(const P& p, int l) {
  OPQ_IDS
  int lane = TIDX & 63, gw = xcd_remap(BIDX, BIDX, gridDim.x) * 8 + (TIDX >> 6), nw = gridDim.x * 8;
  char* ws = opqp(p.ws);
  const u16* proj = (const u16*)(ws + O_PROJ);
  float* rinv = (float*)(ws + O_RINV);
  const float2* rt = (const float2*)(ws + O_ROPE);
  float cw[2][4][8];
#pragma unroll
  for (int part = 0; part < 2; ++part)
#pragma unroll
    for (int j = 0; j < 4; ++j) {
      const float* cp = p.conv_w + ((size_t)l * 4 + j) * 1024 + part * 512 + lane * 8;
      f32x4 c0 = *(const f32x4*)cp, c1 = *(const f32x4*)(cp + 4);
#pragma unroll
      for (int i = 0; i < 4; ++i) { cw[part][j][i] = c0[i]; cw[part][j][4 + i] = c1[i]; }
    }
  const float bif = (lane < 16) ? p.b_if[l * 16 + lane] : 0.f;
  const bf16x8 z8 = {0, 0, 0, 0, 0, 0, 0, 0};
  for (int r = gw; r < NTOK; r += nw) {
    int b = r / TPB, t = r - b * TPB;
    const bool isctx = t < CTXL;
    const int pos = isctx ? t : t - CTXL;
    const int n = isctx ? CTXL : SEQ;
    const u16* pr = proj + (size_t)r * NP;
    const bf16x8 vq = *(const bf16x8*)(pr + C_CQ + lane * 8);
    const bf16x8 vkv = *(const bf16x8*)(pr + C_CKV + lane * 8);
    const u16 kro = pr[C_CKR + lane], krp = pr[C_CKR + (lane ^ 16)];
    const u16 dif = pr[C_DIF + (lane & 15)];
    const int g = lane >> 4, w = 2 << g;
    const int lo = max(pos - w / 2, 0), hi = min(pos + (w - 1 - w / 2), n - 1);
    bf16x8 wv[16];
#pragma unroll
    for (int k = 0; k < 16; ++k) {
      int u = pos + k - 8;
      wv[k] = z8;
      if (u >= lo && u <= hi) wv[k] = *(const bf16x8*)(pr + (ptrdiff_t)(k - 8) * NP + C_BI + lane * 8);
    }
    bf16x8 cv[2][4];
#pragma unroll
    for (int part = 0; part < 2; ++part)
#pragma unroll
      for (int j = 0; j < 4; ++j) {
        int u = pos + j - 2;
        cv[part][j] = z8;
        if (u >= 0 && u < n) cv[part][j] = *(const bf16x8*)(pr + (ptrdiff_t)(j - 2) * NP + C_DQ + part * 512 + lane * 8);
      }
    float sq = 0.f, skv = 0.f;
#pragma unroll
    for (int i = 0; i < 8; ++i) { float a = bfs(vq[i]), c = bfs(vkv[i]); sq += a * a; skv += c * c; }
    sq = wave_sum(sq);
    skv = wave_sum(skv);
    if (lane == 0) {
      rinv[r * 2] = rsqrtf(sq * (1.f / 512.f) + EPS);
      rinv[r * 2 + 1] = rsqrtf(skv * (1.f / 512.f) + EPS);
    }
    {
      float own = bf2f(kro);
      float o = own;
      if (!isctx) {
        float par = bf2f(krp);
        int half = lane >> 5, ii = lane & 31, j = ii & 15;
        int pp = half ? (pos & 63) : (pos >> 6);
        float2 cs = rt[pp * 16 + j];
        o = (ii < 16) ? own * cs.x - par * cs.y : own * cs.x + par * cs.y;
      }
      u16 ob = f2bf(o);
      u16* kh = (u16*)(ws + O_KH) + ((size_t)(b * 4) * TPB + t) * 192 + 128 + lane;
#pragma unroll
      for (int h = 0; h < 4; ++h) kh[(size_t)h * TPB * 192] = ob;
    }
    {
      float s[8] = {0, 0, 0, 0, 0, 0, 0, 0};
#pragma unroll
      for (int k = 0; k < 16; ++k)
#pragma unroll
        for (int i = 0; i < 8; ++i) s[i] += bfs(wv[k][i]);
      float ic = 1.f / (float)(hi - lo + 1);
#pragma unroll
      for (int i = 0; i < 8; ++i) s[i] = s[i] * ic - bfs(wv[8][i]);
      st8((u16*)(ws + O_DPOOL) + (size_t)r * 512 + lane * 8, s);
    }
#pragma unroll
    for (int part = 0; part < 2; ++part) {
      float a[8] = {0, 0, 0, 0, 0, 0, 0, 0};
#pragma unroll
      for (int j = 0; j < 4; ++j)
#pragma unroll
        for (int i = 0; i < 8; ++i) a[i] += bfs(cv[part][j][i]) * cw[part][j][i];
      const float ksc = part ? 0.08838834764831845f : 1.f;
#pragma unroll
      for (int i = 0; i < 8; ++i) a[i] = silu_f(a[i]) * ksc;
      st8((u16*)(ws + O_QKC) + (size_t)r * 1024 + part * 512 + lane * 8, a);
    }
    if (lane < 16) {
      float gg = bf2f(dif) + bif;
      if (lane & 4) gg = fminf(gg, 0.f) - __logf(1.f + __expf(-fabsf(gg)));
      ((float*)(ws + O_GL))[(size_t)r * 16 + lane] = gg;
    }
  }
}

struct AttnTile {
  const u16* kp;
  const u16* vp;
  int isctx;
  int kr;
};

template <int DQK, int QT, bool NA>
__device__ void attn_block(const P& p, int layer, int b, int h, int qrow0  , bool q_is_latent,
                           int ntile, int na_r0  , const u16* Kbase, int ldk,
                           const u16* Vtbase  , const u16* Qbase, int ldq, int gatecol,
                           int ycol, float scale) {
  OPQ_IDS
  constexpr int KS = DQK / 32;
  constexpr int KSTR = DQK + 8;
  const float scale2 = scale * 1.4426950408889634f;
  constexpr int KCH = 64 * DQK / 8 / NTHR;
  u16* Ks = (u16*)shm;
  u16* Vs = Ks + 64 * KSTR;
  float* rpb = (float*)(Vs + 128 * 72);
  const int wid = TIDX >> 6, lane = TIDX & 63, l15 = lane & 15, quad = lane >> 4;
  char* ws = opqp(p.ws);
  const float2* rt = (const float2*)(ws + O_ROPE);

  __syncthreads();
  if (NA) {
    for (int i = TIDX; i < 465; i += NTHR) rpb[i] = p.na_rpb[((size_t)layer * 4 + h) * 465 + i];
  }
  bf16x8 qf[QT][KS];
#pragma unroll
  for (int qt = 0; qt < QT; ++qt) {
    int ql = wid * 16 * QT + qt * 16 + l15;
    const u16* qp = Qbase + (size_t)(qrow0 + ql) * ldq;
#pragma unroll
    for (int ks = 0; ks < KS; ++ks) qf[qt][ks] = *(const bf16x8*)(qp + ks * 32 + quad * 8);
  }
  f32x4 o[8][QT];
  float mrun[QT], lrun[QT];
#pragma unroll
  for (int qt = 0; qt < QT; ++qt) {
    mrun[qt] = -1e30f;
    lrun[qt] = 0.f;
#pragma unroll
    for (int dt = 0; dt < 8; ++dt) o[dt][qt] = f32x4{0.f, 0.f, 0.f, 0.f};
  }
  int na_rq = 0, na_cq = 0, na_cs = 0, na_rs = 0;
  if (NA) {
    na_rq = na_r0 + (wid >> 2);
    na_cq = (wid & 3) * 16 + l15;
    na_cs = min(max(na_cq - 8, 0), 48);
    na_rs = min(max(na_rq - 4, 0), 56);
  }
  const int na_rlo = NA ? min(max(na_r0 - 4, 0), 56) : 0;

  bf16x8 kreg[KCH], vreg[2];
  auto tile_ptrs = [&](int ti, const u16*& kp, const u16*& vp, int& isctx, int& kr) {
    int tok0;
    if (ti < 4) {
      tok0 = ti * 64;
      isctx = 1;
      kr = -1;
    } else {
      isctx = 0;
      kr = NA ? (na_rlo + ti - 4) : (ti - 4);
      tok0 = CTXL + kr * 64;
    }
    kp = Kbase + (size_t)tok0 * ldk;
    vp = Vtbase + tok0;
  };
  auto gloadK = [&](int ti) {
    const u16 *kp, *vp;
    int ic, kr;
    tile_ptrs(ti, kp, vp, ic, kr);
#pragma unroll
    for (int i = 0; i < KCH; ++i) {
      int c = TIDX + i * NTHR, key = c / (DQK / 8), part = c % (DQK / 8);
      kreg[i] = *(const bf16x8*)(kp + (size_t)key * ldk + part * 8);
    }
  };
  auto gloadV = [&](int ti) {
    const u16 *kp, *vp;
    int ic, kr;
    tile_ptrs(ti, kp, vp, ic, kr);
#pragma unroll
    for (int i = 0; i < 2; ++i) {
      int c = TIDX + i * NTHR, dv = c >> 3, part = c & 7;
      vreg[i] = *(const bf16x8*)(vp + (size_t)dv * TPB + part * 8);
    }
  };
  auto sstoreK = [&]() {
#pragma unroll
    for (int i = 0; i < KCH; ++i) {
      int c = TIDX + i * NTHR, key = c / (DQK / 8), part = c % (DQK / 8);
      *(bf16x8*)(Ks + key * KSTR + part * 8) = kreg[i];
    }
  };
  auto sstoreV = [&]() {
#pragma unroll
    for (int i = 0; i < 2; ++i) {
      int c = TIDX + i * NTHR, dv = c >> 3, part = c & 7;
      *(bf16x8*)(Vs + dv * 72 + part * 8) = vreg[i];
    }
  };

  gloadK(0);
  gloadV(0);
  __syncthreads();
  sstoreK();
  sstoreV();
  if (ntile > 1) { gloadK(1); gloadV(1); }
  LDS_BAR();
  auto tile_iter = [&](int ti) {
    const int isctx = ti < 4;
    int kr = NA ? (na_rlo + ti - 4) : 0;
    bool active = true;
    if (NA && !isctx) active = (kr >= na_rs) && (kr < na_rs + 8);
    f32x4 s[4][QT];
    if (active) {
#pragma unroll
      for (int kt = 0; kt < 4; ++kt)
#pragma unroll
        for (int qt = 0; qt < QT; ++qt) s[kt][qt] = f32x4{0.f, 0.f, 0.f, 0.f};
#pragma unroll
      for (int ks = 0; ks < KS; ++ks) {
        bf16x8 a[4];
#pragma unroll
        for (int kt = 0; kt < 4; ++kt) a[kt] = *(const bf16x8*)(Ks + (kt * 16 + l15) * KSTR + ks * 32 + quad * 8);
#pragma unroll
        for (int qt = 0; qt < QT; ++qt) {
          bf16x8 q = qf[qt][ks];
#pragma unroll
          for (int kt = 0; kt < 4; ++kt) s[kt][qt] = __builtin_amdgcn_mfma_f32_16x16x32_bf16(a[kt], q, s[kt][qt], 0, 0, 0);
        }
      }
    }
    LDS_BAR();
    if (ti + 1 < ntile) sstoreK();
    if (ti + 2 < ntile) gloadK(ti + 2);
    if (active) {
      bf16x8 pf[QT][2];
#pragma unroll
      for (int qt = 0; qt < QT; ++qt) {
        float mx = -1e30f;
#pragma unroll
        for (int kt = 0; kt < 4; ++kt)
#pragma unroll
          for (int j = 0; j < 4; ++j) {
            float v = s[kt][qt][j] * scale2;
            if (NA && !isctx) {
              int ck = kt * 16 + quad * 4 + j;
              bool valid = (ck >= na_cs) && (ck < na_cs + 16);
              int bidx = (kr - na_rq + 7) * 31 + min(max(ck - na_cq + 15, 0), 30);
              v = valid ? v + rpb[bidx] * 1.4426950408889634f : -1e30f;
            }
            s[kt][qt][j] = v;
            mx = fmaxf(mx, v);
          }
        mx = fmaxf(mx, SHX(mx, 16));
        mx = fmaxf(mx, SHX(mx, 32));
        float mnew = fmaxf(mrun[qt], mx);
        float alpha = __builtin_amdgcn_exp2f(mrun[qt] - mnew);
        mrun[qt] = mnew;
        float ls = 0.f;
#pragma unroll
        for (int kt = 0; kt < 4; ++kt)
#pragma unroll
          for (int j = 0; j < 4; ++j) {
            float pv = __builtin_amdgcn_exp2f(s[kt][qt][j] - mnew);
            ls += pv;
            s[kt][qt][j] = pv;
          }
        lrun[qt] = lrun[qt] * alpha + ls;
        if (__builtin_amdgcn_ballot_w64(alpha != 1.f)) {
#pragma unroll
          for (int dt = 0; dt < 8; ++dt)
#pragma unroll
            for (int j = 0; j < 4; ++j) o[dt][qt][j] *= alpha;
        }
#pragma unroll
        for (int kk = 0; kk < 2; ++kk) {
          union { bf16x8 v; unsigned u[4]; } cv;
          cv.u[0] = pk2(s[2 * kk][qt][0], s[2 * kk][qt][1]);
          cv.u[1] = pk2(s[2 * kk][qt][2], s[2 * kk][qt][3]);
          cv.u[2] = pk2(s[2 * kk + 1][qt][0], s[2 * kk + 1][qt][1]);
          cv.u[3] = pk2(s[2 * kk + 1][qt][2], s[2 * kk + 1][qt][3]);
          pf[qt][kk] = cv.v;
        }
      }
      {
        const u16* vb0 = Vs + l15 * 72 + quad * 4;
        bf16x4 n0 = *(const bf16x4*)vb0, n1 = *(const bf16x4*)(vb0 + 16);
#pragma unroll
        for (int idx = 0; idx < 16; ++idx) {
          const int kk = idx >> 3, dt = idx & 7;
          bf16x8 va = {n0[0], n0[1], n0[2], n0[3], n1[0], n1[1], n1[2], n1[3]};
          if (idx + 1 < 16) {
            const int kk2 = (idx + 1) >> 3, dt2 = (idx + 1) & 7;
            const u16* vb = Vs + (dt2 * 16 + l15) * 72 + kk2 * 32 + quad * 4;
            n0 = *(const bf16x4*)vb;
            n1 = *(const bf16x4*)(vb + 16);
          }
#pragma unroll
          for (int qt = 0; qt < QT; ++qt) o[dt][qt] = __builtin_amdgcn_mfma_f32_16x16x32_bf16(va, pf[qt][kk], o[dt][qt], 0, 0, 0);
        }
      }
    }
    LDS_BAR();
    if (ti + 1 < ntile) sstoreV();
    if (ti + 2 < ntile) gloadV(ti + 2);
  };
  for (int ti = 0; ti < 4; ++ti) tile_iter(ti);
  if (ntile > 4) {
    if (!NA && DQK == 192) {
#pragma unroll
      for (int qt = 0; qt < QT; ++qt) {
        const int ql = wid * 16 * QT + qt * 16 + l15;
        const u16* qp = Qbase + (size_t)(qrow0 + ql) * ldq;
        const int tq = (qrow0 + ql) % TPB - CTXL;
#pragma unroll
        for (int hf = 0; hf < 2; ++hf) {
          bf16x8 own = qf[qt][KS - 2 + hf];
          bf16x8 par = *(const bf16x8*)(qp + 128 + hf * 32 + (quad ^ 2) * 8);
          int pp = hf ? (tq & 63) : (tq >> 6);
          bf16x8 ro;
#pragma unroll
          for (int e = 0; e < 8; ++e) {
            float2 cs = rt[pp * 16 + (quad & 1) * 8 + e];
            float ov = bfs(own[e]), pv = bfs(par[e]);
            float r = (quad < 2) ? ov * cs.x - pv * cs.y : ov * cs.x + pv * cs.y;
            ro[e] = (short)f2bf(r);
          }
          qf[qt][KS - 2 + hf] = ro;
        }
      }
    }
    for (int ti = 4; ti < ntile; ++ti) tile_iter(ti);
  }
  const u16* proj = (const u16*)(ws + O_PROJ);
  u16* ys = (u16*)(ws + O_YS);
#pragma unroll
  for (int qt = 0; qt < QT; ++qt) {
    float lt = lrun[qt];
    lt += SHX(lt, 16);
    lt += SHX(lt, 32);
    float il = 1.f / lt;
    int r = qrow0 + wid * 16 * QT + qt * 16 + l15;
#pragma unroll
    for (int dt = 0; dt < 8; ++dt) {
      int dv = dt * 16 + quad * 4;
      bf16x4 g = *(const bf16x4*)(proj + (size_t)r * NP + gatecol + h * 128 + dv);
      bf16x4 ov;
#pragma unroll
      for (int j = 0; j < 4; ++j) {
        float y = bf2f(f2bf(o[dt][qt][j] * il));
        ov[j] = (short)f2bf(y * silu_f(bfs(g[j])));
      }
      *(bf16x4*)(ys + (size_t)r * 2048 + ycol + h * 128 + dv) = ov;
    }
  }
}

__device__ void phase_attn(const P& p, int l) {
  OPQ_IDS
  char* ws = opqp(p.ws);
  const bool need_ctx = l < 3;
  const int n_mla_lat = 256, n_na_lat = 512;
  const int n_mla_ctx = need_ctx ? 16 : 0, n_na_ctx = need_ctx ? 32 : 0;
  const int total = n_mla_lat + n_na_lat + n_mla_ctx + n_na_ctx;
  const u16* proj = (const u16*)(ws + O_PROJ);
  for (int it0 = BIDX; it0 < (total + 255) / 256 * 256; it0 += gridDim.x) {
    const int it = xcd_remap(it0, BIDX, gridDim.x);
    if (it >= total) continue;
    int i = it;
    if (i < n_mla_lat) {
      int bh = i >> 4, qb = i & 15, b = bh >> 2, h = bh & 3;
      attn_block<192, 2, false>(p, l, b, h, b * TPB + CTXL + qb * 256, true, 68, 0,
                                (const u16*)(ws + O_KH) + (size_t)bh * TPB * 192, 192,
                                (const u16*)(ws + O_VTC) + (size_t)bh * 128 * TPB,
                                (const u16*)(ws + O_QH) + h * 192, 768, C_CG, 1024, 0.07216878364870322f);
      continue;
    }
    i -= n_mla_lat;
    if (i < n_na_lat) {
      int bh = i >> 5, rp = i & 31, b = bh >> 2, h = bh & 3;
      int r0 = rp * 2;
      int rlo = min(max(r0 - 4, 0), 56), rhi = min(max(r0 + 1 - 4, 0), 56) + 7;
      attn_block<128, 1, true>(p, l, b, h, b * TPB + CTXL + r0 * 64, true, 4 + (rhi - rlo + 1), r0,
                               proj + (size_t)b * TPB * NP + C_AK + h * 128, NP,
                               (const u16*)(ws + O_VTA) + (size_t)bh * 128 * TPB, proj + C_AQ + h * 128, NP, C_AG, 0,
                               0.08838834764831845f);
      continue;
    }
    i -= n_na_lat;
    if (i < n_mla_ctx) {
      int bh = i, b = bh >> 2, h = bh & 3;
      attn_block<192, 2, false>(p, l, b, h, b * TPB, false, 4, 0, (const u16*)(ws + O_KH) + (size_t)bh * TPB * 192, 192,
                                (const u16*)(ws + O_VTC) + (size_t)bh * 128 * TPB, (const u16*)(ws + O_QH) + h * 192,
                                768, C_CG, 1024, 0.07216878364870322f);
      continue;
    }
    i -= n_mla_ctx;
    {
      int bh = i >> 1, half = i & 1, b = bh >> 2, h = bh & 3;
      attn_block<128, 1, false>(p, l, b, h, b * TPB + half * 128, false, 4, 0,
                                proj + (size_t)b * TPB * NP + C_AK + h * 128, NP,
                                (const u16*)(ws + O_VTA) + (size_t)bh * 128 * TPB, proj + C_AQ + h * 128, NP, C_AG, 0,
                                0.08838834764831845f);
    }
  }
}

DEVI int chunk_index(int dir, int blk) {
  if (dir == 0) return blk;
  return blk < 4 ? 3 - blk : 4 + 63 - (blk - 4);
}
__device__ void mlstm_gates(const P& p, int b, int h, int blk, float* gs) {
  OPQ_IDS
  const float* gl = (const float*)(opqp(p.ws) + O_GL);
  int R0 = b * TPB + blk * 64;
  if (TIDX < 128) {
    const int dir = TIDX >> 6, L = LANE, t = dir ? 63 - L : L;
    const float li = gl[(size_t)(R0 + t) * 16 + dir * 8 + h];
    const float lf = gl[(size_t)(R0 + t) * 16 + dir * 8 + 4 + h];
    float bc = lf;
#pragma unroll
    for (int o = 1; o < 64; o <<= 1) {
      float n = __int_as_float(__builtin_amdgcn_ds_bpermute(((L - o) & 63) << 2, __float_as_int(bc)));
      if (L >= o) bc += n;
    }
    float pm = li - bc;
#pragma unroll
    for (int o = 1; o < 64; o <<= 1) {
      float n = __int_as_float(__builtin_amdgcn_ds_bpermute(((L - o) & 63) << 2, __float_as_int(pm)));
      if (L >= o) pm = fmaxf(pm, n);
    }
    gs[dir * 64 + t] = li;
    gs[128 + dir * 64 + t] = lf;
    gs[256 + dir * 64 + t] = bc;
    gs[384 + dir * 64 + t] = pm;
    if (L == 63) {
      gs[512 + dir * 4] = bc;
      gs[512 + dir * 4 + 1] = bc + pm;
    }
  }
  __syncthreads();
}

__device__ void phase_m1(const P& p) {
  OPQ_IDS
  char* ws = opqp(p.ws);
  u16* kwT = (u16*)shm;
  u16* vT = kwT + 2 * 128 * 72;
  float* gs = (float*)(vT + 128 * 72);
  const u16* qkc = (const u16*)(ws + O_QKC);
  const u16* proj = (const u16*)(ws + O_PROJ);
  const int wid = TIDX >> 6, lane = TIDX & 63, l15 = lane & 15, quad = lane >> 4;
  for (int it = BIDX; it < 16 * 68; it += gridDim.x) {
    int bh = it / 68, blk = it % 68, b = bh >> 2, h = bh & 3;
    int R0 = b * TPB + blk * 64;
    __syncthreads();
    mlstm_gates(p, b, h, blk, gs);
#pragma unroll
    for (int i = 0; i < 2; ++i) {
      int c = TIDX + i * NTHR, s = c & 63, part = c >> 6;
      float kf[8];
      ld8(qkc + (size_t)(R0 + s) * 1024 + 512 + h * 128 + part * 8, kf);
      bf16x8 vv = *(const bf16x8*)(proj + (size_t)(R0 + s) * NP + C_DV + h * 128 + part * 8);
#pragma unroll
      for (int dir = 0; dir < 2; ++dir) {
        float bl = gs[512 + dir * 4], ml = gs[512 + dir * 4 + 1];
        float w = __expf(bl - gs[256 + dir * 64 + s] + gs[dir * 64 + s] - ml);
#pragma unroll
        for (int e = 0; e < 8; ++e) kwT[(dir * 128 + part * 8 + e) * 72 + s] = f2bf(kf[e] * w);
      }
#pragma unroll
      for (int e = 0; e < 8; ++e) vT[(part * 8 + e) * 72 + s] = (u16)vv[e];
    }
    __syncthreads();
    int dir = wid >> 2;
    int item = (bh * 2 + dir) * 68 + chunk_index(dir, blk);
    f32x4 acc[2][8];
#pragma unroll
    for (int a = 0; a < 2; ++a)
#pragma unroll
      for (int e = 0; e < 8; ++e) acc[a][e] = f32x4{0.f, 0.f, 0.f, 0.f};
#pragma unroll
    for (int kk = 0; kk < 2; ++kk) {
      bf16x8 af[2];
#pragma unroll
      for (int a = 0; a < 2; ++a) {
        const u16* ab = kwT + (dir * 128 + ((wid & 3) * 2 + a) * 16 + l15) * 72 + kk * 32 + quad * 4;
        bf16x4 v0 = *(const bf16x4*)ab, v1 = *(const bf16x4*)(ab + 16);
        af[a] = bf16x8{v0[0], v0[1], v0[2], v0[3], v1[0], v1[1], v1[2], v1[3]};
      }
#pragma unroll
      for (int e = 0; e < 8; ++e) {
        const u16* bb = vT + (e * 16 + l15) * 72 + kk * 32 + quad * 4;
        bf16x4 v0 = *(const bf16x4*)bb, v1 = *(const bf16x4*)(bb + 16);
        bf16x8 bf = bf16x8{v0[0], v0[1], v0[2], v0[3], v1[0], v1[1], v1[2], v1[3]};
#pragma unroll
        for (int a = 0; a < 2; ++a) acc[a][e] = __builtin_amdgcn_mfma_f32_16x16x32_bf16(af[a], bf, acc[a][e], 0, 0, 0);
      }
    }
    float* kl = (float*)(ws + O_KLOC) + (size_t)item * 16384;
#pragma unroll
    for (int a = 0; a < 2; ++a)
#pragma unroll
      for (int e = 0; e < 8; ++e) {
        int d0 = ((wid & 3) * 2 + a) * 16 + quad * 4, ee = e * 16 + l15;
        *(f32x4*)(kl + ee * 128 + d0) = acc[a][e];
      }
    if (TIDX < 256) {
      int dr = TIDX >> 7, d = TIDX & 127;
      float s = 0.f;
      for (int u = 0; u < 64; ++u) s += bf2f(kwT[(dr * 128 + d) * 72 + u]);
      int itm = (bh * 2 + dr) * 68 + chunk_index(dr, blk);
      ((float*)(ws + O_NLOC))[(size_t)itm * 128 + d] = s;
      if (d < 2) ((float*)(ws + O_SC))[itm * 2 + d] = gs[512 + dr * 4 + d];
    }
  }
}

__device__ void phase_m2(const P& p) {
  OPQ_IDS
  char* ws = opqp(p.ws);
  const float* kloc = (const float*)(ws + O_KLOC);
  const float* nloc = (const float*)(ws + O_NLOC);
  const float* sc = (const float*)(ws + O_SC);
  u16* cin = (u16*)(ws + O_CIN);
  float* nin = (float*)(ws + O_NIN);
  float* minp = (float*)(ws + O_MIN);
  const int per = 4096 + 32;
  for (int idx = BIDX * NTHR + TIDX; idx < 32 * per; idx += gridDim.x * NTHR) {
    int seq = idx / per, q4 = idx % per;
    f32x4 C = {0.f, 0.f, 0.f, 0.f};
    float m = 0.f;
    const bool isn = q4 >= 4096;
    for (int j0 = 0; j0 < 68; j0 += 4) {
      f32x4 kv[4];
      float bl[4], ml[4];
#pragma unroll
      for (int u = 0; u < 4; ++u) {
        int item = seq * 68 + j0 + u;
        kv[u] = isn ? *(const f32x4*)(nloc + (size_t)item * 128 + (q4 - 4096) * 4)
                    : *(const f32x4*)(kloc + (size_t)item * 16384 + q4 * 4);
        bl[u] = sc[item * 2];
        ml[u] = sc[item * 2 + 1];
      }
#pragma unroll
      for (int u = 0; u < 4; ++u) {
        int item = seq * 68 + j0 + u;
        if (isn) {
          *(f32x4*)(nin + (size_t)item * 128 + (q4 - 4096) * 4) = C;
          if (q4 == 4096) minp[item] = m;
        } else {
          bf16x4 o;
#pragma unroll
          for (int e = 0; e < 4; ++e) o[e] = (short)f2bf(C[e]);
          *(bf16x4*)(cin + (size_t)item * 16384 + q4 * 4) = o;
        }
        float mn = fmaxf(bl[u] + m, ml[u]);
        float dec = __expf(bl[u] + m - mn), wl = __expf(ml[u] - mn);
#pragma unroll
        for (int e = 0; e < 4; ++e) C[e] = dec * C[e] + wl * kv[u][e];
        m = mn;
      }
    }
  }
}

__device__ void phase_m3(const P& p, int l) {
  OPQ_IDS
  char* ws = opqp(p.ws);
  u16* Qs = (u16*)shm;
  u16* Ks = Qs + 64 * 136;
  u16* vT = Ks + 64 * 136;
  float* gs = (float*)(vT + 128 * 72);
  float* qn = gs + 528;
  float* ninl = qn + 128;
  float* hbuf = ninl + 256;
  const u16* qkc = (const u16*)(ws + O_QKC);
  const u16* proj = (const u16*)(ws + O_PROJ);
  const int wid = TIDX >> 6, lane = TIDX & 63, l15 = lane & 15, quad = lane >> 4;
  const bool need_ctx = l < 3;
  for (int it = BIDX; it < 16 * 68; it += gridDim.x) {
    int bh = it / 68, blk = it % 68, b = bh >> 2, h = bh & 3;
    if (!need_ctx && blk < 4) continue;
    int R0 = b * TPB + blk * 64;
    int itemd[2];
    itemd[0] = (bh * 2 + 0) * 68 + chunk_index(0, blk);
    itemd[1] = (bh * 2 + 1) * 68 + chunk_index(1, blk);
    bf16x8 lq[2], lk[2], lv[2];
#pragma unroll
    for (int i = 0; i < 2; ++i) {
      int c = TIDX + i * NTHR, s = c >> 4, part = c & 15;
      lq[i] = *(const bf16x8*)(qkc + (size_t)(R0 + s) * 1024 + h * 128 + part * 8);
      lk[i] = *(const bf16x8*)(qkc + (size_t)(R0 + s) * 1024 + 512 + h * 128 + part * 8);
      int c2s = c & 63, c2p = c >> 6;
      lv[i] = *(const bf16x8*)(proj + (size_t)(R0 + c2s) * NP + C_DV + h * 128 + c2p * 8);
    }
    float lnin = 0.f;
    if (TIDX < 256) lnin = ((const float*)(ws + O_NIN))[(size_t)itemd[TIDX >> 7] * 128 + (TIDX & 127)];
    const float m_in = ((const float*)(ws + O_MIN))[itemd[wid >> 2]];
    bf16x8 ldo[2], ldg[2];
    f32x4 lgn[4];
    {
      const int tt = TIDX >> 3, ch0 = h * 128 + (TIDX & 7) * 16;
      const u16* pr = proj + (size_t)(R0 + tt) * NP;
      ldo[0] = *(const bf16x8*)(pr + C_DO + ch0);
      ldo[1] = *(const bf16x8*)(pr + C_DO + ch0 + 8);
      ldg[0] = *(const bf16x8*)(pr + C_DG + ch0);
      ldg[1] = *(const bf16x8*)(pr + C_DG + ch0 + 8);
#pragma unroll
      for (int e4 = 0; e4 < 4; ++e4) lgn[e4] = *(const f32x4*)(p.ml_gnorm + l * 512 + ch0 + e4 * 4);
    }
    __syncthreads();
    mlstm_gates(p, b, h, blk, gs);
#pragma unroll
    for (int i = 0; i < 2; ++i) {
      int c = TIDX + i * NTHR, s = c >> 4, part = c & 15;
      *(bf16x8*)(Qs + s * 136 + part * 8) = lq[i];
      *(bf16x8*)(Ks + s * 136 + part * 8) = lk[i];
      int c2s = c & 63, c2p = c >> 6;
#pragma unroll
      for (int e = 0; e < 8; ++e) vT[(c2p * 8 + e) * 72 + c2s] = (u16)lv[i][e];
    }
    if (TIDX < 256) ninl[TIDX] = lnin;
    __syncthreads();
    {
      const int dr = TIDX >> 8, t = (TIDX >> 2) & 63, pq = TIDX & 3;
      float s = 0.f;
#pragma unroll 8
      for (int d = pq * 32; d < pq * 32 + 32; ++d) s += bf2f(Qs[t * 136 + d]) * ninl[dr * 128 + d];
      s += SHX(s, 1);
      s += SHX(s, 2);
      if (pq == 0) qn[dr * 64 + t] = s;
    }
    __syncthreads();
    {
      const int dir = wid >> 2, tt = wid & 3;
      const int t = tt * 16 + l15;
      const float* li = gs + dir * 64;
      const float* bc = gs + 256 + dir * 64;
      const float bct = bc[t];
      const float mt = fmaxf(bct + m_in, bct + gs[384 + dir * 64 + t]);
      bf16x8 qf[4];
#pragma unroll
      for (int ks = 0; ks < 4; ++ks) qf[ks] = *(const bf16x8*)(Qs + t * 136 + ks * 32 + quad * 8);
      f32x4 s[4];
#pragma unroll
      for (int st = 0; st < 4; ++st) s[st] = f32x4{0.f, 0.f, 0.f, 0.f};
#pragma unroll
      for (int ks = 0; ks < 4; ++ks)
#pragma unroll
        for (int st = 0; st < 4; ++st) {
          bf16x8 a = *(const bf16x8*)(Ks + (st * 16 + l15) * 136 + ks * 32 + quad * 8);
          s[st] = __builtin_amdgcn_mfma_f32_16x16x32_bf16(a, qf[ks], s[st], 0, 0, 0);
        }
      float dsum = 0.f;
      bf16x8 pf[2];
#pragma unroll
      for (int st = 0; st < 4; ++st)
#pragma unroll
        for (int j = 0; j < 4; ++j) {
          int sp = st * 16 + quad * 4 + j;
          bool valid = dir == 0 ? (sp <= t) : (sp >= t);
          float dm = bct - bc[sp] + li[sp] - mt;
          float v = valid ? s[st][j] * __expf(dm) : 0.f;
          dsum += v;
          pf[st >> 1][(st & 1) * 4 + j] = (short)f2bf(v);
        }
      dsum += SHX(dsum, 16);
      dsum += SHX(dsum, 32);
      f32x4 hi[8], hx[8];
#pragma unroll
      for (int e = 0; e < 8; ++e) { hi[e] = f32x4{0.f, 0.f, 0.f, 0.f}; hx[e] = f32x4{0.f, 0.f, 0.f, 0.f}; }
#pragma unroll
      for (int kk = 0; kk < 2; ++kk)
#pragma unroll
        for (int e = 0; e < 8; ++e) {
          const u16* vb = vT + (e * 16 + l15) * 72 + kk * 32 + quad * 4;
          bf16x4 v0 = *(const bf16x4*)vb, v1 = *(const bf16x4*)(vb + 16);
          bf16x8 va = {v0[0], v0[1], v0[2], v0[3], v1[0], v1[1], v1[2], v1[3]};
          hi[e] = __builtin_amdgcn_mfma_f32_16x16x32_bf16(va, pf[kk], hi[e], 0, 0, 0);
        }
      const u16* cin = (const u16*)(ws + O_CIN) + (size_t)itemd[dir] * 16384;
#pragma unroll
      for (int ks = 0; ks < 4; ++ks)
#pragma unroll
        for (int e = 0; e < 8; ++e) {
          bf16x8 ca = *(const bf16x8*)(cin + (e * 16 + l15) * 128 + ks * 32 + quad * 8);
          hx[e] = __builtin_amdgcn_mfma_f32_16x16x32_bf16(ca, qf[ks], hx[e], 0, 0, 0);
        }
      float a = __expf(bct + m_in - mt);
      float den = a * qn[dir * 64 + t] + dsum;
      float idn = 1.f / fmaxf(fabsf(den), __expf(-mt));
#pragma unroll
      for (int e = 0; e < 8; ++e)
#pragma unroll
        for (int j = 0; j < 4; ++j) hbuf[(dir * 64 + t) * 129 + e * 16 + quad * 4 + j] = (a * hx[e][j] + hi[e][j]) * idn;
    }
    __syncthreads();
    {
      int t = TIDX >> 3, part = TIDX & 7;
      float hv[16], ss = 0.f;
#pragma unroll
      for (int e = 0; e < 16; ++e) {
        hv[e] = hbuf[t * 129 + part * 16 + e] + hbuf[(64 + t) * 129 + part * 16 + e];
        ss += hv[e] * hv[e];
      }
      ss += SHX(ss, 1);
      ss += SHX(ss, 2);
      ss += SHX(ss, 4);
      float rs = rsqrtf(ss * (1.f / 128.f) + EPS);
      int r = R0 + t;
      const u16* pr = proj + (size_t)r * NP;
      u16* ys = (u16*)(ws + O_YS) + (size_t)r * 2048 + 1536 + h * 128 + part * 16;
      const int ch0 = h * 128 + part * 16;
      float dox[16], dgx[16], gn[16];
#pragma unroll
      for (int e = 0; e < 8; ++e) {
        dox[e] = bfs(ldo[0][e]); dox[8 + e] = bfs(ldo[1][e]);
        dgx[e] = bfs(ldg[0][e]); dgx[8 + e] = bfs(ldg[1][e]);
      }
#pragma unroll
      for (int e4 = 0; e4 < 4; ++e4)
#pragma unroll
        for (int e = 0; e < 4; ++e) gn[e4 * 4 + e] = lgn[e4][e];
      float yo[16];
#pragma unroll
      for (int e = 0; e < 16; ++e) {
        float y = hv[e] * rs * gn[e] * sigm_f(dox[e]);
        yo[e] = bf2f(f2bf(y)) * silu_f(dgx[e]);
      }
      st8(ys, yo);
      st8(ys + 8, yo + 8);
    }
  }
}

__device__ void gemm_step(const P& p, int step, int l) {
  OPQ_IDS
  char* ws = opqp(p.ws);
  const int nM = NTOK / 256;
  const bool need_ctx = l < 3;
  int ntiles;
  const int nbr = 1;
  if (step == 1) ntiles = nM * (NP / BNT);
  else if (step == 3) ntiles = nM * (2304 / BNT);
  else if (step == 6) ntiles = 4 * nM * (2048 / BNT);
  else if (step == 7) ntiles = nM * 32;
  else ntiles = nM * (2048 / BNT);
  for (int t0 = BIDX; t0 < (ntiles + 255) / 256 * 256; t0 += gridDim.x) {
    const int t = xcd_remap(t0, BIDX, gridDim.x);
    if (t >= ntiles) continue;
    for (int br = 0; br < nbr; ++br) {
      const u16 *A, *Bt;
      int lda, ldb, K, pm, pn, mode, aux = 0, bmode = 0, ncol = BNT;
      if (step == 1) {
        tile_map(t, nM, NP / BNT, pm, pn);
        A = (const u16*)(ws + O_HN); lda = 2048; Bt = (const u16*)(ws + O_WIN); ldb = 2048; K = 2048; mode = M_G1A;
      } else if (step == 3) {
        const int c2 = 768 / BNT, c3 = 1024 / BNT, c4 = 512 / BNT; const int n2 = nM * c2, n3 = nM * c3;
        K = 512; ldb = 512;
        if (t < n2) {
          pm = t / c2; pn = t % c2; A = (const u16*)(ws + O_PROJ) + C_CQ; lda = NP; Bt = (const u16*)(ws + O_WUQ); mode = M_G2;
        } else if (t < n2 + n3) {
          int tt = t - n2; pm = tt / c3; pn = tt % c3; A = (const u16*)(ws + O_PROJ) + C_CKV; lda = NP; Bt = (const u16*)(ws + O_WUKV); mode = M_G3;
        } else {
          int tt = t - n2 - n3; pm = tt / c4; pn = tt % c4; A = (const u16*)(ws + O_DPOOL); lda = 512; Bt = (const u16*)(ws + O_POOL); mode = M_POOL;
        }
      } else if (step == 6) {
        aux = t / (nM * (2048 / BNT));
        tile_map(t % (nM * (2048 / BNT)), nM, 2048 / BNT, pm, pn);
        A = (const u16*)(ws + O_YS) + aux * 512; lda = 2048; Bt = (const u16*)(ws + O_WBR) + (size_t)aux * 2048 * 512; ldb = 512; K = 512; mode = M_G4;
      } else if (step == 7) {
        tile_map(t, nM, 32, pm, pn);
        A = (const u16*)(ws + O_HN); lda = 2048;
        Bt = (l & 1) ? (const u16*)(ws + O_WINM1) : (const u16*)(ws + O_WIN) + (size_t)C_MG * 2048;
        ldb = 2048; K = 2048; mode = M_G1B; bmode = 1; ncol = 64;
      } else {
        tile_map(t, nM, 2048 / BNT, pm, pn);
        A = (const u16*)(ws + O_ACC); lda = 2048; Bt = (const u16*)(ws + O_WOUT); ldb = 2048; K = 2048; mode = M_G5;
      }
      if (step >= 6 && !need_ctx && (pm % 17) == 0) continue;
      gemm256(p, A, lda, Bt, ldb, K, pm * 256, pn * ncol, mode, aux, l, bmode);
    }
  }
}


#define XB_TMO      128
#define XB_XCNT(j)  (256  + 64 * (j))
#define XB_XSUB(j)  (1280 + 64 * (j))
#define XB_XGEN(j)  (2304 + 64 * (j))
#define XB_TOP      3328
#define XB_TOPGEN   3392
#define XCD_BAR_WORDS 3456
#define XB_SPIN_CAP (1u << 18)
#define LAS __attribute__((address_space(3)))
DEVI unsigned xb_ld(unsigned* p) { return __hip_atomic_load(p, __ATOMIC_RELAXED, __HIP_MEMORY_SCOPE_AGENT); }
DEVI unsigned xb_add(unsigned* p, unsigned v) { return __hip_atomic_fetch_add(p, v, __ATOMIC_RELAXED, __HIP_MEMORY_SCOPE_AGENT); }
DEVI unsigned xb_xcc_id() { return (unsigned)__builtin_amdgcn_s_getreg((3 << 11) | 20) & 0xFu; }
#define XB_SPIN(cond, bar) do { unsigned _sp = 0; while (cond) { __builtin_amdgcn_s_sleep(1); \
    if ((++_sp & 255u) == 0u) { if (xb_ld(&(bar)[XB_TMO])) break; if (_sp > XB_SPIN_CAP) { atomicAdd(&(bar)[XB_TMO], 1u); break; } } } } while (0)
struct XcdBarrier { unsigned* bar; unsigned x; volatile LAS unsigned* st; };
DEVI XcdBarrier xcd_barrier_post(unsigned* bar, volatile LAS unsigned* st) {
  XcdBarrier b; b.bar = bar; b.x = xb_xcc_id(); b.st = st;
  if (threadIdx.x == 0) (void)xb_add(&bar[XB_XCNT(b.x)], 1u);
  return b;
}
DEVI void xcd_barrier_complete(unsigned* bar, unsigned x, unsigned& nloc, unsigned& nx) {
  const unsigned G = gridDim.x * gridDim.y * gridDim.z;
  unsigned sum, cnt, mine, sp = 0u;
  for (;;) {
    sum = 0u; cnt = 0u; mine = 0u;
#pragma unroll
    for (unsigned j = 0; j < 16; ++j) { const unsigned c = xb_ld(&bar[XB_XCNT(j)]); sum += c; cnt += (c > 0u) ? 1u : 0u; mine = (j == x) ? c : mine; }
    if (sum == G) break;
    __builtin_amdgcn_s_sleep(1);
    if ((++sp & 255u) == 0u) { if (xb_ld(&bar[XB_TMO])) break; if (sp > XB_SPIN_CAP) { atomicAdd(&bar[XB_TMO], 1u); break; } }
  }
  nloc = mine > 0u ? mine : 1u; nx = cnt > 0u ? cnt : 1u;
}
DEVI void xcd_barrier(const XcdBarrier& b) {
  asm volatile("s_waitcnt vmcnt(0)" ::: "memory");
  __syncthreads();
  if (threadIdx.x == 0) {
    unsigned* bar = b.bar;
    __builtin_amdgcn_s_waitcnt(0);
    unsigned nloc = b.st[0], nx = b.st[1];
    if (nloc == 0u) { xcd_barrier_complete(bar, b.x, nloc, nx); b.st[0] = nloc; b.st[1] = nx; }
    const unsigned old = xb_add(&bar[XB_XSUB(b.x)], 1u);
    const unsigned gen = old / nloc;
    if (old + 1u == (gen + 1u) * nloc) {
      __builtin_amdgcn_fence(__ATOMIC_RELEASE, "agent");
      asm volatile("s_waitcnt vmcnt(0)" ::: "memory");
      const unsigned og = xb_add(&bar[XB_TOP], 1u);
      const unsigned tg = og / nx;
      if (og + 1u == (tg + 1u) * nx) xb_add(&bar[XB_TOPGEN], 1u);
      else XB_SPIN(xb_ld(&bar[XB_TOPGEN]) == tg, bar);
      __builtin_amdgcn_fence(__ATOMIC_ACQUIRE, "agent");
      xb_add(&bar[XB_XGEN(b.x)], 1u);
      asm volatile("s_waitcnt vmcnt(0)" ::: "memory");
    } else {
      XB_SPIN(xb_ld(&bar[XB_XGEN(b.x)]) == gen, bar);
      __builtin_amdgcn_fence(__ATOMIC_ACQUIRE, "agent");
      asm volatile("s_waitcnt vmcnt(0)" ::: "memory");
    }
  }
  __syncthreads();
}

__global__ void __launch_bounds__(NTHR) mega(P p) {
  cg::grid_group grid = cg::this_grid();
  __shared__ uint4 xb_words;
  unsigned* bar = (unsigned*)(p.ws + O_BAR);
  if (threadIdx.x == 0) xb_words = make_uint4(0u, 0u, 0u, 0u);
  if (blockIdx.x == 0) {
    for (int i = threadIdx.x; i < 4096; i += NTHR) bar[i] = 0u;
  }
  __syncthreads();
  if (PHM & 1) phase_mod_partial(p);
  grid.sync();
  XcdBarrier xb = xcd_barrier_post(bar, (volatile LAS unsigned*)&xb_words);
  if (PHM & 1) phase_mod_reduce(p);
  grid.sync();
  for (int ls2 = 0; ls2 < 36 * 2; ++ls2) {
    const int ls = ls2 >> 1;
    const int l = ls / 9, step = ls % 9;
    if ((ls2 & 1) && !((PROBE_DUP >> step) & 1)) continue;
    if (step == 0) { if (PHM & 4) phase_norm(p, l); }
    if (step == 2) { if (PHM & 8) phase_p2(p, l); }
    if (step == 1 || step == 3 || step >= 6) gemm_step(p, step, l);
    {
      const int bid = blockIdx.x, nb = gridDim.x;
      int wl = -1, wmode = 0, rank = bid, count = nb, mod = 1, lo = 0, width = 1, sub_lo = 0, sub_hi = 0;
      if (!(ls2 & 1)) {
        if (step == 0) { wl = l; wmode = (l == 0) ? 0 : 2; }
        else if ((step == 1 || step == 3 || step == 6) && l < 3 && nb == 256) {
          const int ntl = (step == 1) ? 68 * 29 : (step == 3) ? 68 * 9 : 4 * 68 * 8;
          const int rem = ntl - ((ntl + 255) / 256 - 1) * 256;
          const int pos = (bid & 7) * 32 + (bid >> 3);
          if (pos >= rem) {
            wl = l + 1; wmode = 3; rank = pos - rem; count = 256 - rem;
            sub_lo = (step == 1) ? 0 : (step == 3) ? 1660 : 3000;
            sub_hi = (step == 1) ? 1660 : (step == 3) ? 3000 : 4096;
          }
        }
        else if (step == 7 && l < 3) {
          wl = l + 1; wmode = (nb == 256) ? 1 : 4;
          if (nb == 256) {
            count = 128; mod = 5;
            if ((bid & 7) >= 4) { rank = (bid >> 3) * 4 + (bid & 7) - 4; lo = 4; width = 1; }
            else wl = -1;
          }
        } else if (step == 8 && l < 3 && nb == 256 && (bid & 7) != 0) {
          wl = l + 1; wmode = 1; rank = (bid >> 3) * 7 + (bid & 7) - 1; count = 224; mod = 5; lo = 0; width = 4;
        }
      }
      if (wl >= 0 && (PHM & 2)) phase_wprep(p, wl, wmode, rank, count, mod, lo, width, sub_lo, sub_hi);
    }
    if (step == 3) { if (PHM & 16) phase_m1(p); }
    if (step == 4) {
      if (PHM & 32) phase_m2(p);
      if (PHM & 64) phase_attn(p, l);
    }
    if (step == 5) { if (PHM & 128) phase_m3(p, l); }
    xcd_barrier(xb);
  }
  if (PHM & 4) phase_final(p);
}

extern "C" void kernel_launch(void* const* d_in, const int* in_sizes, int n_in, void* d_out, int out_size, void* d_ws,
                              size_t ws_size, hipStream_t stream) {
  static int grid_blocks = 0;
  if (!grid_blocks) {
    int dev = 0, cus = 0, per_cu = 0;
    hipGetDevice(&dev);
    hipDeviceGetAttribute(&cus, hipDeviceAttributeMultiprocessorCount, dev);
    hipFuncSetAttribute((const void*)mega, hipFuncAttributeMaxDynamicSharedMemorySize, SHM_BYTES);
    hipOccupancyMaxActiveBlocksPerMultiprocessor(&per_cu, mega, NTHR, SHM_BYTES);
    if (per_cu < 1) per_cu = 1;
    grid_blocks = cus * per_cu;
  }
  P p{};
  const float** pp = (const float**)&p;
  for (int i = 0; i < 21; ++i) pp[i] = (const float*)d_in[i];
  p.out = (float*)d_out;
  p.ws = (char*)d_ws;
  if (ws_size < O_TOTAL) fprintf(stderr, "workspace too small: %zu < %zu\n", ws_size, (size_t)O_TOTAL);
  void* args[] = {&p};
  hipError_t e = hipLaunchCooperativeKernel((void*)mega, dim3(grid_blocks), dim3(NTHR), args, SHM_BYTES, stream);
  if (e != hipSuccess) fprintf(stderr, "cooperative launch failed: %s (grid %d)\n", hipGetErrorString(e), grid_blocks);
}
```

```cpp
#include <hip/hip_runtime.h>
#include <hip/hip_bf16.h>
#include <hip/hip_cooperative_groups.h>
#include <cstdio>
namespace cg = cooperative_groups;

typedef unsigned short u16;
using bf16x8 = __attribute__((ext_vector_type(8))) short;
using bf16x4 = __attribute__((ext_vector_type(4))) short;
using f32x4 = __attribute__((ext_vector_type(4))) float;
typedef unsigned u32x4 __attribute__((ext_vector_type(4)));
#define DEVI __device__ __forceinline__

constexpr int D = 2048, NBATCH = 4, SEQ = 4096, CTXL = 256, TPB = 4352, NTOK = 17408, DIN = 15440, NP = 7424;
constexpr int C_AQ = 0, C_AK = 512, C_AV = 1024, C_AG = 1536, C_BI = 2048, C_BG = 2560, C_CQ = 3072, C_CKV = 3584,
              C_CKR = 4096, C_CG = 4160, C_DQ = 4672, C_DK = 5184, C_DV = 5696, C_DO = 6208, C_DIF = 6720,
              C_DG = 6736, C_MG = 7248;
constexpr float EPS = 1e-6f;
constexpr int NTHR = 512;
#ifndef PROBE_ZB
#define PROBE_ZB (-1)
#endif
#ifndef PROBE_US
#define PROBE_US 1.f
#endif
#ifndef G8
#define G8 1
#endif
#define BNT (G8 ? 256 : 128)
#ifndef PROBE_DUP
#define PROBE_DUP 0
#endif
#ifndef PHM
#define PHM 0xFFFF
#endif
constexpr int SHM_BYTES = 131072;

constexpr size_t al(size_t x) { return (x + 255) & ~size_t(255); }
constexpr size_t O_WIN = 0;
constexpr size_t O_WBR = O_WIN + al((size_t)DIN * 2048 * 2);
constexpr size_t O_WOUT = O_WBR + al((size_t)4 * 2048 * 512 * 2);
constexpr size_t O_WUQ = O_WOUT + al((size_t)2048 * 2048 * 2);
constexpr size_t O_WUKV = O_WUQ + al((size_t)768 * 512 * 2);
constexpr size_t O_POOL = O_WUKV + al((size_t)1024 * 512 * 2);
constexpr size_t O_MODP = O_POOL + al((size_t)512 * 512 * 2);
constexpr size_t O_MOD = O_MODP + al((size_t)4 * 16 * 5 * 6144 * 4);
constexpr size_t O_ROPE = O_MOD + al((size_t)4 * 5 * 6144 * 4);
constexpr size_t O_XC = O_ROPE + al(64 * 16 * 8);
constexpr size_t O_HN = O_XC + al((size_t)1024 * 2048 * 4);
constexpr size_t O_PROJ = O_HN + al((size_t)NTOK * 2048 * 2);
constexpr size_t O_QH = O_PROJ + al((size_t)NTOK * NP * 2);
constexpr size_t O_KH = O_QH + al((size_t)NTOK * 768 * 2);
constexpr size_t O_VTC = O_KH + al((size_t)NTOK * 768 * 2);
constexpr size_t O_END1 = O_VTC + al((size_t)NTOK * 512 * 2);
constexpr size_t O_YBR = O_PROJ;
static_assert((size_t)NTOK * 8192 * 2 <= O_END1 - O_PROJ, "ybr alias");
constexpr size_t O_VTA = O_END1;
constexpr size_t O_DPOOL = O_VTA + al((size_t)NTOK * 512 * 2);
constexpr size_t O_QKC = O_DPOOL + al((size_t)NTOK * 512 * 2);
constexpr size_t O_GL = O_QKC + al((size_t)NTOK * 1024 * 2);
constexpr size_t O_RINV = O_GL + al((size_t)NTOK * 16 * 4);
constexpr size_t O_YS = O_RINV + al((size_t)NTOK * 2 * 4);
constexpr size_t O_ACC = O_YS + al((size_t)NTOK * 2048 * 2);
constexpr int NITEM = 32 * 68;
constexpr size_t O_KLOC = O_ACC + al((size_t)NTOK * 2048 * 2);
constexpr size_t O_NLOC = O_KLOC + al((size_t)NITEM * 16384 * 4);
constexpr size_t O_SC = O_NLOC + al((size_t)NITEM * 128 * 4);
constexpr size_t O_CIN = O_SC + al((size_t)NITEM * 2 * 4);
constexpr size_t O_NIN = O_CIN + al((size_t)NITEM * 16384 * 2);
constexpr size_t O_MIN = O_NIN + al((size_t)NITEM * 128 * 4);
constexpr size_t O_WINM1 = O_MIN + al((size_t)NITEM * 4);
constexpr size_t O_BAR = O_WINM1 + al((size_t)8192 * 2048 * 2);
constexpr size_t O_TOTAL = O_BAR + al(4096 * 4);
static_assert(O_TOTAL < 1000000000ull, "workspace budget");

struct P {
  const float *x, *c, *ctx, *c_ctx, *norm_g, *w_mod, *b_mod, *w_in, *na_rpb, *pool_w, *pool_scale, *mla_gq, *mla_gkv,
      *w_uq, *w_ukv, *conv_w, *b_if, *ml_gnorm, *w_br, *w_out, *g_final;
  float* out;
  char* ws;
};

extern __shared__ __attribute__((aligned(16))) char shm[];

DEVI u16 f2bf(float f) {
  unsigned u = __float_as_uint(f);
  u += 0x7fffu + ((u >> 16) & 1u);
  return (u16)(u >> 16);
}
typedef __bf16 bf2_t __attribute__((ext_vector_type(2)));
typedef float fl2_t __attribute__((ext_vector_type(2)));
DEVI unsigned pk2(float a, float b) {
  fl2_t v = {a, b};
  bf2_t r = __builtin_convertvector(v, bf2_t);
  return *(unsigned*)&r;
}
DEVI float bf2f(u16 h) { return __uint_as_float(((unsigned)h) << 16); }
DEVI float bfs(short h) { return __uint_as_float(((unsigned)(u16)h) << 16); }
DEVI float silu_f(float x) { return x / (1.f + __expf(-x)); }
DEVI float sigm_f(float x) { return 1.f / (1.f + __expf(-x)); }
DEVI int opqv(int x) { asm volatile("" : "+v"(x)); return x; }
DEVI int opqs(int x) { asm volatile("" : "+s"(x)); return x; }
DEVI size_t opqz() { size_t z = 0; asm volatile("" : "+s"(z)); return z; }
#define opqp(x) ((x) + opqz())
#define SHX(v, m) __int_as_float(__builtin_amdgcn_ds_bpermute(((LANE ^ (m)) << 2), __float_as_int(v)))
#define LDS_BAR() do { asm volatile("s_waitcnt lgkmcnt(0)" ::: "memory"); __builtin_amdgcn_s_barrier(); asm volatile("" ::: "memory"); } while (0)
#define OPQ_IDS const int TIDX = opqv((int)threadIdx.x); const int BIDX = opqs((int)blockIdx.x); const int LANE = TIDX & 63; (void)TIDX; (void)BIDX; (void)LANE;
#define wave_sum(v) wave_sum_l((v), LANE)
DEVI float wave_sum_l(float v, int LANE) {
#pragma unroll
  for (int o = 32; o > 0; o >>= 1) v += SHX(v, o);
  return v;
}

DEVI void ld8(const u16* ptr, float* f) {
  bf16x8 v = *(const bf16x8*)ptr;
#pragma unroll
  for (int i = 0; i < 8; ++i) f[i] = bfs(v[i]);
}
DEVI void st8(u16* ptr, const float* f) {
  bf16x8 v;
#pragma unroll
  for (int i = 0; i < 8; ++i) v[i] = (short)f2bf(f[i]);
  *(bf16x8*)ptr = v;
}
constexpr int BM = 256, BK = 64, HALF = 128, HT = HALF * BK;

DEVI int lds_byte(int r, int c) {
  int st = (r >> 4) * 2 + (c >> 5), rr = r & 15, cc = c & 31, ob = rr * 64 + cc * 2;
  return st * 1024 + (ob ^ (((ob >> 9) & 1) << 5));
}
DEVI void stage_rc(int b, int& R, int& C) {
  int st = b / 1024, sb = b % 1024, swz = sb ^ (((sb >> 9) & 1) << 5);
  R = (st >> 1) * 16 + swz / 64;
  C = (st & 1) * 32 + (swz % 64) / 2;
}

enum { M_G1A = 0, M_G2, M_G3, M_POOL, M_G4, M_G1B, M_G5 };

DEVI void gemm256(const P& p, const u16* A, int lda, const u16* Bt, int ldb, int K, int brow, int bcol, int mode,
                        int aux, int layer, int bmode) {
  OPQ_IDS
  if (!(PHM & 256)) return;
  u16* shmb = (u16*)shm;
#define SA(b, h) (shmb + ((b)*2 + (h)) * HT)
#if G8
#define SB(b, h) (shmb + (4 + (b)*2 + (h)) * HT)
#else
#define SB(b, h) (shmb + (4 + (b)) * HT)
#endif
#define LDSP(x) ((__attribute__((address_space(3))) void*)(x))
#define STAGEA(Pp, br, kt)                                                                                     \
  do {                                                                                                         \
    const int _so = ((br) * lda + (kt)*BK) * 2;                                                                \
    __builtin_amdgcn_raw_ptr_buffer_load_lds(rsA, LDSP((char*)(Pp) + TIDX * 16), 16, offA0, _so, 0, 0);       \
    __builtin_amdgcn_raw_ptr_buffer_load_lds(rsA, LDSP((char*)(Pp) + TIDX * 16 + 8192), 16, offA1, _so, 0, 0);\
  } while (0)
#define STAGEB(Pp, br, kt)                                                                                     \
  do {                                                                                                         \
    const int _so = ((br) * ldb + (kt)*BK) * 2;                                                                \
    __builtin_amdgcn_raw_ptr_buffer_load_lds(rsB, LDSP((char*)(Pp) + TIDX * 16), 16, offB0, _so, 0, 0);       \
    __builtin_amdgcn_raw_ptr_buffer_load_lds(rsB, LDSP((char*)(Pp) + TIDX * 16 + 8192), 16, offB1, _so, 0, 0);\
  } while (0)
#define LDA(dst, b, h)                                                                                         \
  for (int m = 0; m < 4; ++m)                                                                                  \
    for (int k = 0; k < 2; ++k)                                                                                \
  dst[m][k] = *reinterpret_cast<const bf16x8*>((char*)SA(b, h) + lds_byte(wr * 64 + m * 16 + fr, k * 32 + fq * 8))
#define LDB(dst, b, h)                                                                                         \
  for (int n = 0; n < 2; ++n)                                                                                  \
    for (int k = 0; k < 2; ++k)                                                                                \
  dst[n][k] = *reinterpret_cast<const bf16x8*>((char*)SB(b, h) + lds_byte(wc * 32 + n * 16 + fr, k * 32 + fq * 8))
#define MMA(ai, bj, At, Btf)                                                                                   \
  do {                                                                                                         \
    __builtin_amdgcn_s_setprio(1);                                                                             \
    for (int m = 0; m < 4; ++m)                                                                                \
      for (int n = 0; n < 2; ++n)                                                                              \
        for (int k = 0; k < 2; ++k)                                                                            \
          acc[ai][bj][m][n] = __builtin_amdgcn_mfma_f32_16x16x32_bf16(Btf[n][k], At[m][k], acc[ai][bj][m][n], 0, 0, 0); \
    __builtin_amdgcn_s_setprio(0);                                                                             \
  } while (0)
#define WAIT_V(n) asm volatile("s_waitcnt vmcnt(" #n ")" ::: "memory")
#define WAIT_L(n) asm volatile("s_waitcnt lgkmcnt(" #n ")" ::: "memory")
#define BAR __builtin_amdgcn_s_barrier()
#define SCHED __builtin_amdgcn_sched_barrier(0)

  int wid = TIDX >> 6, lane = TIDX & 63, wr = wid >> 2, wc = wid & 3, fr = lane & 15, fq = lane >> 4;
#if G8
  f32x4 acc[2][2][4][2] = {};
  bf16x8 At[4][2], B0[2][2], B1[2][2];
#else
  f32x4 acc[2][1][4][2] = {};
  bf16x8 At[4][2], B0[2][2];
#endif
  int nt = K / BK;
  const int bhalf = bmode ? 4096 : HALF;
  int offA0, offA1, offB0, offB1;
  __amdgpu_buffer_rsrc_t rsA = __builtin_amdgcn_make_buffer_rsrc((void*)A, 0, 0x7fffffff, 0x00020000);
  __amdgpu_buffer_rsrc_t rsB = __builtin_amdgcn_make_buffer_rsrc((void*)Bt, 0, 0x7fffffff, 0x00020000);
  {
    int r0, c0, r1, c1;
    stage_rc(TIDX * 16, r0, c0);
    stage_rc(TIDX * 16 + 8192, r1, c1);
    offA0 = (r0 * lda + c0) * 2; offA1 = (r1 * lda + c1) * 2;
    offB0 = (r0 * ldb + c0) * 2; offB1 = bmode ? offB0 + 2048 * ldb * 2 : (r1 * ldb + c1) * 2;
  }
#if G8
  STAGEB(SB(0, 0), bcol, 0);
  STAGEA(SA(0, 0), brow, 0);
  STAGEB(SB(0, 1), bcol + bhalf, 0);
  STAGEA(SA(0, 1), brow + HALF, 0);
  if (wr == 1) BAR;
  WAIT_V(4);
  BAR;
  STAGEB(SB(1, 0), bcol, 1);
  STAGEA(SA(1, 0), brow, 1);
  STAGEB(SB(1, 1), bcol + bhalf, 1);
  WAIT_V(6);
  BAR;
  for (int t = 0; t < nt - 2; t += 2) {
    LDB(B0, 0, 0); SCHED; LDA(At, 0, 0); STAGEA(SA(1, 1), brow + HALF, t + 1);
    WAIT_L(8); BAR; WAIT_L(0); MMA(0, 0, At, B0); BAR; SCHED;
    LDB(B1, 0, 1); STAGEB(SB(0, 0), bcol, t + 2);
    BAR; WAIT_L(0); MMA(0, 1, At, B1); BAR;
    LDA(At, 0, 1); STAGEA(SA(0, 0), brow, t + 2);
    BAR; WAIT_L(0); MMA(1, 0, At, B0); BAR; SCHED;
    STAGEB(SB(0, 1), bcol + bhalf, t + 2);
    WAIT_V(6); BAR; MMA(1, 1, At, B1); BAR;
    LDB(B0, 1, 0); SCHED; LDA(At, 1, 0); STAGEA(SA(0, 1), brow + HALF, t + 2);
    WAIT_L(8); BAR; WAIT_L(0); MMA(0, 0, At, B0); BAR; SCHED;
    LDB(B1, 1, 1); STAGEB(SB(1, 0), bcol, t + 3);
    BAR; WAIT_L(0); MMA(0, 1, At, B1); BAR;
    LDA(At, 1, 1); STAGEA(SA(1, 0), brow, t + 3);
    BAR; WAIT_L(0); MMA(1, 0, At, B0); BAR; SCHED;
    STAGEB(SB(1, 1), bcol + bhalf, t + 3);
    WAIT_V(6); BAR; MMA(1, 1, At, B1); BAR;
  }
  {
    LDB(B0, 0, 0); LDA(At, 0, 0); STAGEA(SA(1, 1), brow + HALF, nt - 1);
    BAR; WAIT_L(0); MMA(0, 0, At, B0); BAR;
    LDB(B1, 0, 1); BAR; WAIT_L(0); MMA(0, 1, At, B1); BAR;
    LDA(At, 0, 1); WAIT_V(4); BAR; WAIT_L(0); MMA(1, 0, At, B0); MMA(1, 1, At, B1); BAR;
  }
  {
    LDB(B0, 1, 0); LDA(At, 1, 0); WAIT_V(2); BAR; WAIT_L(0); MMA(0, 0, At, B0); BAR;
    LDB(B1, 1, 1); WAIT_V(0); BAR; WAIT_L(0); MMA(0, 1, At, B1); BAR;
    LDA(At, 1, 1); BAR; WAIT_L(0); MMA(1, 0, At, B0); MMA(1, 1, At, B1); BAR;
  }
  if (wr == 0) BAR;
#else
  STAGEB(SB(0, 0), bcol, 0);
  STAGEA(SA(0, 0), brow, 0);
  STAGEA(SA(0, 1), brow + HALF, 0);
  WAIT_V(0);
  BAR;
  for (int t = 0; t < nt; t += 2) {
    STAGEB(SB(1, 0), bcol, t + 1);
    STAGEA(SA(1, 0), brow, t + 1);
    STAGEA(SA(1, 1), brow + HALF, t + 1);
    LDB(B0, 0, 0); LDA(At, 0, 0); WAIT_L(0); MMA(0, 0, At, B0);
    LDA(At, 0, 1); WAIT_L(0); MMA(1, 0, At, B0);
    WAIT_V(0);
    BAR;
    if (t + 2 < nt) {
      STAGEB(SB(0, 0), bcol, t + 2);
      STAGEA(SA(0, 0), brow, t + 2);
      STAGEA(SA(0, 1), brow + HALF, t + 2);
    }
    LDB(B0, 1, 0); LDA(At, 1, 0); WAIT_L(0); MMA(0, 0, At, B0);
    LDA(At, 1, 1); WAIT_L(0); MMA(1, 0, At, B0);
    WAIT_V(0);
    BAR;
  }
#endif
  char* ws = opqp(p.ws);
  const int bb = brow / TPB;
  const int trow = brow - bb * TPB;
  u16* stg = (u16*)shm;
  const int tid = TIDX;
#define SWZ(r, c) ((c) ^ ((r)&15) ^ (((c)&1) << 4))
#pragma unroll
  for (int ai = 0; ai < 2; ++ai)
#pragma unroll
    for (int bj = 0; bj < (G8 ? 2 : 1); ++bj)
#pragma unroll
      for (int m = 0; m < 4; ++m)
#pragma unroll
        for (int n = 0; n < 2; ++n) {
          const int R = ai * HALF + wr * 64 + m * 16 + fr;
          const int chunk = bj * 16 + wc * 4 + n * 2 + (fq >> 1);
          f32x4 v = acc[ai][bj][m][n];
          uint2 pk = make_uint2(pk2(v[0], v[1]), pk2(v[2], v[3]));
          *(uint2*)(stg + R * 256 + SWZ(R, chunk) * 8 + (fq & 1) * 4) = pk;
        }
  LDS_BAR();
  if (mode == M_G1B) {
#pragma unroll 1
    for (int it = 0; it < 4; ++it) {
      const int R = it * 64 + (tid >> 3), co = tid & 7;
      const int row = brow + R, ocol = bcol + co * 8;
      float sum[8] = {0, 0, 0, 0, 0, 0, 0, 0};
#pragma unroll
      for (int br = 0; br < 4; ++br) {
        const int c = br * 8 + co;
        bf16x8 g = *(const bf16x8*)(stg + R * 256 + SWZ(R, c) * 8);
        float yb[8];
        ld8((const u16*)(ws + O_YBR) + (size_t)row * 8192 + br * 2048 + ocol, yb);
#pragma unroll
        for (int e = 0; e < 8; ++e) sum[e] += (br == PROBE_ZB) ? 0.f : sigm_f(bfs(g[e])) * yb[e];
      }
      st8((u16*)(ws + O_ACC) + (size_t)row * 2048 + ocol, sum);
    }
  } else {
    bool tr0 = false, tr1 = false;
    if (mode == M_G1A) { tr0 = bcol >= C_AV && bcol < C_AG; tr1 = bcol + HALF >= C_AV && bcol + HALF < C_AG; }
    else if (mode == M_G3) { tr1 = true; }
#pragma unroll 4
    for (int it = 0; it < 16; ++it) {
      const int R = it * 16 + (tid >> 5), c = tid & 31;
      if ((c < 16) ? tr0 : tr1) continue;
      const int row = brow + R, col = bcol + c * 8;
      bf16x8 raw = *(const bf16x8*)(stg + R * 256 + SWZ(R, c) * 8);
      if (mode == M_G1A) {
        *(bf16x8*)((u16*)(ws + O_PROJ) + (size_t)row * NP + col) = raw;
      } else if (mode == M_G4) {
        *(bf16x8*)((u16*)(ws + O_YBR) + (size_t)row * 8192 + aux * 2048 + col) = raw;
      } else {
        float v[8];
#pragma unroll
        for (int e = 0; e < 8; ++e) v[e] = bfs(raw[e]);
        if (mode == M_G2) {
          float rs = ((const float*)(ws + O_RINV))[row * 2];
#pragma unroll
          for (int e = 0; e < 8; ++e) v[e] *= rs;
          st8((u16*)(ws + O_QH) + (size_t)row * 768 + col, v);
        } else if (mode == M_G3) {
          float rs = ((const float*)(ws + O_RINV))[row * 2 + 1];
#pragma unroll
          for (int e = 0; e < 8; ++e) v[e] *= rs;
          st8((u16*)(ws + O_KH) + ((size_t)(bb * 4 + (col >> 8)) * TPB + (trow + R)) * 192 + (col & 255), v);
        } else if (mode == M_POOL) {
          float g[8];
          ld8((const u16*)(ws + O_PROJ) + (size_t)row * NP + C_BG + col, g);
#pragma unroll
          for (int e = 0; e < 8; ++e) {
            float y = bf2f(f2bf(v[e] * p.pool_scale[layer * 512 + col + e]));
            v[e] = y * silu_f(g[e]);
          }
          st8((u16*)(ws + O_YS) + (size_t)row * 2048 + 512 + col, v);
        } else {
          float* xb;
          const float* gv;
          const float* xs;
          if (trow == 0) {
            xb = (float*)(ws + O_XC) + ((size_t)bb * CTXL + R) * D + col;
            xs = (layer == 0) ? p.ctx + ((size_t)bb * CTXL + R) * D + col : xb;
            gv = (const float*)(ws + O_MOD) + ((size_t)layer * 5 + 4) * 6144 + 4096 + col;
          } else {
            xb = p.out + ((size_t)bb * SEQ + (trow - CTXL) + R) * D + col;
            xs = (layer == 0) ? p.x + ((size_t)bb * SEQ + (trow - CTXL) + R) * D + col : xb;
            gv = (const float*)(ws + O_MOD) + ((size_t)layer * 5 + bb) * 6144 + 4096 + col;
          }
          f32x4 x0 = *(const f32x4*)xs, x1 = *(const f32x4*)(xs + 4);
          f32x4 g0 = *(const f32x4*)gv, g1 = *(const f32x4*)(gv + 4);
#pragma unroll
          for (int e = 0; e < 4; ++e) { x0[e] += PROBE_US * g0[e] * v[e]; x1[e] += PROBE_US * g1[e] * v[4 + e]; }
          *(f32x4*)xb = x0;
          *(f32x4*)(xb + 4) = x1;
        }
      }
    }
#pragma unroll 1
    for (int hj = 0; hj < 2; ++hj) {
      if (!(hj ? tr1 : tr0)) continue;
      const int gc = bcol + hj * HALF;
      u16* tdst;
      if (mode == M_G1A) tdst = (u16*)(ws + O_VTA) + ((size_t)(bb * 512 + (gc - C_AV))) * TPB + trow;
      else tdst = (u16*)(ws + O_VTC) + ((size_t)((bb * 4 + (gc >> 8)) * 128)) * TPB + trow;
      const int cl = tid & 127, rg = tid >> 7;
      const int ct = hj * HALF + cl;
#pragma unroll 1
      for (int i = 0; i < 8; ++i) {
        const int r0 = rg * 64 + i * 8;
        float v[8];
#pragma unroll
        for (int e = 0; e < 8; ++e) {
          const int r = r0 + e;
          v[e] = bf2f(stg[r * 256 + SWZ(r, ct >> 3) * 8 + (ct & 7)]);
          if (mode == M_G3) v[e] *= ((const float*)(ws + O_RINV))[(brow + r) * 2 + 1];
        }
        st8(tdst + (size_t)cl * TPB + r0, v);
      }
    }
  }
  LDS_BAR();
#undef SWZ
}

DEVI int xcd_remap(int t, int bid, int nblk) {
  if (nblk != 256) return t;
  int r = t / 256;
  return r * 256 + (bid & 7) * 32 + (bid >> 3);
}
DEVI void tile_map(int v, int nM, int nN, int& pm, int& pn) {
  int per = 4 * nN, band = v / per, idx = v % per;
  pm = band * 4 + (idx & 3);
  pn = idx >> 2;
}

struct WItem {
  const float* src; const float* kscale; u16* dst;
  int ldsrc, K, N, k0, n0, kind;
};
DEVI WItem wdecode(const P& p, char* ws, int l, int t, int tend, u16* wmerge) {
  constexpr int T_WIN1 = 32 * 114, T_WIN2 = 32 * 128, T_WBR = 4 * 8 * 32, T_WUQ = 8 * 12, T_WUKV = 8 * 16, T_POOL = 64;
  WItem w;
  w.kscale = nullptr; w.kind = 0; w.src = nullptr; w.dst = nullptr; w.ldsrc = 0; w.K = 0; w.N = 0; w.k0 = 0; w.n0 = 0;
  if (t >= tend) { w.kind = -1; return w; }
  int i = t;
  if (i < T_WIN1) {
    w.src = p.w_in + (size_t)l * 2048 * DIN; w.ldsrc = DIN; w.K = 2048; w.N = C_MG; w.dst = (u16*)(ws + O_WIN);
    w.k0 = (i & 31) * 64; w.n0 = (i >> 5) * 64; return w;
  }
  i -= T_WIN1;
  if (i < T_WIN2) {
    w.src = p.w_in + (size_t)l * 2048 * DIN + C_MG; w.ldsrc = DIN; w.K = 2048; w.N = 8192; w.dst = wmerge;
    w.k0 = (i & 31) * 64; w.n0 = (i >> 5) * 64; return w;
  }
  i -= T_WIN2;
  if (i < T_WBR) {
    int br = i >> 8, r = i & 255;
    w.src = p.w_br + ((size_t)l * 4 + br) * 512 * 2048; w.ldsrc = 2048; w.K = 512; w.N = 2048;
    w.dst = (u16*)(ws + O_WBR) + (size_t)br * 2048 * 512; w.k0 = (r & 7) * 64; w.n0 = (r >> 3) * 64; return w;
  }
  i -= T_WBR;
  if (i < T_WUQ) {
    w.src = p.w_uq + (size_t)l * 512 * 768; w.ldsrc = 768; w.K = 512; w.N = 768; w.dst = (u16*)(ws + O_WUQ);
    w.kscale = p.mla_gq + l * 512; w.k0 = (i & 7) * 64; w.n0 = (i >> 3) * 64; return w;
  }
  i -= T_WUQ;
  if (i < T_WUKV) {
    w.src = p.w_ukv + (size_t)l * 512 * 1024; w.ldsrc = 1024; w.K = 512; w.N = 1024; w.dst = (u16*)(ws + O_WUKV);
    w.kscale = p.mla_gkv + l * 512; w.k0 = (i & 7) * 64; w.n0 = (i >> 3) * 64; return w;
  }
  i -= T_WUKV;
  if (i < T_POOL) { w.kind = 1; w.n0 = i; return w; }
  i -= T_POOL;
  w.src = p.w_out + (size_t)l * 2048 * 2048; w.ldsrc = 2048; w.K = 2048; w.N = 2048; w.dst = (u16*)(ws + O_WOUT);
  w.k0 = (i & 31) * 64; w.n0 = (i >> 5) * 64;
  return w;
}
DEVI void wload(const WItem& w, float4 (&v)[2], int tid) {
#pragma unroll
  for (int it = 0; it < 2; ++it) {
    int i = tid + it * NTHR, tr = i >> 4, c4 = (i & 15) * 4;
    float4 x = make_float4(0.f, 0.f, 0.f, 0.f);
    if (w.n0 + c4 < w.N) x = *(const float4*)(w.src + (size_t)(w.k0 + tr) * w.ldsrc + w.n0 + c4);
    if (w.kscale) { float sc = w.kscale[w.k0 + tr]; x.x *= sc; x.y *= sc; x.z *= sc; x.w *= sc; }
    v[it] = x;
  }
}

__device__ void phase_wprep(const P& p, int l, int wmode, int rank, int count, int mod, int lo, int width, int sub_lo,
                            int sub_hi) {
  OPQ_IDS
  char* ws = opqp(p.ws);
  constexpr int T_W1 = 32 * 114, T_W2 = 32 * 128;
  constexpr int T_A = T_W1 + T_W2 + 4 * 8 * 32 + 8 * 12 + 8 * 16 + 64, T_WOUT = 32 * 32;
  const int ubeg = (wmode == 2) ? T_A : (wmode == 3) ? sub_lo : 0;
  const int uend = (wmode == 1) ? T_A - T_W2 : (wmode == 3) ? sub_hi : (wmode == 4) ? T_A : T_A + T_WOUT;
  const int tend = T_A + T_WOUT;
#define WMAP(u) ((u) >= uend ? tend : (wmode == 1) ? ((u) < T_W1 ? (u) : (u) + T_W2) : (wmode == 3) ? T_W1 + (u) : (u))
  u16* wmerge = (l & 1) ? (u16*)(ws + O_WINM1) : (u16*)(ws + O_WIN) + (size_t)C_MG * 2048;
  float* tiles = (float*)shm;
  int g = rank, par = 0;
  WItem cur = wdecode(p, ws, l, WMAP(ubeg + (g / width) * mod + lo + g % width), tend, wmerge);
  float4 v[2] = {make_float4(0.f, 0.f, 0.f, 0.f), make_float4(0.f, 0.f, 0.f, 0.f)};
  __syncthreads();
  if (cur.kind == 0) wload(cur, v, TIDX);
  while (cur.kind >= 0) {
    g += count;
    WItem nxt = wdecode(p, ws, l, WMAP(ubeg + (g / width) * mod + lo + g % width), tend, wmerge);
    float4 vn[2] = {make_float4(0.f, 0.f, 0.f, 0.f), make_float4(0.f, 0.f, 0.f, 0.f)};
    if (nxt.kind == 0) wload(nxt, vn, TIDX);
    if (cur.kind == 0) {
      float* tile = tiles + par * (64 * 65);
      par ^= 1;
#pragma unroll
      for (int it = 0; it < 2; ++it) {
        int i = TIDX + it * NTHR, tr = i >> 4, c4 = (i & 15) * 4;
        float* tp = tile + tr * 65 + c4;
        tp[0] = v[it].x; tp[1] = v[it].y; tp[2] = v[it].z; tp[3] = v[it].w;
      }
      __syncthreads();
      int tn = TIDX & 63, tk = (TIDX >> 6) * 8;
      if (cur.n0 + tn < cur.N) {
        bf16x8 o;
#pragma unroll
        for (int e = 0; e < 8; ++e) o[e] = (short)f2bf(tile[(tk + e) * 65 + tn]);
        *(bf16x8*)(cur.dst + (size_t)(cur.n0 + tn) * cur.K + cur.k0 + tk) = o;
      }
    } else {
      u16* dst = (u16*)(ws + O_POOL);
      for (int e = TIDX; e < 4096; e += NTHR) {
        int idx = cur.n0 * 4096 + e, n = idx >> 9, k = idx & 511;
        int gg = n >> 7, g2 = k >> 7;
        float x = 0.f;
        if (gg == g2) x = p.pool_w[(((size_t)l * 4 + gg) * 128 + (k & 127)) * 128 + (n & 127)];
        dst[idx] = f2bf(x);
      }
    }
    cur = nxt;
    v[0] = vn[0];
    v[1] = vn[1];
  }
  __syncthreads();
}
#undef WMAP

__device__ void phase_mod_partial(const P& p) {
  OPQ_IDS
  float* sl = (float*)shm;
  float* modp = (float*)(p.ws + O_MODP);
  for (int t = BIDX; t < 4 * 24 * 16; t += gridDim.x) {
    int l = t / 384, r = t % 384, nb = r / 16, ks = r % 16;
    __syncthreads();
    for (int i = TIDX; i < 640; i += NTHR) {
      int v = i >> 7, k = i & 127;
      float cv = (v < 4) ? p.c[v * 2048 + ks * 128 + k] : p.c_ctx[ks * 128 + k];
      sl[i] = silu_f(cv);
    }
    __syncthreads();
    int col = TIDX & 255, kh = TIDX >> 8;
    float a[5] = {0, 0, 0, 0, 0};
    const float* w = p.w_mod + ((size_t)l * 2048 + ks * 128 + kh * 64) * 6144 + nb * 256 + col;
#pragma unroll 4
    for (int k = 0; k < 64; ++k) {
      float wv = w[(size_t)k * 6144];
#pragma unroll
      for (int v = 0; v < 5; ++v) a[v] += sl[v * 128 + kh * 64 + k] * wv;
    }
    __syncthreads();
    float* part = sl + 1024;
    if (kh == 1) {
#pragma unroll
      for (int v = 0; v < 5; ++v) part[v * 256 + col] = a[v];
    }
    __syncthreads();
    if (kh == 0) {
#pragma unroll
      for (int v = 0; v < 5; ++v)
        modp[(((size_t)l * 16 + ks) * 5 + v) * 6144 + nb * 256 + col] = a[v] + part[v * 256 + col];
    }
  }
  float2* rt = (float2*)(p.ws + O_ROPE);
  for (int i = BIDX * NTHR + TIDX; i < 1024; i += gridDim.x * NTHR) {
    int pos = i >> 4, j = i & 15;
    float inv = powf(10000.f, -(float)j / 16.f);
    float ang = (float)pos * inv;
    rt[i] = make_float2(cosf(ang), sinf(ang));
  }
}
__device__ void phase_mod_reduce(const P& p) {
  OPQ_IDS
  const float* modp = (const float*)(p.ws + O_MODP);
  float* mod = (float*)(p.ws + O_MOD);
  for (int i = BIDX * NTHR + TIDX; i < 4 * 5 * 6144; i += gridDim.x * NTHR) {
    int l = i / 30720, r = i % 30720, n = r % 6144;
    float s = p.b_mod[l * 6144 + n];
    for (int ks = 0; ks < 16; ++ks) s += modp[((size_t)l * 16 + ks) * 30720 + r];
    mod[i] = s;
  }
}

DEVI float* xrow_ptr(const P& p, int r) {
  int b = r / TPB, t = r - b * TPB;
  return (t < CTXL) ? (float*)(p.ws + O_XC) + ((size_t)b * CTXL + t) * D : p.out + ((size_t)b * SEQ + (t - CTXL)) * D;
}
__device__ void phase_norm(const P& p, int l) {
  OPQ_IDS
  int lane = TIDX & 63, gw = BIDX * 8 + (TIDX >> 6), nw = gridDim.x * 8;
  const float* mod = (const float*)(p.ws + O_MOD);
  u16* hn = (u16*)(p.ws + O_HN);
  for (int r = gw; r < NTOK; r += nw) {
    int b = r / TPB, t = r - b * TPB;
    float* xr = xrow_ptr(p, r);
    const float* src = xr;
    if (l == 0) src = (t < CTXL) ? p.ctx + ((size_t)b * CTXL + t) * D : p.x + ((size_t)b * SEQ + (t - CTXL)) * D;
    const float* mv = mod + ((size_t)l * 5 + (t < CTXL ? 4 : b)) * 6144;
    float4 v[8];
    float ss = 0.f;
#pragma unroll
    for (int i = 0; i < 8; ++i) {
      v[i] = *(const float4*)(src + i * 256 + lane * 4);
      ss += v[i].x * v[i].x + v[i].y * v[i].y + v[i].z * v[i].z + v[i].w * v[i].w;
    }
    ss = wave_sum(ss);
    float rs = rsqrtf(ss * (1.f / D) + EPS);
#pragma unroll
    for (int i = 0; i < 8; ++i) {
      int c0 = i * 256 + lane * 4;
      float4 g = *(const float4*)(p.norm_g + l * D + c0);
      float4 sh = *(const float4*)(mv + c0);
      float4 sc = *(const float4*)(mv + 2048 + c0);
      unsigned a0 = f2bf(v[i].x * rs * g.x * (1.f + sc.x) + sh.x), a1 = f2bf(v[i].y * rs * g.y * (1.f + sc.y) + sh.y);
      unsigned a2 = f2bf(v[i].z * rs * g.z * (1.f + sc.z) + sh.z), a3 = f2bf(v[i].w * rs * g.w * (1.f + sc.w) + sh.w);
      uint2 o = make_uint2(a0 | (a1 << 16), a2 | (a3 << 16));
      *(uint2*)(hn + (size_t)r * D + c0) = o;
    }
  }
}
__device__ void phase_final(const P& p) {
  OPQ_IDS
  int lane = TIDX & 63, gw = BIDX * 8 + (TIDX >> 6), nw = gridDim.x * 8;
  for (int r = gw; r < NBATCH * SEQ; r += nw) {
    float* xr = p.out + (size_t)r * D;
    float4 v[8];
    float ss = 0.f;
#pragma unroll
    for (int i = 0; i < 8; ++i) {
      v[i] = *(const float4*)(xr + i * 256 + lane * 4);
      ss += v[i].x * v[i].x + v[i].y * v[i].y + v[i].z * v[i].z + v[i].w * v[i].w;
    }
    ss = wave_sum(ss);
    float rs = rsqrtf(ss * (1.f / D) + EPS);
#pragma unroll
    for (int i = 0; i < 8; ++i) {
      int c0 = i * 256 + lane * 4;
      float4 g = *(const float4*)(p.g_final + c0);
      *(float4*)(xr + c0) = make_float4(v[i].x * rs * g.x, v[i].y * rs * g.y, v[i].z * rs * g.z, v[i].w * rs * g.w);
    }
  }
}

__device__ void phase_p2(const P& p, int l) {
  OPQ_IDS
  int lane = TIDX & 63, gw = xcd_remap(BIDX, BIDX, gridDim.x) * 8 + (TIDX >> 6), nw = gridDim.x * 8;
  char* ws = opqp(p.ws);
  const u16* proj = (const u16*)(ws + O_PROJ);
  float* rinv = (float*)(ws + O_RINV);
  const float2* rt = (const float2*)(ws + O_ROPE);
  float cw[2][4][8];
#pragma unroll
  for (int part = 0; part < 2; ++part)
#pragma unroll
    for (int j = 0; j < 4; ++j) {
      const float* cp = p.conv_w + ((size_t)l * 4 + j) * 1024 + part * 512 + lane * 8;
      f32x4 c0 = *(const f32x4*)cp, c1 = *(const f32x4*)(cp + 4);
#pragma unroll
      for (int i = 0; i < 4; ++i) { cw[part][j][i] = c0[i]; cw[part][j][4 + i] = c1[i]; }
    }
  const float bif = (lane < 16) ? p.b_if[l * 16 + lane] : 0.f;
  const bf16x8 z8 = {0, 0, 0, 0, 0, 0, 0, 0};
  for (int r = gw; r < NTOK; r += nw) {
    int b = r / TPB, t = r - b * TPB;
    const bool isctx = t < CTXL;
    const int pos = isctx ? t : t - CTXL;
    const int n = isctx ? CTXL : SEQ;
    const u16* pr = proj + (size_t)r * NP;
    const bf16x8 vq = *(const bf16x8*)(pr + C_CQ + lane * 8);
    const bf16x8 vkv = *(const bf16x8*)(pr + C_CKV + lane * 8);
    const u16 kro = pr[C_CKR + lane], krp = pr[C_CKR + (lane ^ 16)];
    const u16 dif = pr[C_DIF + (lane & 15)];
    const int g = lane >> 4, w = 2 << g;
    const int lo = max(pos - w / 2, 0), hi = min(pos + (w - 1 - w / 2), n - 1);
    bf16x8 wv[16];
#pragma unroll
    for (int k = 0; k < 16; ++k) {
      int u = pos + k - 8;
      wv[k] = z8;
      if (u >= lo && u <= hi) wv[k] = *(const bf16x8*)(pr + (ptrdiff_t)(k - 8) * NP + C_BI + lane * 8);
    }
    bf16x8 cv[2][4];
#pragma unroll
    for (int part = 0; part < 2; ++part)
#pragma unroll
      for (int j = 0; j < 4; ++j) {
        int u = pos + j - 2;
        cv[part][j] = z8;
        if (u >= 0 && u < n) cv[part][j] = *(const bf16x8*)(pr + (ptrdiff_t)(j - 2) * NP + C_DQ + part * 512 + lane * 8);
      }
    float sq = 0.f, skv = 0.f;
#pragma unroll
    for (int i = 0; i < 8; ++i) { float a = bfs(vq[i]), c = bfs(vkv[i]); sq += a * a; skv += c * c; }
    sq = wave_sum(sq);
    skv = wave_sum(skv);
    if (lane == 0) {
      rinv[r * 2] = rsqrtf(sq * (1.f / 512.f) + EPS);
      rinv[r * 2 + 1] = rsqrtf(skv * (1.f / 512.f) + EPS);
    }
    {
      float own = bf2f(kro);
      float o = own;
      if (!isctx) {
        float par = bf2f(krp);
        int half = lane >> 5, ii = lane & 31, j = ii & 15;
        int pp = half ? (pos & 63) : (pos >> 6);
        float2 cs = rt[pp * 16 + j];
        o = (ii < 16) ? own * cs.x - par * cs.y : own * cs.x + par * cs.y;
      }
      u16 ob = f2bf(o);
      u16* kh = (u16*)(ws + O_KH) + ((size_t)(b * 4) * TPB + t) * 192 + 128 + lane;
#pragma unroll
      for (int h = 0; h < 4; ++h) kh[(size_t)h * TPB * 192] = ob;
    }
    {
      float s[8] = {0, 0, 0, 0, 0, 0, 0, 0};
#pragma unroll
      for (int k = 0; k < 16; ++k)
#pragma unroll
        for (int i = 0; i < 8; ++i) s[i] += bfs(wv[k][i]);
      float ic = 1.f / (float)(hi - lo + 1);
#pragma unroll
      for (int i = 0; i < 8; ++i) s[i] = s[i] * ic - bfs(wv[8][i]);
      st8((u16*)(ws + O_DPOOL) + (size_t)r * 512 + lane * 8, s);
    }
#pragma unroll
    for (int part = 0; part < 2; ++part) {
      float a[8] = {0, 0, 0, 0, 0, 0, 0, 0};
#pragma unroll
      for (int j = 0; j < 4; ++j)
#pragma unroll
        for (int i = 0; i < 8; ++i) a[i] += bfs(cv[part][j][i]) * cw[part][j][i];
      const float ksc = part ? 0.08838834764831845f : 1.f;
#pragma unroll
      for (int i = 0; i < 8; ++i) a[i] = silu_f(a[i]) * ksc;
      st8((u16*)(ws + O_QKC) + (size_t)r * 1024 + part * 512 + lane * 8, a);
    }
    if (lane < 16) {
      float gg = bf2f(dif) + bif;
      if (lane & 4) gg = fminf(gg, 0.f) - __logf(1.f + __expf(-fabsf(gg)));
      ((float*)(ws + O_GL))[(size_t)r * 16 + lane] = gg;
    }
  }
}

struct AttnTile {
  const u16* kp;
  const u16* vp;
  int isctx;
  int kr;
};

template <int DQK, int QT, bool NA>
__device__ void attn_block(const P& p, int layer, int b, int h, int qrow0  , bool q_is_latent,
                           int ntile, int na_r0  , const u16* Kbase, int ldk,
                           const u16* Vtbase  , const u16* Qbase, int ldq, int gatecol,
                           int ycol, float scale) {
  OPQ_IDS
  constexpr int KS = DQK / 32;
  constexpr int KSTR = DQK + 8;
  const float scale2 = scale * 1.4426950408889634f;
  constexpr int KCH = 64 * DQK / 8 / NTHR;
  u16* Ks = (u16*)shm;
  u16* Vs = Ks + 64 * KSTR;
  float* rpb = (float*)(Vs + 128 * 72);
  const int wid = TIDX >> 6, lane = TIDX & 63, l15 = lane & 15, quad = lane >> 4;
  char* ws = opqp(p.ws);
  const float2* rt = (const float2*)(ws + O_ROPE);

  __syncthreads();
  if (NA) {
    for (int i = TIDX; i < 465; i += NTHR) rpb[i] = p.na_rpb[((size_t)layer * 4 + h) * 465 + i];
  }
  bf16x8 qf[QT][KS];
#pragma unroll
  for (int qt = 0; qt < QT; ++qt) {
    int ql = wid * 16 * QT + qt * 16 + l15;
    const u16* qp = Qbase + (size_t)(qrow0 + ql) * ldq;
#pragma unroll
    for (int ks = 0; ks < KS; ++ks) qf[qt][ks] = *(const bf16x8*)(qp + ks * 32 + quad * 8);
  }
  f32x4 o[8][QT];
  float mrun[QT], lrun[QT];
#pragma unroll
  for (int qt = 0; qt < QT; ++qt) {
    mrun[qt] = -1e30f;
    lrun[qt] = 0.f;
#pragma unroll
    for (int dt = 0; dt < 8; ++dt) o[dt][qt] = f32x4{0.f, 0.f, 0.f, 0.f};
  }
  int na_rq = 0, na_cq = 0, na_cs = 0, na_rs = 0;
  if (NA) {
    na_rq = na_r0 + (wid >> 2);
    na_cq = (wid & 3) * 16 + l15;
    na_cs = min(max(na_cq - 8, 0), 48);
    na_rs = min(max(na_rq - 4, 0), 56);
  }
  const int na_rlo = NA ? min(max(na_r0 - 4, 0), 56) : 0;

  bf16x8 kreg[KCH], vreg[2];
  auto tile_ptrs = [&](int ti, const u16*& kp, const u16*& vp, int& isctx, int& kr) {
    int tok0;
    if (ti < 4) {
      tok0 = ti * 64;
      isctx = 1;
      kr = -1;
    } else {
      isctx = 0;
      kr = NA ? (na_rlo + ti - 4) : (ti - 4);
      tok0 = CTXL + kr * 64;
    }
    kp = Kbase + (size_t)tok0 * ldk;
    vp = Vtbase + tok0;
  };
  auto gloadK = [&](int ti) {
    const u16 *kp, *vp;
    int ic, kr;
    tile_ptrs(ti, kp, vp, ic, kr);
#pragma unroll
    for (int i = 0; i < KCH; ++i) {
      int c = TIDX + i * NTHR, key = c / (DQK / 8), part = c % (DQK / 8);
      kreg[i] = *(const bf16x8*)(kp + (size_t)key * ldk + part * 8);
    }
  };
  auto gloadV = [&](int ti) {
    const u16 *kp, *vp;
    int ic, kr;
    tile_ptrs(ti, kp, vp, ic, kr);
#pragma unroll
    for (int i = 0; i < 2; ++i) {
      int c = TIDX + i * NTHR, dv = c >> 3, part = c & 7;
      vreg[i] = *(const bf16x8*)(vp + (size_t)dv * TPB + part * 8);
    }
  };
  auto sstoreK = [&]() {
#pragma unroll
    for (int i = 0; i < KCH; ++i) {
      int c = TIDX + i * NTHR, key = c / (DQK / 8), part = c % (DQK / 8);
      *(bf16x8*)(Ks + key * KSTR + part * 8) = kreg[i];
    }
  };
  auto sstoreV = [&]() {
#pragma unroll
    for (int i = 0; i < 2; ++i) {
      int c = TIDX + i * NTHR, dv = c >> 3, part = c & 7;
      *(bf16x8*)(Vs + dv * 72 + part * 8) = vreg[i];
    }
  };

  gloadK(0);
  gloadV(0);
  __syncthreads();
  sstoreK();
  sstoreV();
  if (ntile > 1) { gloadK(1); gloadV(1); }
  LDS_BAR();
  auto tile_iter = [&](int ti) {
    const int isctx = ti < 4;
    int kr = NA ? (na_rlo + ti - 4) : 0;
    bool active = true;
    if (NA && !isctx) active = (kr >= na_rs) && (kr < na_rs + 8);
    f32x4 s[4][QT];
    if (active) {
#pragma unroll
      for (int kt = 0; kt < 4; ++kt)
#pragma unroll
        for (int qt = 0; qt < QT; ++qt) s[kt][qt] = f32x4{0.f, 0.f, 0.f, 0.f};
#pragma unroll
      for (int ks = 0; ks < KS; ++ks) {
        bf16x8 a[4];
#pragma unroll
        for (int kt = 0; kt < 4; ++kt) a[kt] = *(const bf16x8*)(Ks + (kt * 16 + l15) * KSTR + ks * 32 + quad * 8);
#pragma unroll
        for (int qt = 0; qt < QT; ++qt) {
          bf16x8 q = qf[qt][ks];
#pragma unroll
          for (int kt = 0; kt < 4; ++kt) s[kt][qt] = __builtin_amdgcn_mfma_f32_16x16x32_bf16(a[kt], q, s[kt][qt], 0, 0, 0);
        }
      }
    }
    LDS_BAR();
    if (ti + 1 < ntile) sstoreK();
    if (ti + 2 < ntile) gloadK(ti + 2);
    if (active) {
      bf16x8 pf[QT][2];
#pragma unroll
      for (int qt = 0; qt < QT; ++qt) {
        float mx = -1e30f;
#pragma unroll
        for (int kt = 0; kt < 4; ++kt)
#pragma unroll
          for (int j = 0; j < 4; ++j) {
            float v = s[kt][qt][j] * scale2;
            if (NA && !isctx) {
              int ck = kt * 16 + quad * 4 + j;
              bool valid = (ck >= na_cs) && (ck < na_cs + 16);
              int bidx = (kr - na_rq + 7) * 31 + min(max(ck - na_cq + 15, 0), 30);
              v = valid ? v + rpb[bidx] * 1.4426950408889634f : -1e30f;
            }
            s[kt][qt][j] = v;
            mx = fmaxf(mx, v);
          }
        mx = fmaxf(mx, SHX(mx, 16));
        mx = fmaxf(mx, SHX(mx, 32));
        float mnew = fmaxf(mrun[qt], mx);
        float alpha = __builtin_amdgcn_exp2f(mrun[qt] - mnew);
        mrun[qt] = mnew;
        float ls = 0.f;
#pragma unroll
        for (int kt = 0; kt < 4; ++kt)
#pragma unroll
          for (int j = 0; j < 4; ++j) {
            float pv = __builtin_amdgcn_exp2f(s[kt][qt][j] - mnew);
            ls += pv;
            s[kt][qt][j] = pv;
          }
        lrun[qt] = lrun[qt] * alpha + ls;
        if (__builtin_amdgcn_ballot_w64(alpha != 1.f)) {
#pragma unroll
          for (int dt = 0; dt < 8; ++dt)
#pragma unroll
            for (int j = 0; j < 4; ++j) o[dt][qt][j] *= alpha;
        }
#pragma unroll
        for (int kk = 0; kk < 2; ++kk) {
          union { bf16x8 v; unsigned u[4]; } cv;
          cv.u[0] = pk2(s[2 * kk][qt][0], s[2 * kk][qt][1]);
          cv.u[1] = pk2(s[2 * kk][qt][2], s[2 * kk][qt][3]);
          cv.u[2] = pk2(s[2 * kk + 1][qt][0], s[2 * kk + 1][qt][1]);
          cv.u[3] = pk2(s[2 * kk + 1][qt][2], s[2 * kk + 1][qt][3]);
          pf[qt][kk] = cv.v;
        }
      }
      {
        const u16* vb0 = Vs + l15 * 72 + quad * 4;
        bf16x4 n0 = *(const bf16x4*)vb0, n1 = *(const bf16x4*)(vb0 + 16);
#pragma unroll
        for (int idx = 0; idx < 16; ++idx) {
          const int kk = idx >> 3, dt = idx & 7;
          bf16x8 va = {n0[0], n0[1], n0[2], n0[3], n1[0], n1[1], n1[2], n1[3]};
          if (idx + 1 < 16) {
            const int kk2 = (idx + 1) >> 3, dt2 = (idx + 1) & 7;
            const u16* vb = Vs + (dt2 * 16 + l15) * 72 + kk2 * 32 + quad * 4;
            n0 = *(const bf16x4*)vb;
            n1 = *(const bf16x4*)(vb + 16);
          }
#pragma unroll
          for (int qt = 0; qt < QT; ++qt) o[dt][qt] = __builtin_amdgcn_mfma_f32_16x16x32_bf16(va, pf[qt][kk], o[dt][qt], 0, 0, 0);
        }
      }
    }
    LDS_BAR();
    if (ti + 1 < ntile) sstoreV();
    if (ti + 2 < ntile) gloadV(ti + 2);
  };
  for (int ti = 0; ti < 4; ++ti) tile_iter(ti);
  if (ntile > 4) {
    if (!NA && DQK == 192) {
#pragma unroll
      for (int qt = 0; qt < QT; ++qt) {
        const int ql = wid * 16 * QT + qt * 16 + l15;
        const u16* qp = Qbase + (size_t)(qrow0 + ql) * ldq;
        const int tq = (qrow0 + ql) % TPB - CTXL;
#pragma unroll
        for (int hf = 0; hf < 2; ++hf) {
          bf16x8 own = qf[qt][KS - 2 + hf];
          bf16x8 par = *(const bf16x8*)(qp + 128 + hf * 32 + (quad ^ 2) * 8);
          int pp = hf ? (tq & 63) : (tq >> 6);
          bf16x8 ro;
#pragma unroll
          for (int e = 0; e < 8; ++e) {
            float2 cs = rt[pp * 16 + (quad & 1) * 8 + e];
            float ov = bfs(own[e]), pv = bfs(par[e]);
            float r = (quad < 2) ? ov * cs.x - pv * cs.y : ov * cs.x + pv * cs.y;
            ro[e] = (short)f2bf(r);
          }
          qf[qt][KS - 2 + hf] = ro;
        }
      }
    }
    for (int ti = 4; ti < ntile; ++ti) tile_iter(ti);
  }
  const u16* proj = (const u16*)(ws + O_PROJ);
  u16* ys = (u16*)(ws + O_YS);
#pragma unroll
  for (int qt = 0; qt < QT; ++qt) {
    float lt = lrun[qt];
    lt += SHX(lt, 16);
    lt += SHX(lt, 32);
    float il = 1.f / lt;
    int r = qrow0 + wid * 16 * QT + qt * 16 + l15;
#pragma unroll
    for (int dt = 0; dt < 8; ++dt) {
      int dv = dt * 16 + quad * 4;
      bf16x4 g = *(const bf16x4*)(proj + (size_t)r * NP + gatecol + h * 128 + dv);
      bf16x4 ov;
#pragma unroll
      for (int j = 0; j < 4; ++j) {
        float y = bf2f(f2bf(o[dt][qt][j] * il));
        ov[j] = (short)f2bf(y * silu_f(bfs(g[j])));
      }
      *(bf16x4*)(ys + (size_t)r * 2048 + ycol + h * 128 + dv) = ov;
    }
  }
}

__device__ void phase_attn(const P& p, int l) {
  OPQ_IDS
  char* ws = opqp(p.ws);
  const bool need_ctx = l < 3;
  const int n_mla_lat = 256, n_na_lat = 512;
  const int n_mla_ctx = need_ctx ? 16 : 0, n_na_ctx = need_ctx ? 32 : 0;
  const int total = n_mla_lat + n_na_lat + n_mla_ctx + n_na_ctx;
  const u16* proj = (const u16*)(ws + O_PROJ);
  for (int it0 = BIDX; it0 < (total + 255) / 256 * 256; it0 += gridDim.x) {
    const int it = xcd_remap(it0, BIDX, gridDim.x);
    if (it >= total) continue;
    int i = it;
    if (i < n_mla_lat) {
      int bh = i >> 4, qb = i & 15, b = bh >> 2, h = bh & 3;
      attn_block<192, 2, false>(p, l, b, h, b * TPB + CTXL + qb * 256, true, 68, 0,
                                (const u16*)(ws + O_KH) + (size_t)bh * TPB * 192, 192,
                                (const u16*)(ws + O_VTC) + (size_t)bh * 128 * TPB,
                                (const u16*)(ws + O_QH) + h * 192, 768, C_CG, 1024, 0.07216878364870322f);
      continue;
    }
    i -= n_mla_lat;
    if (i < n_na_lat) {
      int bh = i >> 5, rp = i & 31, b = bh >> 2, h = bh & 3;
      int r0 = rp * 2;
      int rlo = min(max(r0 - 4, 0), 56), rhi = min(max(r0 + 1 - 4, 0), 56) + 7;
      attn_block<128, 1, true>(p, l, b, h, b * TPB + CTXL + r0 * 64, true, 4 + (rhi - rlo + 1), r0,
                               proj + (size_t)b * TPB * NP + C_AK + h * 128, NP,
                               (const u16*)(ws + O_VTA) + (size_t)bh * 128 * TPB, proj + C_AQ + h * 128, NP, C_AG, 0,
                               0.08838834764831845f);
      continue;
    }
    i -= n_na_lat;
    if (i < n_mla_ctx) {
      int bh = i, b = bh >> 2, h = bh & 3;
      attn_block<192, 2, false>(p, l, b, h, b * TPB, false, 4, 0, (const u16*)(ws + O_KH) + (size_t)bh * TPB * 192, 192,
                                (const u16*)(ws + O_VTC) + (size_t)bh * 128 * TPB, (const u16*)(ws + O_QH) + h * 192,
                                768, C_CG, 1024, 0.07216878364870322f);
      continue;
    }
    i -= n_mla_ctx;
    {
      int bh = i >> 1, half = i & 1, b = bh >> 2, h = bh & 3;
      attn_block<128, 1, false>(p, l, b, h, b * TPB + half * 128, false, 4, 0,
                                proj + (size_t)b * TPB * NP + C_AK + h * 128, NP,
                                (const u16*)(ws + O_VTA) + (size_t)bh * 128 * TPB, proj + C_AQ + h * 128, NP, C_AG, 0,
                                0.08838834764831845f);
    }
  }
}

DEVI int chunk_index(int dir, int blk) {
  if (dir == 0) return blk;
  return blk < 4 ? 3 - blk : 4 + 63 - (blk - 4);
}
__device__ void mlstm_gates(const P& p, int b, int h, int blk, float* gs) {
  OPQ_IDS
  const float* gl = (const float*)(opqp(p.ws) + O_GL);
  int R0 = b * TPB + blk * 64;
  if (TIDX < 128) {
    const int dir = TIDX >> 6, L = LANE, t = dir ? 63 - L : L;
    const float li = gl[(size_t)(R0 + t) * 16 + dir * 8 + h];
    const float lf = gl[(size_t)(R0 + t) * 16 + dir * 8 + 4 + h];
    float bc = lf;
#pragma unroll
    for (int o = 1; o < 64; o <<= 1) {
      float n = __int_as_float(__builtin_amdgcn_ds_bpermute(((L - o) & 63) << 2, __float_as_int(bc)));
      if (L >= o) bc += n;
    }
    float pm = li - bc;
#pragma unroll
    for (int o = 1; o < 64; o <<= 1) {
      float n = __int_as_float(__builtin_amdgcn_ds_bpermute(((L - o) & 63) << 2, __float_as_int(pm)));
      if (L >= o) pm = fmaxf(pm, n);
    }
    gs[dir * 64 + t] = li;
    gs[128 + dir * 64 + t] = lf;
    gs[256 + dir * 64 + t] = bc;
    gs[384 + dir * 64 + t] = pm;
    if (L == 63) {
      gs[512 + dir * 4] = bc;
      gs[512 + dir * 4 + 1] = bc + pm;
    }
  }
  __syncthreads();
}

__device__ void phase_m1(const P& p) {
  OPQ_IDS
  char* ws = opqp(p.ws);
  u16* kwT = (u16*)shm;
  u16* vT = kwT + 2 * 128 * 72;
  float* gs = (float*)(vT + 128 * 72);
  const u16* qkc = (const u16*)(ws + O_QKC);
  const u16* proj = (const u16*)(ws + O_PROJ);
  const int wid = TIDX >> 6, lane = TIDX & 63, l15 = lane & 15, quad = lane >> 4;
  for (int it = BIDX; it < 16 * 68; it += gridDim.x) {
    int bh = it / 68, blk = it % 68, b = bh >> 2, h = bh & 3;
    int R0 = b * TPB + blk * 64;
    __syncthreads();
    mlstm_gates(p, b, h, blk, gs);
#pragma unroll
    for (int i = 0; i < 2; ++i) {
      int c = TIDX + i * NTHR, s = c & 63, part = c >> 6;
      float kf[8];
      ld8(qkc + (size_t)(R0 + s) * 1024 + 512 + h * 128 + part * 8, kf);
      bf16x8 vv = *(const bf16x8*)(proj + (size_t)(R0 + s) * NP + C_DV + h * 128 + part * 8);
#pragma unroll
      for (int dir = 0; dir < 2; ++dir) {
        float bl = gs[512 + dir * 4], ml = gs[512 + dir * 4 + 1];
        float w = __expf(bl - gs[256 + dir * 64 + s] + gs[dir * 64 + s] - ml);
#pragma unroll
        for (int e = 0; e < 8; ++e) kwT[(dir * 128 + part * 8 + e) * 72 + s] = f2bf(kf[e] * w);
      }
#pragma unroll
      for (int e = 0; e < 8; ++e) vT[(part * 8 + e) * 72 + s] = (u16)vv[e];
    }
    __syncthreads();
    int dir = wid >> 2;
    int item = (bh * 2 + dir) * 68 + chunk_index(dir, blk);
    f32x4 acc[2][8];
#pragma unroll
    for (int a = 0; a < 2; ++a)
#pragma unroll
      for (int e = 0; e < 8; ++e) acc[a][e] = f32x4{0.f, 0.f, 0.f, 0.f};
#pragma unroll
    for (int kk = 0; kk < 2; ++kk) {
      bf16x8 af[2];
#pragma unroll
      for (int a = 0; a < 2; ++a) {
        const u16* ab = kwT + (dir * 128 + ((wid & 3) * 2 + a) * 16 + l15) * 72 + kk * 32 + quad * 4;
        bf16x4 v0 = *(const bf16x4*)ab, v1 = *(const bf16x4*)(ab + 16);
        af[a] = bf16x8{v0[0], v0[1], v0[2], v0[3], v1[0], v1[1], v1[2], v1[3]};
      }
#pragma unroll
      for (int e = 0; e < 8; ++e) {
        const u16* bb = vT + (e * 16 + l15) * 72 + kk * 32 + quad * 4;
        bf16x4 v0 = *(const bf16x4*)bb, v1 = *(const bf16x4*)(bb + 16);
        bf16x8 bf = bf16x8{v0[0], v0[1], v0[2], v0[3], v1[0], v1[1], v1[2], v1[3]};
#pragma unroll
        for (int a = 0; a < 2; ++a) acc[a][e] = __builtin_amdgcn_mfma_f32_16x16x32_bf16(af[a], bf, acc[a][e], 0, 0, 0);
      }
    }
    float* kl = (float*)(ws + O_KLOC) + (size_t)item * 16384;
#pragma unroll
    for (int a = 0; a < 2; ++a)
#pragma unroll
      for (int e = 0; e < 8; ++e) {
        int d0 = ((wid & 3) * 2 + a) * 16 + quad * 4, ee = e * 16 + l15;
        *(f32x4*)(kl + ee * 128 + d0) = acc[a][e];
      }
    if (TIDX < 256) {
      int dr = TIDX >> 7, d = TIDX & 127;
      float s = 0.f;
      for (int u = 0; u < 64; ++u) s += bf2f(kwT[(dr * 128 + d) * 72 + u]);
      int itm = (bh * 2 + dr) * 68 + chunk_index(dr, blk);
      ((float*)(ws + O_NLOC))[(size_t)itm * 128 + d] = s;
      if (d < 2) ((float*)(ws + O_SC))[itm * 2 + d] = gs[512 + dr * 4 + d];
    }
  }
}

__device__ void phase_m2(const P& p) {
  OPQ_IDS
  char* ws = opqp(p.ws);
  const float* kloc = (const float*)(ws + O_KLOC);
  const float* nloc = (const float*)(ws + O_NLOC);
  const float* sc = (const float*)(ws + O_SC);
  u16* cin = (u16*)(ws + O_CIN);
  float* nin = (float*)(ws + O_NIN);
  float* minp = (float*)(ws + O_MIN);
  const int per = 4096 + 32;
  for (int idx = BIDX * NTHR + TIDX; idx < 32 * per; idx += gridDim.x * NTHR) {
    int seq = idx / per, q4 = idx % per;
    f32x4 C = {0.f, 0.f, 0.f, 0.f};
    float m = 0.f;
    const bool isn = q4 >= 4096;
    for (int j0 = 0; j0 < 68; j0 += 4) {
      f32x4 kv[4];
      float bl[4], ml[4];
#pragma unroll
      for (int u = 0; u < 4; ++u) {
        int item = seq * 68 + j0 + u;
        kv[u] = isn ? *(const f32x4*)(nloc + (size_t)item * 128 + (q4 - 4096) * 4)
                    : *(const f32x4*)(kloc + (size_t)item * 16384 + q4 * 4);
        bl[u] = sc[item * 2];
        ml[u] = sc[item * 2 + 1];
      }
#pragma unroll
      for (int u = 0; u < 4; ++u) {
        int item = seq * 68 + j0 + u;
        if (isn) {
          *(f32x4*)(nin + (size_t)item * 128 + (q4 - 4096) * 4) = C;
          if (q4 == 4096) minp[item] = m;
        } else {
          bf16x4 o;
#pragma unroll
          for (int e = 0; e < 4; ++e) o[e] = (short)f2bf(C[e]);
          *(bf16x4*)(cin + (size_t)item * 16384 + q4 * 4) = o;
        }
        float mn = fmaxf(bl[u] + m, ml[u]);
        float dec = __expf(bl[u] + m - mn), wl = __expf(ml[u] - mn);
#pragma unroll
        for (int e = 0; e < 4; ++e) C[e] = dec * C[e] + wl * kv[u][e];
        m = mn;
      }
    }
  }
}

__device__ void phase_m3(const P& p, int l) {
  OPQ_IDS
  char* ws = opqp(p.ws);
  u16* Qs = (u16*)shm;
  u16* Ks = Qs + 64 * 136;
  u16* vT = Ks + 64 * 136;
  float* gs = (float*)(vT + 128 * 72);
  float* qn = gs + 528;
  float* ninl = qn + 128;
  float* hbuf = ninl + 256;
  const u16* qkc = (const u16*)(ws + O_QKC);
  const u16* proj = (const u16*)(ws + O_PROJ);
  const int wid = TIDX >> 6, lane = TIDX & 63, l15 = lane & 15, quad = lane >> 4;
  const bool need_ctx = l < 3;
  for (int it = BIDX; it < 16 * 68; it += gridDim.x) {
    int bh = it / 68, blk = it % 68, b = bh >> 2, h = bh & 3;
    if (!need_ctx && blk < 4) continue;
    int R0 = b * TPB + blk * 64;
    int itemd[2];
    itemd[0] = (bh * 2 + 0) * 68 + chunk_index(0, blk);
    itemd[1] = (bh * 2 + 1) * 68 + chunk_index(1, blk);
    bf16x8 lq[2], lk[2], lv[2];
#pragma unroll
    for (int i = 0; i < 2; ++i) {
      int c = TIDX + i * NTHR, s = c >> 4, part = c & 15;
      lq[i] = *(const bf16x8*)(qkc + (size_t)(R0 + s) * 1024 + h * 128 + part * 8);
      lk[i] = *(const bf16x8*)(qkc + (size_t)(R0 + s) * 1024 + 512 + h * 128 + part * 8);
      int c2s = c & 63, c2p = c >> 6;
      lv[i] = *(const bf16x8*)(proj + (size_t)(R0 + c2s) * NP + C_DV + h * 128 + c2p * 8);
    }
    float lnin = 0.f;
    if (TIDX < 256) lnin = ((const float*)(ws + O_NIN))[(size_t)itemd[TIDX >> 7] * 128 + (TIDX & 127)];
    const float m_in = ((const float*)(ws + O_MIN))[itemd[wid >> 2]];
    bf16x8 ldo[2], ldg[2];
    f32x4 lgn[4];
    {
      const int tt = TIDX >> 3, ch0 = h * 128 + (TIDX & 7) * 16;
      const u16* pr = proj + (size_t)(R0 + tt) * NP;
      ldo[0] = *(const bf16x8*)(pr + C_DO + ch0);
      ldo[1] = *(const bf16x8*)(pr + C_DO + ch0 + 8);
      ldg[0] = *(const bf16x8*)(pr + C_DG + ch0);
      ldg[1] = *(const bf16x8*)(pr + C_DG + ch0 + 8);
#pragma unroll
      for (int e4 = 0; e4 < 4; ++e4) lgn[e4] = *(const f32x4*)(p.ml_gnorm + l * 512 + ch0 + e4 * 4);
    }
    __syncthreads();
    mlstm_gates(p, b, h, blk, gs);
#pragma unroll
    for (int i = 0; i < 2; ++i) {
      int c = TIDX + i * NTHR, s = c >> 4, part = c & 15;
      *(bf16x8*)(Qs + s * 136 + part * 8) = lq[i];
      *(bf16x8*)(Ks + s * 136 + part * 8) = lk[i];
      int c2s = c & 63, c2p = c >> 6;
#pragma unroll
      for (int e = 0; e < 8; ++e) vT[(c2p * 8 + e) * 72 + c2s] = (u16)lv[i][e];
    }
    if (TIDX < 256) ninl[TIDX] = lnin;
    __syncthreads();
    {
      const int dr = TIDX >> 8, t = (TIDX >> 2) & 63, pq = TIDX & 3;
      float s = 0.f;
#pragma unroll 8
      for (int d = pq * 32; d < pq * 32 + 32; ++d) s += bf2f(Qs[t * 136 + d]) * ninl[dr * 128 + d];
      s += SHX(s, 1);
      s += SHX(s, 2);
      if (pq == 0) qn[dr * 64 + t] = s;
    }
    __syncthreads();
    {
      const int dir = wid >> 2, tt = wid & 3;
      const int t = tt * 16 + l15;
      const float* li = gs + dir * 64;
      const float* bc = gs + 256 + dir * 64;
      const float bct = bc[t];
      const float mt = fmaxf(bct + m_in, bct + gs[384 + dir * 64 + t]);
      bf16x8 qf[4];
#pragma unroll
      for (int ks = 0; ks < 4; ++ks) qf[ks] = *(const bf16x8*)(Qs + t * 136 + ks * 32 + quad * 8);
      f32x4 s[4];
#pragma unroll
      for (int st = 0; st < 4; ++st) s[st] = f32x4{0.f, 0.f, 0.f, 0.f};
#pragma unroll
      for (int ks = 0; ks < 4; ++ks)
#pragma unroll
        for (int st = 0; st < 4; ++st) {
          bf16x8 a = *(const bf16x8*)(Ks + (st * 16 + l15) * 136 + ks * 32 + quad * 8);
          s[st] = __builtin_amdgcn_mfma_f32_16x16x32_bf16(a, qf[ks], s[st], 0, 0, 0);
        }
      float dsum = 0.f;
      bf16x8 pf[2];
#pragma unroll
      for (int st = 0; st < 4; ++st)
#pragma unroll
        for (int j = 0; j < 4; ++j) {
          int sp = st * 16 + quad * 4 + j;
          bool valid = dir == 0 ? (sp <= t) : (sp >= t);
          float dm = bct - bc[sp] + li[sp] - mt;
          float v = valid ? s[st][j] * __expf(dm) : 0.f;
          dsum += v;
          pf[st >> 1][(st & 1) * 4 + j] = (short)f2bf(v);
        }
      dsum += SHX(dsum, 16);
      dsum += SHX(dsum, 32);
      f32x4 hi[8], hx[8];
#pragma unroll
      for (int e = 0; e < 8; ++e) { hi[e] = f32x4{0.f, 0.f, 0.f, 0.f}; hx[e] = f32x4{0.f, 0.f, 0.f, 0.f}; }
#pragma unroll
      for (int kk = 0; kk < 2; ++kk)
#pragma unroll
        for (int e = 0; e < 8; ++e) {
          const u16* vb = vT + (e * 16 + l15) * 72 + kk * 32 + quad * 4;
          bf16x4 v0 = *(const bf16x4*)vb, v1 = *(const bf16x4*)(vb + 16);
          bf16x8 va = {v0[0], v0[1], v0[2], v0[3], v1[0], v1[1], v1[2], v1[3]};
          hi[e] = __builtin_amdgcn_mfma_f32_16x16x32_bf16(va, pf[kk], hi[e], 0, 0, 0);
        }
      const u16* cin = (const u16*)(ws + O_CIN) + (size_t)itemd[dir] * 16384;
      {
        bf16x8 cn[8];
#pragma unroll
        for (int e = 0; e < 8; ++e) cn[e] = *(const bf16x8*)(cin + (e * 16 + l15) * 128 + quad * 8);
#pragma unroll
        for (int ks = 0; ks < 4; ++ks) {
          bf16x8 ca[8];
#pragma unroll
          for (int e = 0; e < 8; ++e) ca[e] = cn[e];
          if (ks + 1 < 4) {
#pragma unroll
            for (int e = 0; e < 8; ++e) cn[e] = *(const bf16x8*)(cin + (e * 16 + l15) * 128 + (ks + 1) * 32 + quad * 8);
          }
#pragma unroll
          for (int e = 0; e < 8; ++e) hx[e] = __builtin_amdgcn_mfma_f32_16x16x32_bf16(ca[e], qf[ks], hx[e], 0, 0, 0);
        }
      }
      float a = __expf(bct + m_in - mt);
      float den = a * qn[dir * 64 + t] + dsum;
      float idn = 1.f / fmaxf(fabsf(den), __expf(-mt));
#pragma unroll
      for (int e = 0; e < 8; ++e)
#pragma unroll
        for (int j = 0; j < 4; ++j) hbuf[(dir * 64 + t) * 129 + e * 16 + quad * 4 + j] = (a * hx[e][j] + hi[e][j]) * idn;
    }
    __syncthreads();
    {
      int t = TIDX >> 3, part = TIDX & 7;
      float hv[16], ss = 0.f;
#pragma unroll
      for (int e = 0; e < 16; ++e) {
        hv[e] = hbuf[t * 129 + part * 16 + e] + hbuf[(64 + t) * 129 + part * 16 + e];
        ss += hv[e] * hv[e];
      }
      ss += SHX(ss, 1);
      ss += SHX(ss, 2);
      ss += SHX(ss, 4);
      float rs = rsqrtf(ss * (1.f / 128.f) + EPS);
      int r = R0 + t;
      const u16* pr = proj + (size_t)r * NP;
      u16* ys = (u16*)(ws + O_YS) + (size_t)r * 2048 + 1536 + h * 128 + part * 16;
      const int ch0 = h * 128 + part * 16;
      float dox[16], dgx[16], gn[16];
#pragma unroll
      for (int e = 0; e < 8; ++e) {
        dox[e] = bfs(ldo[0][e]); dox[8 + e] = bfs(ldo[1][e]);
        dgx[e] = bfs(ldg[0][e]); dgx[8 + e] = bfs(ldg[1][e]);
      }
#pragma unroll
      for (int e4 = 0; e4 < 4; ++e4)
#pragma unroll
        for (int e = 0; e < 4; ++e) gn[e4 * 4 + e] = lgn[e4][e];
      float yo[16];
#pragma unroll
      for (int e = 0; e < 16; ++e) {
        float y = hv[e] * rs * gn[e] * sigm_f(dox[e]);
        yo[e] = bf2f(f2bf(y)) * silu_f(dgx[e]);
      }
      st8(ys, yo);
      st8(ys + 8, yo + 8);
    }
  }
}

__device__ void gemm_step(const P& p, int step, int l) {
  OPQ_IDS
  char* ws = opqp(p.ws);
  const int nM = NTOK / 256;
  const bool need_ctx = l < 3;
  int ntiles;
  const int nbr = 1;
  if (step == 1) ntiles = nM * (NP / BNT);
  else if (step == 3) ntiles = nM * (2304 / BNT);
  else if (step == 6) ntiles = 4 * nM * (2048 / BNT);
  else if (step == 7) ntiles = nM * 32;
  else ntiles = nM * (2048 / BNT);
  for (int t0 = BIDX; t0 < (ntiles + 255) / 256 * 256; t0 += gridDim.x) {
    const int t = xcd_remap(t0, BIDX, gridDim.x);
    if (t >= ntiles) continue;
    for (int br = 0; br < nbr; ++br) {
      const u16 *A, *Bt;
      int lda, ldb, K, pm, pn, mode, aux = 0, bmode = 0, ncol = BNT;
      if (step == 1) {
        tile_map(t, nM, NP / BNT, pm, pn);
        A = (const u16*)(ws + O_HN); lda = 2048; Bt = (const u16*)(ws + O_WIN); ldb = 2048; K = 2048; mode = M_G1A;
      } else if (step == 3) {
        const int c2 = 768 / BNT, c3 = 1024 / BNT, c4 = 512 / BNT; const int n2 = nM * c2, n3 = nM * c3;
        K = 512; ldb = 512;
        if (t < n2) {
          pm = t / c2; pn = t % c2; A = (const u16*)(ws + O_PROJ) + C_CQ; lda = NP; Bt = (const u16*)(ws + O_WUQ); mode = M_G2;
        } else if (t < n2 + n3) {
          int tt = t - n2; pm = tt / c3; pn = tt % c3; A = (const u16*)(ws + O_PROJ) + C_CKV; lda = NP; Bt = (const u16*)(ws + O_WUKV); mode = M_G3;
        } else {
          int tt = t - n2 - n3; pm = tt / c4; pn = tt % c4; A = (const u16*)(ws + O_DPOOL); lda = 512; Bt = (const u16*)(ws + O_POOL); mode = M_POOL;
        }
      } else if (step == 6) {
        aux = t / (nM * (2048 / BNT));
        tile_map(t % (nM * (2048 / BNT)), nM, 2048 / BNT, pm, pn);
        A = (const u16*)(ws + O_YS) + aux * 512; lda = 2048; Bt = (const u16*)(ws + O_WBR) + (size_t)aux * 2048 * 512; ldb = 512; K = 512; mode = M_G4;
      } else if (step == 7) {
        tile_map(t, nM, 32, pm, pn);
        A = (const u16*)(ws + O_HN); lda = 2048;
        Bt = (l & 1) ? (const u16*)(ws + O_WINM1) : (const u16*)(ws + O_WIN) + (size_t)C_MG * 2048;
        ldb = 2048; K = 2048; mode = M_G1B; bmode = 1; ncol = 64;
      } else {
        tile_map(t, nM, 2048 / BNT, pm, pn);
        A = (const u16*)(ws + O_ACC); lda = 2048; Bt = (const u16*)(ws + O_WOUT); ldb = 2048; K = 2048; mode = M_G5;
      }
      if (step >= 6 && !need_ctx && (pm % 17) == 0) continue;
      gemm256(p, A, lda, Bt, ldb, K, pm * 256, pn * ncol, mode, aux, l, bmode);
    }
  }
}


#define XB_TMO      128
#define XB_XCNT(j)  (256  + 64 * (j))
#define XB_XSUB(j)  (1280 + 64 * (j))
#define XB_XGEN(j)  (2304 + 64 * (j))
#define XB_TOP      3328
#define XB_TOPGEN   3392
#define XCD_BAR_WORDS 3456
#define XB_SPIN_CAP (1u << 18)
#define LAS __attribute__((address_space(3)))
DEVI unsigned xb_ld(unsigned* p) { return __hip_atomic_load(p, __ATOMIC_RELAXED, __HIP_MEMORY_SCOPE_AGENT); }
DEVI unsigned xb_add(unsigned* p, unsigned v) { return __hip_atomic_fetch_add(p, v, __ATOMIC_RELAXED, __HIP_MEMORY_SCOPE_AGENT); }
DEVI unsigned xb_xcc_id() { return (unsigned)__builtin_amdgcn_s_getreg((3 << 11) | 20) & 0xFu; }
#define XB_SPIN(cond, bar) do { unsigned _sp = 0; while (cond) { __builtin_amdgcn_s_sleep(1); \
    if ((++_sp & 255u) == 0u) { if (xb_ld(&(bar)[XB_TMO])) break; if (_sp > XB_SPIN_CAP) { atomicAdd(&(bar)[XB_TMO], 1u); break; } } } } while (0)
struct XcdBarrier { unsigned* bar; unsigned x; volatile LAS unsigned* st; };
DEVI XcdBarrier xcd_barrier_post(unsigned* bar, volatile LAS unsigned* st) {
  XcdBarrier b; b.bar = bar; b.x = xb_xcc_id(); b.st = st;
  if (threadIdx.x == 0) (void)xb_add(&bar[XB_XCNT(b.x)], 1u);
  return b;
}
DEVI void xcd_barrier_complete(unsigned* bar, unsigned x, unsigned& nloc, unsigned& nx) {
  const unsigned G = gridDim.x * gridDim.y * gridDim.z;
  unsigned sum, cnt, mine, sp = 0u;
  for (;;) {
    sum = 0u; cnt = 0u; mine = 0u;
#pragma unroll
    for (unsigned j = 0; j < 16; ++j) { const unsigned c = xb_ld(&bar[XB_XCNT(j)]); sum += c; cnt += (c > 0u) ? 1u : 0u; mine = (j == x) ? c : mine; }
    if (sum == G) break;
    __builtin_amdgcn_s_sleep(1);
    if ((++sp & 255u) == 0u) { if (xb_ld(&bar[XB_TMO])) break; if (sp > XB_SPIN_CAP) { atomicAdd(&bar[XB_TMO], 1u); break; } }
  }
  nloc = mine > 0u ? mine : 1u; nx = cnt > 0u ? cnt : 1u;
}
DEVI void xcd_barrier(const XcdBarrier& b) {
  asm volatile("s_waitcnt vmcnt(0)" ::: "memory");
  __syncthreads();
  if (threadIdx.x == 0) {
    unsigned* bar = b.bar;
    __builtin_amdgcn_s_waitcnt(0);
    unsigned nloc = b.st[0], nx = b.st[1];
    if (nloc == 0u) { xcd_barrier_complete(bar, b.x, nloc, nx); b.st[0] = nloc; b.st[1] = nx; }
    const unsigned old = xb_add(&bar[XB_XSUB(b.x)], 1u);
    const unsigned gen = old / nloc;
    if (old + 1u == (gen + 1u) * nloc) {
      __builtin_amdgcn_fence(__ATOMIC_RELEASE, "agent");
      asm volatile("s_waitcnt vmcnt(0)" ::: "memory");
      const unsigned og = xb_add(&bar[XB_TOP], 1u);
      const unsigned tg = og / nx;
      if (og + 1u == (tg + 1u) * nx) xb_add(&bar[XB_TOPGEN], 1u);
      else XB_SPIN(xb_ld(&bar[XB_TOPGEN]) == tg, bar);
      __builtin_amdgcn_fence(__ATOMIC_ACQUIRE, "agent");
      xb_add(&bar[XB_XGEN(b.x)], 1u);
      asm volatile("s_waitcnt vmcnt(0)" ::: "memory");
    } else {
      XB_SPIN(xb_ld(&bar[XB_XGEN(b.x)]) == gen, bar);
      __builtin_amdgcn_fence(__ATOMIC_ACQUIRE, "agent");
      asm volatile("s_waitcnt vmcnt(0)" ::: "memory");
    }
  }
  __syncthreads();
}

__global__ void __launch_bounds__(NTHR) mega(P p) {
  cg::grid_group grid = cg::this_grid();
  __shared__ uint4 xb_words;
  unsigned* bar = (unsigned*)(p.ws + O_BAR);
  if (threadIdx.x == 0) xb_words = make_uint4(0u, 0u, 0u, 0u);
  if (blockIdx.x == 0) {
    for (int i = threadIdx.x; i < 4096; i += NTHR) bar[i] = 0u;
  }
  __syncthreads();
  if (PHM & 1) phase_mod_partial(p);
  grid.sync();
  XcdBarrier xb = xcd_barrier_post(bar, (volatile LAS unsigned*)&xb_words);
  if (PHM & 1) phase_mod_reduce(p);
  grid.sync();
  for (int ls2 = 0; ls2 < 36 * 2; ++ls2) {
    const int ls = ls2 >> 1;
    const int l = ls / 9, step = ls % 9;
    if ((ls2 & 1) && !((PROBE_DUP >> step) & 1)) continue;
    if (step == 0) { if (PHM & 4) phase_norm(p, l); }
    if (step == 2) { if (PHM & 8) phase_p2(p, l); }
    if (step == 1 || step == 3 || step >= 6) gemm_step(p, step, l);
    {
      const int bid = blockIdx.x, nb = gridDim.x;
      int wl = -1, wmode = 0, rank = bid, count = nb, mod = 1, lo = 0, width = 1, sub_lo = 0, sub_hi = 0;
      if (!(ls2 & 1)) {
        if (step == 0) { wl = l; wmode = (l == 0) ? 0 : 2; }
        else if ((step == 1 || step == 3 || step == 6) && l < 3 && nb == 256) {
          const int ntl = (step == 1) ? 68 * 29 : (step == 3) ? 68 * 9 : 4 * 68 * 8;
          const int rem = ntl - ((ntl + 255) / 256 - 1) * 256;
          const int pos = (bid & 7) * 32 + (bid >> 3);
          if (pos >= rem) {
            wl = l + 1; wmode = 3; rank = pos - rem; count = 256 - rem;
            sub_lo = (step == 1) ? 0 : (step == 3) ? 1660 : 3000;
            sub_hi = (step == 1) ? 1660 : (step == 3) ? 3000 : 4096;
          }
        }
        else if (step == 7 && l < 3) {
          wl = l + 1; wmode = (nb == 256) ? 1 : 4;
          if (nb == 256) {
            count = 128; mod = 5;
            if ((bid & 7) >= 4) { rank = (bid >> 3) * 4 + (bid & 7) - 4; lo = 4; width = 1; }
            else wl = -1;
          }
        } else if (step == 8 && l < 3 && nb == 256 && (bid & 7) != 0) {
          wl = l + 1; wmode = 1; rank = (bid >> 3) * 7 + (bid & 7) - 1; count = 224; mod = 5; lo = 0; width = 4;
        }
      }
      if (wl >= 0 && (PHM & 2)) phase_wprep(p, wl, wmode, rank, count, mod, lo, width, sub_lo, sub_hi);
    }
    if (step == 3) { if (PHM & 16) phase_m1(p); }
    if (step == 4) {
      if (PHM & 32) phase_m2(p);
      if (PHM & 64) phase_attn(p, l);
    }
    if (step == 5) { if (PHM & 128) phase_m3(p, l); }
    xcd_barrier(xb);
  }
  if (PHM & 4) phase_final(p);
}

extern "C" void kernel_launch(void* const* d_in, const int* in_sizes, int n_in, void* d_out, int out_size, void* d_ws,
                              size_t ws_size, hipStream_t stream) {
  static int grid_blocks = 0;
  if (!grid_blocks) {
    int dev = 0, cus = 0, per_cu = 0;
    hipGetDevice(&dev);
    hipDeviceGetAttribute(&cus, hipDeviceAttributeMultiprocessorCount, dev);
    hipFuncSetAttribute((const void*)mega, hipFuncAttributeMaxDynamicSharedMemorySize, SHM_BYTES);
    hipOccupancyMaxActiveBlocksPerMultiprocessor(&per_cu, mega, NTHR, SHM_BYTES);
    if (per_cu < 1) per_cu = 1;
    grid_blocks = cus * per_cu;
  }
  P p{};
  const float** pp = (const float**)&p;
  for (int i = 0; i < 21; ++i) pp[i] = (const float*)d_in[i];
  p.out = (float*)d_out;
  p.ws = (char*)d_ws;
  if (ws_size < O_TOTAL) fprintf(stderr, "workspace too small: %zu < %zu\n", ws_size, (size_t)O_TOTAL);
  void* args[] = {&p};
  hipError_t e = hipLaunchCooperativeKernel((void*)mega, dim3(grid_blocks), dim3(NTHR), args, SHM_BYTES, stream);
  if (e != hipSuccess) fprintf(stderr, "cooperative launch failed: %s (grid %d)\n", hipGetErrorString(e), grid_blocks);
}
```

```cpp
#include <hip/hip_runtime.h>
#include <hip/hip_bf16.h>
#include <hip/hip_cooperative_groups.h>
#include <cstdio>
namespace cg = cooperative_groups;

typedef unsigned short u16;
using bf16x8 = __attribute__((ext_vector_type(8))) short;
using bf16x4 = __attribute__((ext_vector_type(4))) short;
using f32x4 = __attribute__((ext_vector_type(4))) float;
typedef unsigned u32x4 __attribute__((ext_vector_type(4)));
#define DEVI __device__ __forceinline__

constexpr int D = 2048, NBATCH = 4, SEQ = 4096, CTXL = 256, TPB = 4352, NTOK = 17408, DIN = 15440, NP = 7424;
constexpr int C_AQ = 0, C_AK = 512, C_AV = 1024, C_AG = 1536, C_BI = 2048, C_BG = 2560, C_CQ = 3072, C_CKV = 3584,
              C_CKR = 4096, C_CG = 4160, C_DQ = 4672, C_DK = 5184, C_DV = 5696, C_DO = 6208, C_DIF = 6720,
              C_DG = 6736, C_MG = 7248;
constexpr float EPS = 1e-6f;
constexpr int NTHR = 512;
#ifndef PROBE_ZB
#define PROBE_ZB (-1)
#endif
#ifndef PROBE_US
#define PROBE_US 1.f
#endif
#ifndef G8
#define G8 1
#endif
#define BNT (G8 ? 256 : 128)
#ifndef PROBE_DUP
#define PROBE_DUP 0
#endif
#ifndef PHM
#define PHM 0xFFFF
#endif
constexpr int SHM_BYTES = 131072;

constexpr size_t al(size_t x) { return (x + 255) & ~size_t(255); }
constexpr size_t O_WIN = 0;
constexpr size_t O_WBR = O_WIN + al((size_t)DIN * 2048 * 2);
constexpr size_t O_WOUT = O_WBR + al((size_t)4 * 2048 * 512 * 2);
constexpr size_t O_WUQ = O_WOUT + al((size_t)2048 * 2048 * 2);
constexpr size_t O_WUKV = O_WUQ + al((size_t)768 * 512 * 2);
constexpr size_t O_POOL = O_WUKV + al((size_t)1024 * 512 * 2);
constexpr size_t O_MODP = O_POOL + al((size_t)512 * 512 * 2);
constexpr size_t O_MOD = O_MODP + al((size_t)4 * 16 * 5 * 6144 * 4);
constexpr size_t O_ROPE = O_MOD + al((size_t)4 * 5 * 6144 * 4);
constexpr size_t O_XC = O_ROPE + al(64 * 16 * 8);
constexpr size_t O_HN = O_XC + al((size_t)1024 * 2048 * 4);
constexpr size_t O_PROJ = O_HN + al((size_t)NTOK * 2048 * 2);
constexpr size_t O_QH = O_PROJ + al((size_t)NTOK * NP * 2);
constexpr size_t O_KH = O_QH + al((size_t)NTOK * 768 * 2);
constexpr size_t O_VTC = O_KH + al((size_t)NTOK * 768 * 2);
constexpr size_t O_END1 = O_VTC + al((size_t)NTOK * 512 * 2);
constexpr size_t O_YBR = O_PROJ;
static_assert((size_t)NTOK * 8192 * 2 <= O_END1 - O_PROJ, "ybr alias");
constexpr size_t O_VTA = O_END1;
constexpr size_t O_DPOOL = O_VTA + al((size_t)NTOK * 512 * 2);
constexpr size_t O_QKC = O_DPOOL + al((size_t)NTOK * 512 * 2);
constexpr size_t O_GL = O_QKC + al((size_t)NTOK * 1024 * 2);
constexpr size_t O_RINV = O_GL + al((size_t)NTOK * 16 * 4);
constexpr size_t O_YS = O_RINV + al((size_t)NTOK * 2 * 4);
constexpr size_t O_ACC = O_YS + al((size_t)NTOK * 2048 * 2);
constexpr int NITEM = 32 * 68;
constexpr size_t O_KLOC = O_ACC + al((size_t)NTOK * 2048 * 2);
constexpr size_t O_NLOC = O_KLOC + al((size_t)NITEM * 16384 * 4);
constexpr size_t O_SC = O_NLOC + al((size_t)NITEM * 128 * 4);
constexpr size_t O_CIN = O_SC + al((size_t)NITEM * 2 * 4);
constexpr size_t O_NIN = O_CIN + al((size_t)NITEM * 16384 * 2);
constexpr size_t O_MIN = O_NIN + al((size_t)NITEM * 128 * 4);
constexpr size_t O_WINM1 = O_MIN + al((size_t)NITEM * 4);
constexpr size_t O_BAR = O_WINM1 + al((size_t)8192 * 2048 * 2);
constexpr size_t O_TOTAL = O_BAR + al(4096 * 4);
static_assert(O_TOTAL < 1000000000ull, "workspace budget");

struct P {
  const float *x, *c, *ctx, *c_ctx, *norm_g, *w_mod, *b_mod, *w_in, *na_rpb, *pool_w, *pool_scale, *mla_gq, *mla_gkv,
      *w_uq, *w_ukv, *conv_w, *b_if, *ml_gnorm, *w_br, *w_out, *g_final;
  float* out;
  char* ws;
};

extern __shared__ __attribute__((aligned(16))) char shm[];

DEVI u16 f2bf(float f) {
  unsigned u = __float_as_uint(f);
  u += 0x7fffu + ((u >> 16) & 1u);
  return (u16)(u >> 16);
}
typedef __bf16 bf2_t __attribute__((ext_vector_type(2)));
typedef float fl2_t __attribute__((ext_vector_type(2)));
DEVI unsigned pk2(float a, float b) {
  fl2_t v = {a, b};
  bf2_t r = __builtin_convertvector(v, bf2_t);
  return *(unsigned*)&r;
}
DEVI float bf2f(u16 h) { return __uint_as_float(((unsigned)h) << 16); }
DEVI float bfs(short h) { return __uint_as_float(((unsigned)(u16)h) << 16); }
DEVI float silu_f(float x) { return x / (1.f + __expf(-x)); }
DEVI float sigm_f(float x) { return 1.f / (1.f + __expf(-x)); }
DEVI int opqv(int x) { asm volatile("" : "+v"(x)); return x; }
DEVI int opqs(int x) { asm volatile("" : "+s"(x)); return x; }
DEVI size_t opqz() { size_t z = 0; asm volatile("" : "+s"(z)); return z; }
#define opqp(x) ((x) + opqz())
#define SHX(v, m) __int_as_float(__builtin_amdgcn_ds_bpermute(((LANE ^ (m)) << 2), __float_as_int(v)))
#define LDS_BAR() do { asm volatile("s_waitcnt lgkmcnt(0)" ::: "memory"); __builtin_amdgcn_s_barrier(); asm volatile("" ::: "memory"); } while (0)
#define OPQ_IDS const int TIDX = opqv((int)threadIdx.x); const int BIDX = opqs((int)blockIdx.x); const int LANE = TIDX & 63; (void)TIDX; (void)BIDX; (void)LANE;
#define wave_sum(v) wave_sum_l((v), LANE)
DEVI float wave_sum_l(float v, int LANE) {
#pragma unroll
  for (int o = 32; o > 0; o >>= 1) v += SHX(v, o);
  return v;
}

DEVI void ld8(const u16* ptr, float* f) {
  bf16x8 v = *(const bf16x8*)ptr;
#pragma unroll
  for (int i = 0; i < 8; ++i) f[i] = bfs(v[i]);
}
DEVI void st8(u16* ptr, const float* f) {
  bf16x8 v;
#pragma unroll
  for (int i = 0; i < 8; ++i) v[i] = (short)f2bf(f[i]);
  *(bf16x8*)ptr = v;
}
constexpr int BM = 256, BK = 64, HALF = 128, HT = HALF * BK;

DEVI int lds_byte(int r, int c) {
  int st = (r >> 4) * 2 + (c >> 5), rr = r & 15, cc = c & 31, ob = rr * 64 + cc * 2;
  return st * 1024 + (ob ^ (((ob >> 9) & 1) << 5));
}
DEVI void stage_rc(int b, int& R, int& C) {
  int st = b / 1024, sb = b % 1024, swz = sb ^ (((sb >> 9) & 1) << 5);
  R = (st >> 1) * 16 + swz / 64;
  C = (st & 1) * 32 + (swz % 64) / 2;
}

enum { M_G1A = 0, M_G2, M_G3, M_POOL, M_G4, M_G1B, M_G5 };

DEVI void gemm256(const P& p, const u16* A, int lda, const u16* Bt, int ldb, int K, int brow, int bcol, int mode,
                        int aux, int layer, int bmode) {
  OPQ_IDS
  if (!(PHM & 256)) return;
  u16* shmb = (u16*)shm;
#define SA(b, h) (shmb + ((b)*2 + (h)) * HT)
#if G8
#define SB(b, h) (shmb + (4 + (b)*2 + (h)) * HT)
#else
#define SB(b, h) (shmb + (4 + (b)) * HT)
#endif
#define LDSP(x) ((__attribute__((address_space(3))) void*)(x))
#define STAGEA(Pp, br, kt)                                                                                     \
  do {                                                                                                         \
    const int _so = ((br) * lda + (kt)*BK) * 2;                                                                \
    __builtin_amdgcn_raw_ptr_buffer_load_lds(rsA, LDSP((char*)(Pp) + TIDX * 16), 16, offA0, _so, 0, 0);       \
    __builtin_amdgcn_raw_ptr_buffer_load_lds(rsA, LDSP((char*)(Pp) + TIDX * 16 + 8192), 16, offA1, _so, 0, 0);\
  } while (0)
#define STAGEB(Pp, br, kt)                                                                                     \
  do {                                                                                                         \
    const int _so = ((br) * ldb + (kt)*BK) * 2;                                                                \
    __builtin_amdgcn_raw_ptr_buffer_load_lds(rsB, LDSP((char*)(Pp) + TIDX * 16), 16, offB0, _so, 0, 0);       \
    __builtin_amdgcn_raw_ptr_buffer_load_lds(rsB, LDSP((char*)(Pp) + TIDX * 16 + 8192), 16, offB1, _so, 0, 0);\
  } while (0)
#define LDA(dst, b, h)                                                                                         \
  for (int m = 0; m < 4; ++m)                                                                                  \
    for (int k = 0; k < 2; ++k)                                                                                \
  dst[m][k] = *reinterpret_cast<const bf16x8*>((char*)SA(b, h) + lds_byte(wr * 64 + m * 16 + fr, k * 32 + fq * 8))
#define LDB(dst, b, h)                                                                                         \
  for (int n = 0; n < 2; ++n)                                                                                  \
    for (int k = 0; k < 2; ++k)                                                                                \
  dst[n][k] = *reinterpret_cast<const bf16x8*>((char*)SB(b, h) + lds_byte(wc * 32 + n * 16 + fr, k * 32 + fq * 8))
#define MMA(ai, bj, At, Btf)                                                                                   \
  do {                                                                                                         \
    __builtin_amdgcn_s_setprio(1);                                                                             \
    for (int m = 0; m < 4; ++m)                                                                                \
      for (int n = 0; n < 2; ++n)                                                                              \
        for (int k = 0; k < 2; ++k)                                                                            \
          acc[ai][bj][m][n] = __builtin_amdgcn_mfma_f32_16x16x32_bf16(Btf[n][k], At[m][k], acc[ai][bj][m][n], 0, 0, 0); \
    __builtin_amdgcn_s_setprio(0);                                                                             \
  } while (0)
#define WAIT_V(n) asm volatile("s_waitcnt vmcnt(" #n ")" ::: "memory")
#define WAIT_L(n) asm volatile("s_waitcnt lgkmcnt(" #n ")" ::: "memory")
#define BAR __builtin_amdgcn_s_barrier()
#define SCHED __builtin_amdgcn_sched_barrier(0)

  int wid = TIDX >> 6, lane = TIDX & 63, wr = wid >> 2, wc = wid & 3, fr = lane & 15, fq = lane >> 4;
#if G8
  f32x4 acc[2][2][4][2] = {};
  bf16x8 At[4][2], B0[2][2], B1[2][2];
#else
  f32x4 acc[2][1][4][2] = {};
  bf16x8 At[4][2], B0[2][2];
#endif
  int nt = K / BK;
  const int bhalf = bmode ? 4096 : HALF;
  int offA0, offA1, offB0, offB1;
  __amdgpu_buffer_rsrc_t rsA = __builtin_amdgcn_make_buffer_rsrc((void*)A, 0, 0x7fffffff, 0x00020000);
  __amdgpu_buffer_rsrc_t rsB = __builtin_amdgcn_make_buffer_rsrc((void*)Bt, 0, 0x7fffffff, 0x00020000);
  {
    int r0, c0, r1, c1;
    stage_rc(TIDX * 16, r0, c0);
    stage_rc(TIDX * 16 + 8192, r1, c1);
    offA0 = (r0 * lda + c0) * 2; offA1 = (r1 * lda + c1) * 2;
    offB0 = (r0 * ldb + c0) * 2; offB1 = bmode ? offB0 + 2048 * ldb * 2 : (r1 * ldb + c1) * 2;
  }
#if G8
  STAGEB(SB(0, 0), bcol, 0);
  STAGEA(SA(0, 0), brow, 0);
  STAGEB(SB(0, 1), bcol + bhalf, 0);
  STAGEA(SA(0, 1), brow + HALF, 0);
  if (wr == 1) BAR;
  WAIT_V(4);
  BAR;
  STAGEB(SB(1, 0), bcol, 1);
  STAGEA(SA(1, 0), brow, 1);
  STAGEB(SB(1, 1), bcol + bhalf, 1);
  WAIT_V(6);
  BAR;
  for (int t = 0; t < nt - 2; t += 2) {
    LDB(B0, 0, 0); SCHED; LDA(At, 0, 0); STAGEA(SA(1, 1), brow + HALF, t + 1);
    WAIT_L(8); BAR; WAIT_L(0); MMA(0, 0, At, B0); BAR; SCHED;
    LDB(B1, 0, 1); STAGEB(SB(0, 0), bcol, t + 2);
    BAR; WAIT_L(0); MMA(0, 1, At, B1); BAR;
    LDA(At, 0, 1); STAGEA(SA(0, 0), brow, t + 2);
    BAR; WAIT_L(0); MMA(1, 0, At, B0); BAR; SCHED;
    STAGEB(SB(0, 1), bcol + bhalf, t + 2);
    WAIT_V(6); BAR; MMA(1, 1, At, B1); BAR;
    LDB(B0, 1, 0); SCHED; LDA(At, 1, 0); STAGEA(SA(0, 1), brow + HALF, t + 2);
    WAIT_L(8); BAR; WAIT_L(0); MMA(0, 0, At, B0); BAR; SCHED;
    LDB(B1, 1, 1); STAGEB(SB(1, 0), bcol, t + 3);
    BAR; WAIT_L(0); MMA(0, 1, At, B1); BAR;
    LDA(At, 1, 1); STAGEA(SA(1, 0), brow, t + 3);
    BAR; WAIT_L(0); MMA(1, 0, At, B0); BAR; SCHED;
    STAGEB(SB(1, 1), bcol + bhalf, t + 3);
    WAIT_V(6); BAR; MMA(1, 1, At, B1); BAR;
  }
  {
    LDB(B0, 0, 0); LDA(At, 0, 0); STAGEA(SA(1, 1), brow + HALF, nt - 1);
    BAR; WAIT_L(0); MMA(0, 0, At, B0); BAR;
    LDB(B1, 0, 1); BAR; WAIT_L(0); MMA(0, 1, At, B1); BAR;
    LDA(At, 0, 1); WAIT_V(4); BAR; WAIT_L(0); MMA(1, 0, At, B0); MMA(1, 1, At, B1); BAR;
  }
  {
    LDB(B0, 1, 0); LDA(At, 1, 0); WAIT_V(2); BAR; WAIT_L(0); MMA(0, 0, At, B0); BAR;
    LDB(B1, 1, 1); WAIT_V(0); BAR; WAIT_L(0); MMA(0, 1, At, B1); BAR;
    LDA(At, 1, 1); BAR; WAIT_L(0); MMA(1, 0, At, B0); MMA(1, 1, At, B1); BAR;
  }
  if (wr == 0) BAR;
#else
  STAGEB(SB(0, 0), bcol, 0);
  STAGEA(SA(0, 0), brow, 0);
  STAGEA(SA(0, 1), brow + HALF, 0);
  WAIT_V(0);
  BAR;
  for (int t = 0; t < nt; t += 2) {
    STAGEB(SB(1, 0), bcol, t + 1);
    STAGEA(SA(1, 0), brow, t + 1);
    STAGEA(SA(1, 1), brow + HALF, t + 1);
    LDB(B0, 0, 0); LDA(At, 0, 0); WAIT_L(0); MMA(0, 0, At, B0);
    LDA(At, 0, 1); WAIT_L(0); MMA(1, 0, At, B0);
    WAIT_V(0);
    BAR;
    if (t + 2 < nt) {
      STAGEB(SB(0, 0), bcol, t + 2);
      STAGEA(SA(0, 0), brow, t + 2);
      STAGEA(SA(0, 1), brow + HALF, t + 2);
    }
    LDB(B0, 1, 0); LDA(At, 1, 0); WAIT_L(0); MMA(0, 0, At, B0);
    LDA(At, 1, 1); WAIT_L(0); MMA(1, 0, At, B0);
    WAIT_V(0);
    BAR;
  }
#endif
  char* ws = opqp(p.ws);
  const int bb = brow / TPB;
  const int trow = brow - bb * TPB;
  u16* stg = (u16*)shm;
  const int tid = TIDX;
#define SWZ(r, c) ((c) ^ ((r)&15) ^ (((c)&1) << 4))
#pragma unroll
  for (int ai = 0; ai < 2; ++ai)
#pragma unroll
    for (int bj = 0; bj < (G8 ? 2 : 1); ++bj)
#pragma unroll
      for (int m = 0; m < 4; ++m)
#pragma unroll
        for (int n = 0; n < 2; ++n) {
          const int R = ai * HALF + wr * 64 + m * 16 + fr;
          const int chunk = bj * 16 + wc * 4 + n * 2 + (fq >> 1);
          f32x4 v = acc[ai][bj][m][n];
          uint2 pk = make_uint2(pk2(v[0], v[1]), pk2(v[2], v[3]));
          *(uint2*)(stg + R * 256 + SWZ(R, chunk) * 8 + (fq & 1) * 4) = pk;
        }
  LDS_BAR();
  if (mode == M_G1B) {
#pragma unroll 1
    for (int it = 0; it < 4; ++it) {
      const int R = it * 64 + (tid >> 3), co = tid & 7;
      const int row = brow + R, ocol = bcol + co * 8;
      float sum[8] = {0, 0, 0, 0, 0, 0, 0, 0};
#pragma unroll
      for (int br = 0; br < 4; ++br) {
        const int c = br * 8 + co;
        bf16x8 g = *(const bf16x8*)(stg + R * 256 + SWZ(R, c) * 8);
        float yb[8];
        ld8((const u16*)(ws + O_YBR) + (size_t)row * 8192 + br * 2048 + ocol, yb);
#pragma unroll
        for (int e = 0; e < 8; ++e) sum[e] += (br == PROBE_ZB) ? 0.f : sigm_f(bfs(g[e])) * yb[e];
      }
      st8((u16*)(ws + O_ACC) + (size_t)row * 2048 + ocol, sum);
    }
  } else {
    bool tr0 = false, tr1 = false;
    if (mode == M_G1A) { tr0 = bcol >= C_AV && bcol < C_AG; tr1 = bcol + HALF >= C_AV && bcol + HALF < C_AG; }
    else if (mode == M_G3) { tr1 = true; }
#pragma unroll 4
    for (int it = 0; it < 16; ++it) {
      const int R = it * 16 + (tid >> 5), c = tid & 31;
      if ((c < 16) ? tr0 : tr1) continue;
      const int row = brow + R, col = bcol + c * 8;
      bf16x8 raw = *(const bf16x8*)(stg + R * 256 + SWZ(R, c) * 8);
      if (mode == M_G1A) {
        *(bf16x8*)((u16*)(ws + O_PROJ) + (size_t)row * NP + col) = raw;
      } else if (mode == M_G4) {
        *(bf16x8*)((u16*)(ws + O_YBR) + (size_t)row * 8192 + aux * 2048 + col) = raw;
      } else {
        float v[8];
#pragma unroll
        for (int e = 0; e < 8; ++e) v[e] = bfs(raw[e]);
        if (mode == M_G2) {
          float rs = ((const float*)(ws + O_RINV))[row * 2];
#pragma unroll
          for (int e = 0; e < 8; ++e) v[e] *= rs;
          st8((u16*)(ws + O_QH) + (size_t)row * 768 + col, v);
        } else if (mode == M_G3) {
          float rs = ((const float*)(ws + O_RINV))[row * 2 + 1];
#pragma unroll
          for (int e = 0; e < 8; ++e) v[e] *= rs;
          st8((u16*)(ws + O_KH) + ((size_t)(bb * 4 + (col >> 8)) * TPB + (trow + R)) * 192 + (col & 255), v);
        } else if (mode == M_POOL) {
          float g[8];
          ld8((const u16*)(ws + O_PROJ) + (size_t)row * NP + C_BG + col, g);
#pragma unroll
          for (int e = 0; e < 8; ++e) {
            float y = bf2f(f2bf(v[e] * p.pool_scale[layer * 512 + col + e]));
            v[e] = y * silu_f(g[e]);
          }
          st8((u16*)(ws + O_YS) + (size_t)row * 2048 + 512 + col, v);
        } else {
          float* xb;
          const float* gv;
          const float* xs;
          if (trow == 0) {
            xb = (float*)(ws + O_XC) + ((size_t)bb * CTXL + R) * D + col;
            xs = (layer == 0) ? p.ctx + ((size_t)bb * CTXL + R) * D + col : xb;
            gv = (const float*)(ws + O_MOD) + ((size_t)layer * 5 + 4) * 6144 + 4096 + col;
          } else {
            xb = p.out + ((size_t)bb * SEQ + (trow - CTXL) + R) * D + col;
            xs = (layer == 0) ? p.x + ((size_t)bb * SEQ + (trow - CTXL) + R) * D + col : xb;
            gv = (const float*)(ws + O_MOD) + ((size_t)layer * 5 + bb) * 6144 + 4096 + col;
          }
          f32x4 x0 = *(const f32x4*)xs, x1 = *(const f32x4*)(xs + 4);
          f32x4 g0 = *(const f32x4*)gv, g1 = *(const f32x4*)(gv + 4);
#pragma unroll
          for (int e = 0; e < 4; ++e) { x0[e] += PROBE_US * g0[e] * v[e]; x1[e] += PROBE_US * g1[e] * v[4 + e]; }
          *(f32x4*)xb = x0;
          *(f32x4*)(xb + 4) = x1;
        }
      }
    }
#pragma unroll 1
    for (int hj = 0; hj < 2; ++hj) {
      if (!(hj ? tr1 : tr0)) continue;
      const int gc = bcol + hj * HALF;
      u16* tdst;
      if (mode == M_G1A) tdst = (u16*)(ws + O_VTA) + ((size_t)(bb * 512 + (gc - C_AV))) * TPB + trow;
      else tdst = (u16*)(ws + O_VTC) + ((size_t)((bb * 4 + (gc >> 8)) * 128)) * TPB + trow;
      const int cl = tid & 127, rg = tid >> 7;
      const int ct = hj * HALF + cl;
#pragma unroll 1
      for (int i = 0; i < 8; ++i) {
        const int r0 = rg * 64 + i * 8;
        float v[8], rs8[8];
        if (mode == M_G3) {
          const f32x4* rp = (const f32x4*)((const float*)(ws + O_RINV) + (size_t)(brow + r0) * 2);
          const f32x4 q0 = rp[0], q1 = rp[1], q2 = rp[2], q3 = rp[3];
          rs8[0] = q0[1]; rs8[1] = q0[3]; rs8[2] = q1[1]; rs8[3] = q1[3];
          rs8[4] = q2[1]; rs8[5] = q2[3]; rs8[6] = q3[1]; rs8[7] = q3[3];
        } else {
#pragma unroll
          for (int e = 0; e < 8; ++e) rs8[e] = 1.f;
        }
#pragma unroll
        for (int e = 0; e < 8; ++e) {
          const int r = r0 + e;
          v[e] = bf2f(stg[r * 256 + SWZ(r, ct >> 3) * 8 + (ct & 7)]) * rs8[e];
        }
        st8(tdst + (size_t)cl * TPB + r0, v);
      }
    }
  }
  LDS_BAR();
#undef SWZ
}

DEVI int xcd_remap(int t, int bid, int nblk) {
  if (nblk != 256) return t;
  int r = t / 256;
  return r * 256 + (bid & 7) * 32 + (bid >> 3);
}
DEVI void tile_map(int v, int nM, int nN, int& pm, int& pn) {
  int per = 4 * nN, band = v / per, idx = v % per;
  pm = band * 4 + (idx & 3);
  pn = idx >> 2;
}

struct WItem {
  const float* src; const float* kscale; u16* dst;
  int ldsrc, K, N, k0, n0, kind;
};
DEVI WItem wdecode(const P& p, char* ws, int l, int t, int tend, u16* wmerge) {
  constexpr int T_WIN1 = 32 * 114, T_WIN2 = 32 * 128, T_WBR = 4 * 8 * 32, T_WUQ = 8 * 12, T_WUKV = 8 * 16, T_POOL = 64;
  WItem w;
  w.kscale = nullptr; w.kind = 0; w.src = nullptr; w.dst = nullptr; w.ldsrc = 0; w.K = 0; w.N = 0; w.k0 = 0; w.n0 = 0;
  if (t >= tend) { w.kind = -1; return w; }
  int i = t;
  if (i < T_WIN1) {
    w.src = p.w_in + (size_t)l * 2048 * DIN; w.ldsrc = DIN; w.K = 2048; w.N = C_MG; w.dst = (u16*)(ws + O_WIN);
    w.k0 = (i & 31) * 64; w.n0 = (i >> 5) * 64; return w;
  }
  i -= T_WIN1;
  if (i < T_WIN2) {
    w.src = p.w_in + (size_t)l * 2048 * DIN + C_MG; w.ldsrc = DIN; w.K = 2048; w.N = 8192; w.dst = wmerge;
    w.k0 = (i & 31) * 64; w.n0 = (i >> 5) * 64; return w;
  }
  i -= T_WIN2;
  if (i < T_WBR) {
    int br = i >> 8, r = i & 255;
    w.src = p.w_br + ((size_t)l * 4 + br) * 512 * 2048; w.ldsrc = 2048; w.K = 512; w.N = 2048;
    w.dst = (u16*)(ws + O_WBR) + (size_t)br * 2048 * 512; w.k0 = (r & 7) * 64; w.n0 = (r >> 3) * 64; return w;
  }
  i -= T_WBR;
  if (i < T_WUQ) {
    w.src = p.w_uq + (size_t)l * 512 * 768; w.ldsrc = 768; w.K = 512; w.N = 768; w.dst = (u16*)(ws + O_WUQ);
    w.kscale = p.mla_gq + l * 512; w.k0 = (i & 7) * 64; w.n0 = (i >> 3) * 64; return w;
  }
  i -= T_WUQ;
  if (i < T_WUKV) {
    w.src = p.w_ukv + (size_t)l * 512 * 1024; w.ldsrc = 1024; w.K = 512; w.N = 1024; w.dst = (u16*)(ws + O_WUKV);
    w.kscale = p.mla_gkv + l * 512; w.k0 = (i & 7) * 64; w.n0 = (i >> 3) * 64; return w;
  }
  i -= T_WUKV;
  if (i < T_POOL) { w.kind = 1; w.n0 = i; return w; }
  i -= T_POOL;
  w.src = p.w_out + (size_t)l * 2048 * 2048; w.ldsrc = 2048; w.K = 2048; w.N = 2048; w.dst = (u16*)(ws + O_WOUT);
  w.k0 = (i & 31) * 64; w.n0 = (i >> 5) * 64;
  return w;
}
DEVI void wload(const WItem& w, float4 (&v)[2], int tid) {
#pragma unroll
  for (int it = 0; it < 2; ++it) {
    int i = tid + it * NTHR, tr = i >> 4, c4 = (i & 15) * 4;
    float4 x = make_float4(0.f, 0.f, 0.f, 0.f);
    if (w.n0 + c4 < w.N) x = *(const float4*)(w.src + (size_t)(w.k0 + tr) * w.ldsrc + w.n0 + c4);
    if (w.kscale) { float sc = w.kscale[w.k0 + tr]; x.x *= sc; x.y *= sc; x.z *= sc; x.w *= sc; }
    v[it] = x;
  }
}

__device__ void phase_wprep(const P& p, int l, int wmode, int rank, int count, int mod, int lo, int width, int sub_lo,
                            int sub_hi) {
  OPQ_IDS
  char* ws = opqp(p.ws);
  constexpr int T_W1 = 32 * 114, T_W2 = 32 * 128;
  constexpr int T_A = T_W1 + T_W2 + 4 * 8 * 32 + 8 * 12 + 8 * 16 + 64, T_WOUT = 32 * 32;
  const int ubeg = (wmode == 2) ? T_A : (wmode == 3) ? sub_lo : 0;
  const int uend = (wmode == 1) ? T_A - T_W2 : (wmode == 3) ? sub_hi : (wmode == 4) ? T_A : T_A + T_WOUT;
  const int tend = T_A + T_WOUT;
#define WMAP(u) ((u) >= uend ? tend : (wmode == 1) ? ((u) < T_W1 ? (u) : (u) + T_W2) : (wmode == 3) ? T_W1 + (u) : (u))
  u16* wmerge = (l & 1) ? (u16*)(ws + O_WINM1) : (u16*)(ws + O_WIN) + (size_t)C_MG * 2048;
  float* tiles = (float*)shm;
  int g = rank, par = 0;
  WItem cur = wdecode(p, ws, l, WMAP(ubeg + (g / width) * mod + lo + g % width), tend, wmerge);
  float4 v[2] = {make_float4(0.f, 0.f, 0.f, 0.f), make_float4(0.f, 0.f, 0.f, 0.f)};
  __syncthreads();
  if (cur.kind == 0) wload(cur, v, TIDX);
  while (cur.kind >= 0) {
    g += count;
    WItem nxt = wdecode(p, ws, l, WMAP(ubeg + (g / width) * mod + lo + g % width), tend, wmerge);
    float4 vn[2] = {make_float4(0.f, 0.f, 0.f, 0.f), make_float4(0.f, 0.f, 0.f, 0.f)};
    if (nxt.kind == 0) wload(nxt, vn, TIDX);
    if (cur.kind == 0) {
      float* tile = tiles + par * (64 * 65);
      par ^= 1;
#pragma unroll
      for (int it = 0; it < 2; ++it) {
        int i = TIDX + it * NTHR, tr = i >> 4, c4 = (i & 15) * 4;
        float* tp = tile + tr * 65 + c4;
        tp[0] = v[it].x; tp[1] = v[it].y; tp[2] = v[it].z; tp[3] = v[it].w;
      }
      __syncthreads();
      int tn = TIDX & 63, tk = (TIDX >> 6) * 8;
      if (cur.n0 + tn < cur.N) {
        bf16x8 o;
#pragma unroll
        for (int e = 0; e < 8; ++e) o[e] = (short)f2bf(tile[(tk + e) * 65 + tn]);
        *(bf16x8*)(cur.dst + (size_t)(cur.n0 + tn) * cur.K + cur.k0 + tk) = o;
      }
    } else {
      u16* dst = (u16*)(ws + O_POOL);
      for (int e = TIDX; e < 4096; e += NTHR) {
        int idx = cur.n0 * 4096 + e, n = idx >> 9, k = idx & 511;
        int gg = n >> 7, g2 = k >> 7;
        float x = 0.f;
        if (gg == g2) x = p.pool_w[(((size_t)l * 4 + gg) * 128 + (k & 127)) * 128 + (n & 127)];
        dst[idx] = f2bf(x);
      }
    }
    cur = nxt;
    v[0] = vn[0];
    v[1] = vn[1];
  }
  __syncthreads();
}
#undef WMAP

__device__ void phase_mod_partial(const P& p) {
  OPQ_IDS
  float* sl = (float*)shm;
  float* modp = (float*)(p.ws + O_MODP);
  for (int t = BIDX; t < 4 * 24 * 16; t += gridDim.x) {
    int l = t / 384, r = t % 384, nb = r / 16, ks = r % 16;
    __syncthreads();
    for (int i = TIDX; i < 640; i += NTHR) {
      int v = i >> 7, k = i & 127;
      float cv = (v < 4) ? p.c[v * 2048 + ks * 128 + k] : p.c_ctx[ks * 128 + k];
      sl[i] = silu_f(cv);
    }
    __syncthreads();
    int col = TIDX & 255, kh = TIDX >> 8;
    float a[5] = {0, 0, 0, 0, 0};
    const float* w = p.w_mod + ((size_t)l * 2048 + ks * 128 + kh * 64) * 6144 + nb * 256 + col;
#pragma unroll 4
    for (int k = 0; k < 64; ++k) {
      float wv = w[(size_t)k * 6144];
#pragma unroll
      for (int v = 0; v < 5; ++v) a[v] += sl[v * 128 + kh * 64 + k] * wv;
    }
    __syncthreads();
    float* part = sl + 1024;
    if (kh == 1) {
#pragma unroll
      for (int v = 0; v < 5; ++v) part[v * 256 + col] = a[v];
    }
    __syncthreads();
    if (kh == 0) {
#pragma unroll
      for (int v = 0; v < 5; ++v)
        modp[(((size_t)l * 16 + ks) * 5 + v) * 6144 + nb * 256 + col] = a[v] + part[v * 256 + col];
    }
  }
  float2* rt = (float2*)(p.ws + O_ROPE);
  for (int i = BIDX * NTHR + TIDX; i < 1024; i += gridDim.x * NTHR) {
    int pos = i >> 4, j = i & 15;
    float inv = powf(10000.f, -(float)j / 16.f);
    float ang = (float)pos * inv;
    rt[i] = make_float2(cosf(ang), sinf(ang));
  }
}
__device__ void phase_mod_reduce(const P& p) {
  OPQ_IDS
  const float* modp = (const float*)(p.ws + O_MODP);
  float* mod = (float*)(p.ws + O_MOD);
  for (int i = BIDX * NTHR + TIDX; i < 4 * 5 * 6144; i += gridDim.x * NTHR) {
    int l = i / 30720, r = i % 30720, n = r % 6144;
    float s = p.b_mod[l * 6144 + n];
    for (int ks = 0; ks < 16; ++ks) s += modp[((size_t)l * 16 + ks) * 30720 + r];
    mod[i] = s;
  }
}

DEVI float* xrow_ptr(const P& p, int r) {
  int b = r / TPB, t = r - b * TPB;
  return (t < CTXL) ? (float*)(p.ws + O_XC) + ((size_t)b * CTXL + t) * D : p.out + ((size_t)b * SEQ + (t - CTXL)) * D;
}
__device__ void phase_norm(const P& p, int l) {
  OPQ_IDS
  int lane = TIDX & 63, gw = BIDX * 8 + (TIDX >> 6), nw = gridDim.x * 8;
  const float* mod = (const float*)(p.ws + O_MOD);
  u16* hn = (u16*)(p.ws + O_HN);
  float4 g[8];
#pragma unroll
  for (int i = 0; i < 8; ++i) g[i] = *(const float4*)(p.norm_g + l * D + i * 256 + lane * 4);
  for (int r = gw; r < NTOK; r += nw) {
    int b = r / TPB, t = r - b * TPB;
    float* xr = xrow_ptr(p, r);
    const float* src = xr;
    if (l == 0) src = (t < CTXL) ? p.ctx + ((size_t)b * CTXL + t) * D : p.x + ((size_t)b * SEQ + (t - CTXL)) * D;
    const float* mv = mod + ((size_t)l * 5 + (t < CTXL ? 4 : b)) * 6144;
    float4 v[8], sh[8], sc[8];
#pragma unroll
    for (int i = 0; i < 8; ++i) {
      const int c0 = i * 256 + lane * 4;
      v[i] = *(const float4*)(src + c0);
      sh[i] = *(const float4*)(mv + c0);
      sc[i] = *(const float4*)(mv + 2048 + c0);
    }
    float ss = 0.f;
#pragma unroll
    for (int i = 0; i < 8; ++i) ss += v[i].x * v[i].x + v[i].y * v[i].y + v[i].z * v[i].z + v[i].w * v[i].w;
    ss = wave_sum(ss);
    float rs = rsqrtf(ss * (1.f / D) + EPS);
#pragma unroll
    for (int i = 0; i < 8; ++i) {
      int c0 = i * 256 + lane * 4;
      unsigned a0 = f2bf(v[i].x * rs * g[i].x * (1.f + sc[i].x) + sh[i].x), a1 = f2bf(v[i].y * rs * g[i].y * (1.f + sc[i].y) + sh[i].y);
      unsigned a2 = f2bf(v[i].z * rs * g[i].z * (1.f + sc[i].z) + sh[i].z), a3 = f2bf(v[i].w * rs * g[i].w * (1.f + sc[i].w) + sh[i].w);
      uint2 o = make_uint2(a0 | (a1 << 16), a2 | (a3 << 16));
      *(uint2*)(hn + (size_t)r * D + c0) = o;
    }
  }
}
__device__ void phase_final(const P& p) {
  OPQ_IDS
  int lane = TIDX & 63, gw = BIDX * 8 + (TIDX >> 6), nw = gridDim.x * 8;
  float4 g[8];
#pragma unroll
  for (int i = 0; i < 8; ++i) g[i] = *(const float4*)(p.g_final + i * 256 + lane * 4);
  for (int r = gw; r < NBATCH * SEQ; r += nw) {
    float* xr = p.out + (size_t)r * D;
    float4 v[8];
    float ss = 0.f;
#pragma unroll
    for (int i = 0; i < 8; ++i) {
      v[i] = *(const float4*)(xr + i * 256 + lane * 4);
      ss += v[i].x * v[i].x + v[i].y * v[i].y + v[i].z * v[i].z + v[i].w * v[i].w;
    }
    ss = wave_sum(ss);
    float rs = rsqrtf(ss * (1.f / D) + EPS);
#pragma unroll
    for (int i = 0; i < 8; ++i) {
      int c0 = i * 256 + lane * 4;
      *(float4*)(xr + c0) = make_float4(v[i].x * rs * g[i].x, v[i].y * rs * g[i].y, v[i].z * rs * g[i].z, v[i].w * rs * g[i].w);
    }
  }
}

__device__ void phase_p2(const P& p, int l) {
  OPQ_IDS
  int lane = TIDX & 63, gw = xcd_remap(BIDX, BIDX, gridDim.x) * 8 + (TIDX >> 6), nw = gridDim.x * 8;
  char* ws = opqp(p.ws);
  const u16* proj = (const u16*)(ws + O_PROJ);
  float* rinv = (float*)(ws + O_RINV);
  const float2* rt = (const float2*)(ws + O_ROPE);
  float cw[2][4][8];
#pragma unroll
  for (int part = 0; part < 2; ++part)
#pragma unroll
    for (int j = 0; j < 4; ++j) {
      const float* cp = p.conv_w + ((size_t)l * 4 + j) * 1024 + part * 512 + lane * 8;
      f32x4 c0 = *(const f32x4*)cp, c1 = *(const f32x4*)(cp + 4);
#pragma unroll
      for (int i = 0; i < 4; ++i) { cw[part][j][i] = c0[i]; cw[part][j][4 + i] = c1[i]; }
    }
  const float bif = (lane < 16) ? p.b_if[l * 16 + lane] : 0.f;
  const bf16x8 z8 = {0, 0, 0, 0, 0, 0, 0, 0};
  for (int r = gw; r < NTOK; r += nw) {
    int b = r / TPB, t = r - b * TPB;
    const bool isctx = t < CTXL;
    const int pos = isctx ? t : t - CTXL;
    const int n = isctx ? CTXL : SEQ;
    const u16* pr = proj + (size_t)r * NP;
    const bf16x8 vq = *(const bf16x8*)(pr + C_CQ + lane * 8);
    const bf16x8 vkv = *(const bf16x8*)(pr + C_CKV + lane * 8);
    const u16 kro = pr[C_CKR + lane], krp = pr[C_CKR + (lane ^ 16)];
    const u16 dif = pr[C_DIF + (lane & 15)];
    const int g = lane >> 4, w = 2 << g;
    const int lo = max(pos - w / 2, 0), hi = min(pos + (w - 1 - w / 2), n - 1);
    bf16x8 wv[16];
#pragma unroll
    for (int k = 0; k < 16; ++k) {
      int u = pos + k - 8;
      wv[k] = z8;
      if (u >= lo && u <= hi) wv[k] = *(const bf16x8*)(pr + (ptrdiff_t)(k - 8) * NP + C_BI + lane * 8);
    }
    bf16x8 cv[2][4];
#pragma unroll
    for (int part = 0; part < 2; ++part)
#pragma unroll
      for (int j = 0; j < 4; ++j) {
        int u = pos + j - 2;
        cv[part][j] = z8;
        if (u >= 0 && u < n) cv[part][j] = *(const bf16x8*)(pr + (ptrdiff_t)(j - 2) * NP + C_DQ + part * 512 + lane * 8);
      }
    float sq = 0.f, skv = 0.f;
#pragma unroll
    for (int i = 0; i < 8; ++i) { float a = bfs(vq[i]), c = bfs(vkv[i]); sq += a * a; skv += c * c; }
    sq = wave_sum(sq);
    skv = wave_sum(skv);
    if (lane == 0) {
      rinv[r * 2] = rsqrtf(sq * (1.f / 512.f) + EPS);
      rinv[r * 2 + 1] = rsqrtf(skv * (1.f / 512.f) + EPS);
    }
    {
      float own = bf2f(kro);
      float o = own;
      if (!isctx) {
        float par = bf2f(krp);
        int half = lane >> 5, ii = lane & 31, j = ii & 15;
        int pp = half ? (pos & 63) : (pos >> 6);
        float2 cs = rt[pp * 16 + j];
        o = (ii < 16) ? own * cs.x - par * cs.y : own * cs.x + par * cs.y;
      }
      u16 ob = f2bf(o);
      u16* kh = (u16*)(ws + O_KH) + ((size_t)(b * 4) * TPB + t) * 192 + 128 + lane;
#pragma unroll
      for (int h = 0; h < 4; ++h) kh[(size_t)h * TPB * 192] = ob;
    }
    {
      float s[8] = {0, 0, 0, 0, 0, 0, 0, 0};
#pragma unroll
      for (int k = 0; k < 16; ++k)
#pragma unroll
        for (int i = 0; i < 8; ++i) s[i] += bfs(wv[k][i]);
      float ic = 1.f / (float)(hi - lo + 1);
#pragma unroll
      for (int i = 0; i < 8; ++i) s[i] = s[i] * ic - bfs(wv[8][i]);
      st8((u16*)(ws + O_DPOOL) + (size_t)r * 512 + lane * 8, s);
    }
#pragma unroll
    for (int part = 0; part < 2; ++part) {
      float a[8] = {0, 0, 0, 0, 0, 0, 0, 0};
#pragma unroll
      for (int j = 0; j < 4; ++j)
#pragma unroll
        for (int i = 0; i < 8; ++i) a[i] += bfs(cv[part][j][i]) * cw[part][j][i];
      const float ksc = part ? 0.08838834764831845f : 1.f;
#pragma unroll
      for (int i = 0; i < 8; ++i) a[i] = silu_f(a[i]) * ksc;
      st8((u16*)(ws + O_QKC) + (size_t)r * 1024 + part * 512 + lane * 8, a);
    }
    if (lane < 16) {
      float gg = bf2f(dif) + bif;
      if (lane & 4) gg = fminf(gg, 0.f) - __logf(1.f + __expf(-fabsf(gg)));
      ((float*)(ws + O_GL))[(size_t)r * 16 + lane] = gg;
    }
  }
}

struct AttnTile {
  const u16* kp;
  const u16* vp;
  int isctx;
  int kr;
};

template <int DQK, int QT, bool NA>
__device__ void attn_block(const P& p, int layer, int b, int h, int qrow0  , bool q_is_latent,
                           int ntile, int na_r0  , const u16* Kbase, int ldk,
                           const u16* Vtbase  , const u16* Qbase, int ldq, int gatecol,
                           int ycol, float scale) {
  OPQ_IDS
  constexpr int KS = DQK / 32;
  constexpr int KSTR = DQK + 8;
  const float scale2 = scale * 1.4426950408889634f;
  constexpr int KCH = 64 * DQK / 8 / NTHR;
  u16* Ks = (u16*)shm;
  u16* Vs = Ks + 64 * KSTR;
  float* rpb = (float*)(Vs + 128 * 72);
  const int wid = TIDX >> 6, lane = TIDX & 63, l15 = lane & 15, quad = lane >> 4;
  char* ws = opqp(p.ws);
  const float2* rt = (const float2*)(ws + O_ROPE);

  __syncthreads();
  if (NA) {
    for (int i = TIDX; i < 465; i += NTHR) rpb[i] = p.na_rpb[((size_t)layer * 4 + h) * 465 + i];
  }
  bf16x8 qf[QT][KS];
#pragma unroll
  for (int qt = 0; qt < QT; ++qt) {
    int ql = wid * 16 * QT + qt * 16 + l15;
    const u16* qp = Qbase + (size_t)(qrow0 + ql) * ldq;
#pragma unroll
    for (int ks = 0; ks < KS; ++ks) qf[qt][ks] = *(const bf16x8*)(qp + ks * 32 + quad * 8);
  }
  f32x4 o[8][QT];
  float mrun[QT], lrun[QT];
#pragma unroll
  for (int qt = 0; qt < QT; ++qt) {
    mrun[qt] = -1e30f;
    lrun[qt] = 0.f;
#pragma unroll
    for (int dt = 0; dt < 8; ++dt) o[dt][qt] = f32x4{0.f, 0.f, 0.f, 0.f};
  }
  int na_rq = 0, na_cq = 0, na_cs = 0, na_rs = 0;
  if (NA) {
    na_rq = na_r0 + (wid >> 2);
    na_cq = (wid & 3) * 16 + l15;
    na_cs = min(max(na_cq - 8, 0), 48);
    na_rs = min(max(na_rq - 4, 0), 56);
  }
  const int na_rlo = NA ? min(max(na_r0 - 4, 0), 56) : 0;

  bf16x8 kreg[KCH], vreg[2];
  auto tile_ptrs = [&](int ti, const u16*& kp, const u16*& vp, int& isctx, int& kr) {
    int tok0;
    if (ti < 4) {
      tok0 = ti * 64;
      isctx = 1;
      kr = -1;
    } else {
      isctx = 0;
      kr = NA ? (na_rlo + ti - 4) : (ti - 4);
      tok0 = CTXL + kr * 64;
    }
    kp = Kbase + (size_t)tok0 * ldk;
    vp = Vtbase + tok0;
  };
  auto gloadK = [&](int ti) {
    const u16 *kp, *vp;
    int ic, kr;
    tile_ptrs(ti, kp, vp, ic, kr);
#pragma unroll
    for (int i = 0; i < KCH; ++i) {
      int c = TIDX + i * NTHR, key = c / (DQK / 8), part = c % (DQK / 8);
      kreg[i] = *(const bf16x8*)(kp + (size_t)key * ldk + part * 8);
    }
  };
  auto gloadV = [&](int ti) {
    const u16 *kp, *vp;
    int ic, kr;
    tile_ptrs(ti, kp, vp, ic, kr);
#pragma unroll
    for (int i = 0; i < 2; ++i) {
      int c = TIDX + i * NTHR, dv = c >> 3, part = c & 7;
      vreg[i] = *(const bf16x8*)(vp + (size_t)dv * TPB + part * 8);
    }
  };
  auto sstoreK = [&]() {
#pragma unroll
    for (int i = 0; i < KCH; ++i) {
      int c = TIDX + i * NTHR, key = c / (DQK / 8), part = c % (DQK / 8);
      *(bf16x8*)(Ks + key * KSTR + part * 8) = kreg[i];
    }
  };
  auto sstoreV = [&]() {
#pragma unroll
    for (int i = 0; i < 2; ++i) {
      int c = TIDX + i * NTHR, dv = c >> 3, part = c & 7;
      *(bf16x8*)(Vs + dv * 72 + part * 8) = vreg[i];
    }
  };

  gloadK(0);
  gloadV(0);
  __syncthreads();
  sstoreK();
  sstoreV();
  if (ntile > 1) { gloadK(1); gloadV(1); }
  LDS_BAR();
  auto tile_iter = [&](int ti) {
    const int isctx = ti < 4;
    int kr = NA ? (na_rlo + ti - 4) : 0;
    bool active = true;
    if (NA && !isctx) active = (kr >= na_rs) && (kr < na_rs + 8);
    f32x4 s[4][QT];
    if (active) {
#pragma unroll
      for (int kt = 0; kt < 4; ++kt)
#pragma unroll
        for (int qt = 0; qt < QT; ++qt) s[kt][qt] = f32x4{0.f, 0.f, 0.f, 0.f};
#pragma unroll
      for (int ks = 0; ks < KS; ++ks) {
        bf16x8 a[4];
#pragma unroll
        for (int kt = 0; kt < 4; ++kt) a[kt] = *(const bf16x8*)(Ks + (kt * 16 + l15) * KSTR + ks * 32 + quad * 8);
#pragma unroll
        for (int qt = 0; qt < QT; ++qt) {
          bf16x8 q = qf[qt][ks];
#pragma unroll
          for (int kt = 0; kt < 4; ++kt) s[kt][qt] = __builtin_amdgcn_mfma_f32_16x16x32_bf16(a[kt], q, s[kt][qt], 0, 0, 0);
        }
      }
    }
    LDS_BAR();
    if (ti + 1 < ntile) sstoreK();
    if (ti + 2 < ntile) gloadK(ti + 2);
    if (active) {
      bf16x8 pf[QT][2];
#pragma unroll
      for (int qt = 0; qt < QT; ++qt) {
        float mx = -1e30f;
#pragma unroll
        for (int kt = 0; kt < 4; ++kt)
#pragma unroll
          for (int j = 0; j < 4; ++j) {
            float v = s[kt][qt][j] * scale2;
            if (NA && !isctx) {
              int ck = kt * 16 + quad * 4 + j;
              bool valid = (ck >= na_cs) && (ck < na_cs + 16);
              int bidx = (kr - na_rq + 7) * 31 + min(max(ck - na_cq + 15, 0), 30);
              v = valid ? v + rpb[bidx] * 1.4426950408889634f : -1e30f;
            }
            s[kt][qt][j] = v;
            mx = fmaxf(mx, v);
          }
        mx = fmaxf(mx, SHX(mx, 16));
        mx = fmaxf(mx, SHX(mx, 32));
        float mnew = fmaxf(mrun[qt], mx);
        float alpha = __builtin_amdgcn_exp2f(mrun[qt] - mnew);
        mrun[qt] = mnew;
        float ls = 0.f;
#pragma unroll
        for (int kt = 0; kt < 4; ++kt)
#pragma unroll
          for (int j = 0; j < 4; ++j) {
            float pv = __builtin_amdgcn_exp2f(s[kt][qt][j] - mnew);
            ls += pv;
            s[kt][qt][j] = pv;
          }
        lrun[qt] = lrun[qt] * alpha + ls;
        if (__builtin_amdgcn_ballot_w64(alpha != 1.f)) {
#pragma unroll
          for (int dt = 0; dt < 8; ++dt)
#pragma unroll
            for (int j = 0; j < 4; ++j) o[dt][qt][j] *= alpha;
        }
#pragma unroll
        for (int kk = 0; kk < 2; ++kk) {
          union { bf16x8 v; unsigned u[4]; } cv;
          cv.u[0] = pk2(s[2 * kk][qt][0], s[2 * kk][qt][1]);
          cv.u[1] = pk2(s[2 * kk][qt][2], s[2 * kk][qt][3]);
          cv.u[2] = pk2(s[2 * kk + 1][qt][0], s[2 * kk + 1][qt][1]);
          cv.u[3] = pk2(s[2 * kk + 1][qt][2], s[2 * kk + 1][qt][3]);
          pf[qt][kk] = cv.v;
        }
      }
      {
        const u16* vb0 = Vs + l15 * 72 + quad * 4;
        bf16x4 n0 = *(const bf16x4*)vb0, n1 = *(const bf16x4*)(vb0 + 16);
#pragma unroll
        for (int idx = 0; idx < 16; ++idx) {
          const int kk = idx >> 3, dt = idx & 7;
          bf16x8 va = {n0[0], n0[1], n0[2], n0[3], n1[0], n1[1], n1[2], n1[3]};
          if (idx + 1 < 16) {
            const int kk2 = (idx + 1) >> 3, dt2 = (idx + 1) & 7;
            const u16* vb = Vs + (dt2 * 16 + l15) * 72 + kk2 * 32 + quad * 4;
            n0 = *(const bf16x4*)vb;
            n1 = *(const bf16x4*)(vb + 16);
          }
#pragma unroll
          for (int qt = 0; qt < QT; ++qt) o[dt][qt] = __builtin_amdgcn_mfma_f32_16x16x32_bf16(va, pf[qt][kk], o[dt][qt], 0, 0, 0);
        }
      }
    }
    LDS_BAR();
    if (ti + 1 < ntile) sstoreV();
    if (ti + 2 < ntile) gloadV(ti + 2);
  };
  for (int ti = 0; ti < 4; ++ti) tile_iter(ti);
  if (ntile > 4) {
    if (!NA && DQK == 192) {
#pragma unroll
      for (int qt = 0; qt < QT; ++qt) {
        const int ql = wid * 16 * QT + qt * 16 + l15;
        const u16* qp = Qbase + (size_t)(qrow0 + ql) * ldq;
        const int tq = (qrow0 + ql) % TPB - CTXL;
#pragma unroll
        for (int hf = 0; hf < 2; ++hf) {
          bf16x8 own = qf[qt][KS - 2 + hf];
          bf16x8 par = *(const bf16x8*)(qp + 128 + hf * 32 + (quad ^ 2) * 8);
          int pp = hf ? (tq & 63) : (tq >> 6);
          bf16x8 ro;
#pragma unroll
          for (int e = 0; e < 8; ++e) {
            float2 cs = rt[pp * 16 + (quad & 1) * 8 + e];
            float ov = bfs(own[e]), pv = bfs(par[e]);
            float r = (quad < 2) ? ov * cs.x - pv * cs.y : ov * cs.x + pv * cs.y;
            ro[e] = (short)f2bf(r);
          }
          qf[qt][KS - 2 + hf] = ro;
        }
      }
    }
    for (int ti = 4; ti < ntile; ++ti) tile_iter(ti);
  }
  const u16* proj = (const u16*)(ws + O_PROJ);
  u16* ys = (u16*)(ws + O_YS);
#pragma unroll
  for (int qt = 0; qt < QT; ++qt) {
    float lt = lrun[qt];
    lt += SHX(lt, 16);
    lt += SHX(lt, 32);
    float il = 1.f / lt;
    int r = qrow0 + wid * 16 * QT + qt * 16 + l15;
#pragma unroll
    for (int dt = 0; dt < 8; ++dt) {
      int dv = dt * 16 + quad * 4;
      bf16x4 g = *(const bf16x4*)(proj + (size_t)r * NP + gatecol + h * 128 + dv);
      bf16x4 ov;
#pragma unroll
      for (int j = 0; j < 4; ++j) {
        float y = bf2f(f2bf(o[dt][qt][j] * il));
        ov[j] = (short)f2bf(y * silu_f(bfs(g[j])));
      }
      *(bf16x4*)(ys + (size_t)r * 2048 + ycol + h * 128 + dv) = ov;
    }
  }
}

__device__ void phase_attn(const P& p, int l) {
  OPQ_IDS
  char* ws = opqp(p.ws);
  const bool need_ctx = l < 3;
  const int n_mla_lat = 256, n_na_lat = 512;
  const int n_mla_ctx = need_ctx ? 16 : 0, n_na_ctx = need_ctx ? 32 : 0;
  const int total = n_mla_lat + n_na_lat + n_mla_ctx + n_na_ctx;
  const u16* proj = (const u16*)(ws + O_PROJ);
  for (int it0 = BIDX; it0 < (total + 255) / 256 * 256; it0 += gridDim.x) {
    const int it = xcd_remap(it0, BIDX, gridDim.x);
    if (it >= total) continue;
    int i = it;
    if (i < n_mla_lat) {
      int bh = i >> 4, qb = i & 15, b = bh >> 2, h = bh & 3;
      attn_block<192, 2, false>(p, l, b, h, b * TPB + CTXL + qb * 256, true, 68, 0,
                                (const u16*)(ws + O_KH) + (size_t)bh * TPB * 192, 192,
                                (const u16*)(ws + O_VTC) + (size_t)bh * 128 * TPB,
                                (const u16*)(ws + O_QH) + h * 192, 768, C_CG, 1024, 0.07216878364870322f);
      continue;
    }
    i -= n_mla_lat;
    if (i < n_na_lat) {
      int bh = i >> 5, rp = i & 31, b = bh >> 2, h = bh & 3;
      int r0 = rp * 2;
      int rlo = min(max(r0 - 4, 0), 56), rhi = min(max(r0 + 1 - 4, 0), 56) + 7;
      attn_block<128, 1, true>(p, l, b, h, b * TPB + CTXL + r0 * 64, true, 4 + (rhi - rlo + 1), r0,
                               proj + (size_t)b * TPB * NP + C_AK + h * 128, NP,
                               (const u16*)(ws + O_VTA) + (size_t)bh * 128 * TPB, proj + C_AQ + h * 128, NP, C_AG, 0,
                               0.08838834764831845f);
      continue;
    }
    i -= n_na_lat;
    if (i < n_mla_ctx) {
      int bh = i, b = bh >> 2, h = bh & 3;
      attn_block<192, 2, false>(p, l, b, h, b * TPB, false, 4, 0, (const u16*)(ws + O_KH) + (size_t)bh * TPB * 192, 192,
                                (const u16*)(ws + O_VTC) + (size_t)bh * 128 * TPB, (const u16*)(ws + O_QH) + h * 192,
                                768, C_CG, 1024, 0.07216878364870322f);
      continue;
    }
    i -= n_mla_ctx;
    {
      int bh = i >> 1, half = i & 1, b = bh >> 2, h = bh & 3;
      attn_block<128, 1, false>(p, l, b, h, b * TPB + half * 128, false, 4, 0,
                                proj + (size_t)b * TPB * NP + C_AK + h * 128, NP,
                                (const u16*)(ws + O_VTA) + (size_t)bh * 128 * TPB, proj + C_AQ + h * 128, NP, C_AG, 0,
                                0.08838834764831845f);
    }
  }
}

DEVI int chunk_index(int dir, int blk) {
  if (dir == 0) return blk;
  return blk < 4 ? 3 - blk : 4 + 63 - (blk - 4);
}
__device__ void mlstm_gates(const P& p, int b, int h, int blk, float* gs) {
  OPQ_IDS
  const float* gl = (const float*)(opqp(p.ws) + O_GL);
  int R0 = b * TPB + blk * 64;
  if (TIDX < 128) {
    const int dir = TIDX >> 6, L = LANE, t = dir ? 63 - L : L;
    const float li = gl[(size_t)(R0 + t) * 16 + dir * 8 + h];
    const float lf = gl[(size_t)(R0 + t) * 16 + dir * 8 + 4 + h];
    float bc = lf;
#pragma unroll
    for (int o = 1; o < 64; o <<= 1) {
      float n = __int_as_float(__builtin_amdgcn_ds_bpermute(((L - o) & 63) << 2, __float_as_int(bc)));
      if (L >= o) bc += n;
    }
    float pm = li - bc;
#pragma unroll
    for (int o = 1; o < 64; o <<= 1) {
      float n = __int_as_float(__builtin_amdgcn_ds_bpermute(((L - o) & 63) << 2, __float_as_int(pm)));
      if (L >= o) pm = fmaxf(pm, n);
    }
    gs[dir * 64 + t] = li;
    gs[128 + dir * 64 + t] = lf;
    gs[256 + dir * 64 + t] = bc;
    gs[384 + dir * 64 + t] = pm;
    if (L == 63) {
      gs[512 + dir * 4] = bc;
      gs[512 + dir * 4 + 1] = bc + pm;
    }
  }
  __syncthreads();
}

__device__ void phase_m1(const P& p) {
  OPQ_IDS
  char* ws = opqp(p.ws);
  u16* kwT = (u16*)shm;
  u16* vT = kwT + 2 * 128 * 72;
  float* gs = (float*)(vT + 128 * 72);
  const u16* qkc = (const u16*)(ws + O_QKC);
  const u16* proj = (const u16*)(ws + O_PROJ);
  const int wid = TIDX >> 6, lane = TIDX & 63, l15 = lane & 15, quad = lane >> 4;
  for (int it = BIDX; it < 16 * 68; it += gridDim.x) {
    int bh = it / 68, blk = it % 68, b = bh >> 2, h = bh & 3;
    int R0 = b * TPB + blk * 64;
    __syncthreads();
    mlstm_gates(p, b, h, blk, gs);
#pragma unroll
    for (int i = 0; i < 2; ++i) {
      int c = TIDX + i * NTHR, s = c & 63, part = c >> 6;
      float kf[8];
      ld8(qkc + (size_t)(R0 + s) * 1024 + 512 + h * 128 + part * 8, kf);
      bf16x8 vv = *(const bf16x8*)(proj + (size_t)(R0 + s) * NP + C_DV + h * 128 + part * 8);
#pragma unroll
      for (int dir = 0; dir < 2; ++dir) {
        float bl = gs[512 + dir * 4], ml = gs[512 + dir * 4 + 1];
        float w = __expf(bl - gs[256 + dir * 64 + s] + gs[dir * 64 + s] - ml);
#pragma unroll
        for (int e = 0; e < 8; ++e) kwT[(dir * 128 + part * 8 + e) * 72 + s] = f2bf(kf[e] * w);
      }
#pragma unroll
      for (int e = 0; e < 8; ++e) vT[(part * 8 + e) * 72 + s] = (u16)vv[e];
    }
    __syncthreads();
    int dir = wid >> 2;
    int item = (bh * 2 + dir) * 68 + chunk_index(dir, blk);
    f32x4 acc[2][8];
#pragma unroll
    for (int a = 0; a < 2; ++a)
#pragma unroll
      for (int e = 0; e < 8; ++e) acc[a][e] = f32x4{0.f, 0.f, 0.f, 0.f};
#pragma unroll
    for (int kk = 0; kk < 2; ++kk) {
      bf16x8 af[2];
#pragma unroll
      for (int a = 0; a < 2; ++a) {
        const u16* ab = kwT + (dir * 128 + ((wid & 3) * 2 + a) * 16 + l15) * 72 + kk * 32 + quad * 4;
        bf16x4 v0 = *(const bf16x4*)ab, v1 = *(const bf16x4*)(ab + 16);
        af[a] = bf16x8{v0[0], v0[1], v0[2], v0[3], v1[0], v1[1], v1[2], v1[3]};
      }
#pragma unroll
      for (int e = 0; e < 8; ++e) {
        const u16* bb = vT + (e * 16 + l15) * 72 + kk * 32 + quad * 4;
        bf16x4 v0 = *(const bf16x4*)bb, v1 = *(const bf16x4*)(bb + 16);
        bf16x8 bf = bf16x8{v0[0], v0[1], v0[2], v0[3], v1[0], v1[1], v1[2], v1[3]};
#pragma unroll
        for (int a = 0; a < 2; ++a) acc[a][e] = __builtin_amdgcn_mfma_f32_16x16x32_bf16(af[a], bf, acc[a][e], 0, 0, 0);
      }
    }
    float* kl = (float*)(ws + O_KLOC) + (size_t)item * 16384;
#pragma unroll
    for (int a = 0; a < 2; ++a)
#pragma unroll
      for (int e = 0; e < 8; ++e) {
        int d0 = ((wid & 3) * 2 + a) * 16 + quad * 4, ee = e * 16 + l15;
        *(f32x4*)(kl + ee * 128 + d0) = acc[a][e];
      }
    if (TIDX < 256) {
      int dr = TIDX >> 7, d = TIDX & 127;
      float s = 0.f;
      for (int u = 0; u < 64; ++u) s += bf2f(kwT[(dr * 128 + d) * 72 + u]);
      int itm = (bh * 2 + dr) * 68 + chunk_index(dr, blk);
      ((float*)(ws + O_NLOC))[(size_t)itm * 128 + d] = s;
      if (d < 2) ((float*)(ws + O_SC))[itm * 2 + d] = gs[512 + dr * 4 + d];
    }
  }
}

__device__ void phase_m2(const P& p) {
  OPQ_IDS
  char* ws = opqp(p.ws);
  const float* kloc = (const float*)(ws + O_KLOC);
  const float* nloc = (const float*)(ws + O_NLOC);
  const float* sc = (const float*)(ws + O_SC);
  u16* cin = (u16*)(ws + O_CIN);
  float* nin = (float*)(ws + O_NIN);
  float* minp = (float*)(ws + O_MIN);
  const int per = 4096 + 32;
  for (int idx = BIDX * NTHR + TIDX; idx < 32 * per; idx += gridDim.x * NTHR) {
    int seq = idx / per, q4 = idx % per;
    f32x4 C = {0.f, 0.f, 0.f, 0.f};
    float m = 0.f;
    const bool isn = q4 >= 4096;
    for (int j0 = 0; j0 < 68; j0 += 4) {
      f32x4 kv[4];
      float bl[4], ml[4];
#pragma unroll
      for (int u = 0; u < 4; ++u) {
        int item = seq * 68 + j0 + u;
        kv[u] = isn ? *(const f32x4*)(nloc + (size_t)item * 128 + (q4 - 4096) * 4)
                    : *(const f32x4*)(kloc + (size_t)item * 16384 + q4 * 4);
        bl[u] = sc[item * 2];
        ml[u] = sc[item * 2 + 1];
      }
#pragma unroll
      for (int u = 0; u < 4; ++u) {
        int item = seq * 68 + j0 + u;
        if (isn) {
          *(f32x4*)(nin + (size_t)item * 128 + (q4 - 4096) * 4) = C;
          if (q4 == 4096) minp[item] = m;
        } else {
          bf16x4 o;
#pragma unroll
          for (int e = 0; e < 4; ++e) o[e] = (short)f2bf(C[e]);
          *(bf16x4*)(cin + (size_t)item * 16384 + q4 * 4) = o;
        }
        float mn = fmaxf(bl[u] + m, ml[u]);
        float dec = __expf(bl[u] + m - mn), wl = __expf(ml[u] - mn);
#pragma unroll
        for (int e = 0; e < 4; ++e) C[e] = dec * C[e] + wl * kv[u][e];
        m = mn;
      }
    }
  }
}

__device__ void phase_m3(const P& p, int l) {
  OPQ_IDS
  char* ws = opqp(p.ws);
  u16* Qs = (u16*)shm;
  u16* Ks = Qs + 64 * 136;
  u16* vT = Ks + 64 * 136;
  float* gs = (float*)(vT + 128 * 72);
  float* qn = gs + 528;
  float* ninl = qn + 128;
  float* hbuf = ninl + 256;
  const u16* qkc = (const u16*)(ws + O_QKC);
  const u16* proj = (const u16*)(ws + O_PROJ);
  const int wid = TIDX >> 6, lane = TIDX & 63, l15 = lane & 15, quad = lane >> 4;
  const bool need_ctx = l < 3;
  for (int it = BIDX; it < 16 * 68; it += gridDim.x) {
    int bh = it / 68, blk = it % 68, b = bh >> 2, h = bh & 3;
    if (!need_ctx && blk < 4) continue;
    int R0 = b * TPB + blk * 64;
    int itemd[2];
    itemd[0] = (bh * 2 + 0) * 68 + chunk_index(0, blk);
    itemd[1] = (bh * 2 + 1) * 68 + chunk_index(1, blk);
    bf16x8 lq[2], lk[2], lv[2];
#pragma unroll
    for (int i = 0; i < 2; ++i) {
      int c = TIDX + i * NTHR, s = c >> 4, part = c & 15;
      lq[i] = *(const bf16x8*)(qkc + (size_t)(R0 + s) * 1024 + h * 128 + part * 8);
      lk[i] = *(const bf16x8*)(qkc + (size_t)(R0 + s) * 1024 + 512 + h * 128 + part * 8);
      int c2s = c & 63, c2p = c >> 6;
      lv[i] = *(const bf16x8*)(proj + (size_t)(R0 + c2s) * NP + C_DV + h * 128 + c2p * 8);
    }
    float lnin = 0.f;
    if (TIDX < 256) lnin = ((const float*)(ws + O_NIN))[(size_t)itemd[TIDX >> 7] * 128 + (TIDX & 127)];
    const float m_in = ((const float*)(ws + O_MIN))[itemd[wid >> 2]];
    bf16x8 ldo[2], ldg[2];
    f32x4 lgn[4];
    {
      const int tt = TIDX >> 3, ch0 = h * 128 + (TIDX & 7) * 16;
      const u16* pr = proj + (size_t)(R0 + tt) * NP;
      ldo[0] = *(const bf16x8*)(pr + C_DO + ch0);
      ldo[1] = *(const bf16x8*)(pr + C_DO + ch0 + 8);
      ldg[0] = *(const bf16x8*)(pr + C_DG + ch0);
      ldg[1] = *(const bf16x8*)(pr + C_DG + ch0 + 8);
#pragma unroll
      for (int e4 = 0; e4 < 4; ++e4) lgn[e4] = *(const f32x4*)(p.ml_gnorm + l * 512 + ch0 + e4 * 4);
    }
    __syncthreads();
    mlstm_gates(p, b, h, blk, gs);
#pragma unroll
    for (int i = 0; i < 2; ++i) {
      int c = TIDX + i * NTHR, s = c >> 4, part = c & 15;
      *(bf16x8*)(Qs + s * 136 + part * 8) = lq[i];
      *(bf16x8*)(Ks + s * 136 + part * 8) = lk[i];
      int c2s = c & 63, c2p = c >> 6;
#pragma unroll
      for (int e = 0; e < 8; ++e) vT[(c2p * 8 + e) * 72 + c2s] = (u16)lv[i][e];
    }
    if (TIDX < 256) ninl[TIDX] = lnin;
    __syncthreads();
    {
      const int dr = TIDX >> 8, t = (TIDX >> 2) & 63, pq = TIDX & 3;
      float s = 0.f;
#pragma unroll 8
      for (int d = pq * 32; d < pq * 32 + 32; ++d) s += bf2f(Qs[t * 136 + d]) * ninl[dr * 128 + d];
      s += SHX(s, 1);
      s += SHX(s, 2);
      if (pq == 0) qn[dr * 64 + t] = s;
    }
    __syncthreads();
    {
      const int dir = wid >> 2, tt = wid & 3;
      const int t = tt * 16 + l15;
      const float* li = gs + dir * 64;
      const float* bc = gs + 256 + dir * 64;
      const float bct = bc[t];
      const float mt = fmaxf(bct + m_in, bct + gs[384 + dir * 64 + t]);
      bf16x8 qf[4];
#pragma unroll
      for (int ks = 0; ks < 4; ++ks) qf[ks] = *(const bf16x8*)(Qs + t * 136 + ks * 32 + quad * 8);
      f32x4 s[4];
#pragma unroll
      for (int st = 0; st < 4; ++st) s[st] = f32x4{0.f, 0.f, 0.f, 0.f};
#pragma unroll
      for (int ks = 0; ks < 4; ++ks)
#pragma unroll
        for (int st = 0; st < 4; ++st) {
          bf16x8 a = *(const bf16x8*)(Ks + (st * 16 + l15) * 136 + ks * 32 + quad * 8);
          s[st] = __builtin_amdgcn_mfma_f32_16x16x32_bf16(a, qf[ks], s[st], 0, 0, 0);
        }
      float dsum = 0.f;
      bf16x8 pf[2];
#pragma unroll
      for (int st = 0; st < 4; ++st)
#pragma unroll
        for (int j = 0; j < 4; ++j) {
          int sp = st * 16 + quad * 4 + j;
          bool valid = dir == 0 ? (sp <= t) : (sp >= t);
          float dm = bct - bc[sp] + li[sp] - mt;
          float v = valid ? s[st][j] * __expf(dm) : 0.f;
          dsum += v;
          pf[st >> 1][(st & 1) * 4 + j] = (short)f2bf(v);
        }
      dsum += SHX(dsum, 16);
      dsum += SHX(dsum, 32);
      f32x4 hi[8], hx[8];
#pragma unroll
      for (int e = 0; e < 8; ++e) { hi[e] = f32x4{0.f, 0.f, 0.f, 0.f}; hx[e] = f32x4{0.f, 0.f, 0.f, 0.f}; }
#pragma unroll
      for (int kk = 0; kk < 2; ++kk)
#pragma unroll
        for (int e = 0; e < 8; ++e) {
          const u16* vb = vT + (e * 16 + l15) * 72 + kk * 32 + quad * 4;
          bf16x4 v0 = *(const bf16x4*)vb, v1 = *(const bf16x4*)(vb + 16);
          bf16x8 va = {v0[0], v0[1], v0[2], v0[3], v1[0], v1[1], v1[2], v1[3]};
          hi[e] = __builtin_amdgcn_mfma_f32_16x16x32_bf16(va, pf[kk], hi[e], 0, 0, 0);
        }
      const u16* cin = (const u16*)(ws + O_CIN) + (size_t)itemd[dir] * 16384;
      {
        bf16x8 cn[8];
#pragma unroll
        for (int e = 0; e < 8; ++e) cn[e] = *(const bf16x8*)(cin + (e * 16 + l15) * 128 + quad * 8);
#pragma unroll
        for (int ks = 0; ks < 4; ++ks) {
          bf16x8 ca[8];
#pragma unroll
          for (int e = 0; e < 8; ++e) ca[e] = cn[e];
          if (ks + 1 < 4) {
#pragma unroll
            for (int e = 0; e < 8; ++e) cn[e] = *(const bf16x8*)(cin + (e * 16 + l15) * 128 + (ks + 1) * 32 + quad * 8);
          }
#pragma unroll
          for (int e = 0; e < 8; ++e) hx[e] = __builtin_amdgcn_mfma_f32_16x16x32_bf16(ca[e], qf[ks], hx[e], 0, 0, 0);
        }
      }
      float a = __expf(bct + m_in - mt);
      float den = a * qn[dir * 64 + t] + dsum;
      float idn = 1.f / fmaxf(fabsf(den), __expf(-mt));
#pragma unroll
      for (int e = 0; e < 8; ++e)
#pragma unroll
        for (int j = 0; j < 4; ++j) hbuf[(dir * 64 + t) * 129 + e * 16 + quad * 4 + j] = (a * hx[e][j] + hi[e][j]) * idn;
    }
    __syncthreads();
    {
      int t = TIDX >> 3, part = TIDX & 7;
      float hv[16], ss = 0.f;
#pragma unroll
      for (int e = 0; e < 16; ++e) {
        hv[e] = hbuf[t * 129 + part * 16 + e] + hbuf[(64 + t) * 129 + part * 16 + e];
        ss += hv[e] * hv[e];
      }
      ss += SHX(ss, 1);
      ss += SHX(ss, 2);
      ss += SHX(ss, 4);
      float rs = rsqrtf(ss * (1.f / 128.f) + EPS);
      int r = R0 + t;
      const u16* pr = proj + (size_t)r * NP;
      u16* ys = (u16*)(ws + O_YS) + (size_t)r * 2048 + 1536 + h * 128 + part * 16;
      const int ch0 = h * 128 + part * 16;
      float dox[16], dgx[16], gn[16];
#pragma unroll
      for (int e = 0; e < 8; ++e) {
        dox[e] = bfs(ldo[0][e]); dox[8 + e] = bfs(ldo[1][e]);
        dgx[e] = bfs(ldg[0][e]); dgx[8 + e] = bfs(ldg[1][e]);
      }
#pragma unroll
      for (int e4 = 0; e4 < 4; ++e4)
#pragma unroll
        for (int e = 0; e < 4; ++e) gn[e4 * 4 + e] = lgn[e4][e];
      float yo[16];
#pragma unroll
      for (int e = 0; e < 16; ++e) {
        float y = hv[e] * rs * gn[e] * sigm_f(dox[e]);
        yo[e] = bf2f(f2bf(y)) * silu_f(dgx[e]);
      }
      st8(ys, yo);
      st8(ys + 8, yo + 8);
    }
  }
}

__device__ void gemm_step(const P& p, int step, int l) {
  OPQ_IDS
  char* ws = opqp(p.ws);
  const int nM = NTOK / 256;
  const bool need_ctx = l < 3;
  int ntiles;
  const int nbr = 1;
  if (step == 1) ntiles = nM * (NP / BNT);
  else if (step == 3) ntiles = nM * (2304 / BNT);
  else if (step == 6) ntiles = 4 * nM * (2048 / BNT);
  else if (step == 7) ntiles = nM * 32;
  else ntiles = nM * (2048 / BNT);
  for (int t0 = BIDX; t0 < (ntiles + 255) / 256 * 256; t0 += gridDim.x) {
    const int t = xcd_remap(t0, BIDX, gridDim.x);
    if (t >= ntiles) continue;
    for (int br = 0; br < nbr; ++br) {
      const u16 *A, *Bt;
      int lda, ldb, K, pm, pn, mode, aux = 0, bmode = 0, ncol = BNT;
      if (step == 1) {
        tile_map(t, nM, NP / BNT, pm, pn);
        A = (const u16*)(ws + O_HN); lda = 2048; Bt = (const u16*)(ws + O_WIN); ldb = 2048; K = 2048; mode = M_G1A;
      } else if (step == 3) {
        const int c2 = 768 / BNT, c3 = 1024 / BNT, c4 = 512 / BNT; const int n2 = nM * c2, n3 = nM * c3;
        K = 512; ldb = 512;
        if (t < n2) {
          pm = t / c2; pn = t % c2; A = (const u16*)(ws + O_PROJ) + C_CQ; lda = NP; Bt = (const u16*)(ws + O_WUQ); mode = M_G2;
        } else if (t < n2 + n3) {
          int tt = t - n2; pm = tt / c3; pn = tt % c3; A = (const u16*)(ws + O_PROJ) + C_CKV; lda = NP; Bt = (const u16*)(ws + O_WUKV); mode = M_G3;
        } else {
          int tt = t - n2 - n3; pm = tt / c4; pn = tt % c4; A = (const u16*)(ws + O_DPOOL); lda = 512; Bt = (const u16*)(ws + O_POOL); mode = M_POOL;
        }
      } else if (step == 6) {
        aux = t / (nM * (2048 / BNT));
        tile_map(t % (nM * (2048 / BNT)), nM, 2048 / BNT, pm, pn);
        A = (const u16*)(ws + O_YS) + aux * 512; lda = 2048; Bt = (const u16*)(ws + O_WBR) + (size_t)aux * 2048 * 512; ldb = 512; K = 512; mode = M_G4;
      } else if (step == 7) {
        tile_map(t, nM, 32, pm, pn);
        A = (const u16*)(ws + O_HN); lda = 2048;
        Bt = (l & 1) ? (const u16*)(ws + O_WINM1) : (const u16*)(ws + O_WIN) + (size_t)C_MG * 2048;
        ldb = 2048; K = 2048; mode = M_G1B; bmode = 1; ncol = 64;
      } else {
        tile_map(t, nM, 2048 / BNT, pm, pn);
        A = (const u16*)(ws + O_ACC); lda = 2048; Bt = (const u16*)(ws + O_WOUT); ldb = 2048; K = 2048; mode = M_G5;
      }
      if (step >= 6 && !need_ctx && (pm % 17) == 0) continue;
      gemm256(p, A, lda, Bt, ldb, K, pm * 256, pn * ncol, mode, aux, l, bmode);
    }
  }
}


#define XB_TMO      128
#define XB_XCNT(j)  (256  + 64 * (j))
#define XB_XSUB(j)  (1280 + 64 * (j))
#define XB_XGEN(j)  (2304 + 64 * (j))
#define XB_TOP      3328
#define XB_TOPGEN   3392
#define XCD_BAR_WORDS 3456
#define XB_SPIN_CAP (1u << 18)
#define LAS __attribute__((address_space(3)))
DEVI unsigned xb_ld(unsigned* p) { return __hip_atomic_load(p, __ATOMIC_RELAXED, __HIP_MEMORY_SCOPE_AGENT); }
DEVI unsigned xb_add(unsigned* p, unsigned v) { return __hip_atomic_fetch_add(p, v, __ATOMIC_RELAXED, __HIP_MEMORY_SCOPE_AGENT); }
DEVI unsigned xb_xcc_id() { return (unsigned)__builtin_amdgcn_s_getreg((3 << 11) | 20) & 0xFu; }
#define XB_SPIN(cond, bar) do { unsigned _sp = 0; while (cond) { __builtin_amdgcn_s_sleep(1); \
    if ((++_sp & 255u) == 0u) { if (xb_ld(&(bar)[XB_TMO])) break; if (_sp > XB_SPIN_CAP) { atomicAdd(&(bar)[XB_TMO], 1u); break; } } } } while (0)
struct XcdBarrier { unsigned* bar; unsigned x; volatile LAS unsigned* st; };
DEVI XcdBarrier xcd_barrier_post(unsigned* bar, volatile LAS unsigned* st) {
  XcdBarrier b; b.bar = bar; b.x = xb_xcc_id(); b.st = st;
  if (threadIdx.x == 0) (void)xb_add(&bar[XB_XCNT(b.x)], 1u);
  return b;
}
DEVI void xcd_barrier_complete(unsigned* bar, unsigned x, unsigned& nloc, unsigned& nx) {
  const unsigned G = gridDim.x * gridDim.y * gridDim.z;
  unsigned sum, cnt, mine, sp = 0u;
  for (;;) {
    sum = 0u; cnt = 0u; mine = 0u;
#pragma unroll
    for (unsigned j = 0; j < 16; ++j) { const unsigned c = xb_ld(&bar[XB_XCNT(j)]); sum += c; cnt += (c > 0u) ? 1u : 0u; mine = (j == x) ? c : mine; }
    if (sum == G) break;
    __builtin_amdgcn_s_sleep(1);
    if ((++sp & 255u) == 0u) { if (xb_ld(&bar[XB_TMO])) break; if (sp > XB_SPIN_CAP) { atomicAdd(&bar[XB_TMO], 1u); break; } }
  }
  nloc = mine > 0u ? mine : 1u; nx = cnt > 0u ? cnt : 1u;
}
DEVI void xcd_barrier(const XcdBarrier& b) {
  asm volatile("s_waitcnt vmcnt(0)" ::: "memory");
  __syncthreads();
  if (threadIdx.x == 0) {
    unsigned* bar = b.bar;
    __builtin_amdgcn_s_waitcnt(0);
    unsigned nloc = b.st[0], nx = b.st[1];
    if (nloc == 0u) { xcd_barrier_complete(bar, b.x, nloc, nx); b.st[0] = nloc; b.st[1] = nx; }
    const unsigned old = xb_add(&bar[XB_XSUB(b.x)], 1u);
    const unsigned gen = old / nloc;
    if (old + 1u == (gen + 1u) * nloc) {
      __builtin_amdgcn_fence(__ATOMIC_RELEASE, "agent");
      asm volatile("s_waitcnt vmcnt(0)" ::: "memory");
      const unsigned og = xb_add(&bar[XB_TOP], 1u);
      const unsigned tg = og / nx;
      if (og + 1u == (tg + 1u) * nx) xb_add(&bar[XB_TOPGEN], 1u);
      else XB_SPIN(xb_ld(&bar[XB_TOPGEN]) == tg, bar);
      __builtin_amdgcn_fence(__ATOMIC_ACQUIRE, "agent");
      xb_add(&bar[XB_XGEN(b.x)], 1u);
      asm volatile("s_waitcnt vmcnt(0)" ::: "memory");
    } else {
      XB_SPIN(xb_ld(&bar[XB_XGEN(b.x)]) == gen, bar);
      __builtin_amdgcn_fence(__ATOMIC_ACQUIRE, "agent");
      asm volatile("s_waitcnt vmcnt(0)" ::: "memory");
    }
  }
  __syncthreads();
}

__global__ void __launch_bounds__(NTHR) mega(P p) {
  cg::grid_group grid = cg::this_grid();
  __shared__ uint4 xb_words;
  unsigned* bar = (unsigned*)(p.ws + O_BAR);
  if (threadIdx.x == 0) xb_words = make_uint4(0u, 0u, 0u, 0u);
  if (blockIdx.x == 0) {
    for (int i = threadIdx.x; i < 4096; i += NTHR) bar[i] = 0u;
  }
  __syncthreads();
  if (PHM & 1) phase_mod_partial(p);
  grid.sync();
  XcdBarrier xb = xcd_barrier_post(bar, (volatile LAS unsigned*)&xb_words);
  if (PHM & 1) phase_mod_reduce(p);
  grid.sync();
  for (int ls2 = 0; ls2 < 36 * 2; ++ls2) {
    const int ls = ls2 >> 1;
    const int l = ls / 9, step = ls % 9;
    if ((ls2 & 1) && !((PROBE_DUP >> step) & 1)) continue;
    if (step == 0) { if (PHM & 4) phase_norm(p, l); }
    if (step == 2) { if (PHM & 8) phase_p2(p, l); }
    if (step == 1 || step == 3 || step >= 6) gemm_step(p, step, l);
    {
      const int bid = blockIdx.x, nb = gridDim.x;
      int wl = -1, wmode = 0, rank = bid, count = nb, mod = 1, lo = 0, width = 1, sub_lo = 0, sub_hi = 0;
      if (!(ls2 & 1)) {
        if (step == 0) { wl = l; wmode = (l == 0) ? 0 : 2; }
        else if ((step == 1 || step == 3 || step == 6) && l < 3 && nb == 256) {
          const int ntl = (step == 1) ? 68 * 29 : (step == 3) ? 68 * 9 : 4 * 68 * 8;
          const int rem = ntl - ((ntl + 255) / 256 - 1) * 256;
          const int pos = (bid & 7) * 32 + (bid >> 3);
          if (pos >= rem) {
            wl = l + 1; wmode = 3; rank = pos - rem; count = 256 - rem;
            sub_lo = (step == 1) ? 0 : (step == 3) ? 1660 : 3000;
            sub_hi = (step == 1) ? 1660 : (step == 3) ? 3000 : 4096;
          }
        }
        else if (step == 7 && l < 3) {
          wl = l + 1; wmode = (nb == 256) ? 1 : 4;
          if (nb == 256) {
            count = 128; mod = 5;
            if ((bid & 7) >= 4) { rank = (bid >> 3) * 4 + (bid & 7) - 4; lo = 4; width = 1; }
            else wl = -1;
          }
        } else if (step == 8 && l < 3 && nb == 256 && (bid & 7) != 0) {
          wl = l + 1; wmode = 1; rank = (bid >> 3) * 7 + (bid & 7) - 1; count = 224; mod = 5; lo = 0; width = 4;
        }
      }
      if (wl >= 0 && (PHM & 2)) phase_wprep(p, wl, wmode, rank, count, mod, lo, width, sub_lo, sub_hi);
    }
    if (step == 3) { if (PHM & 16) phase_m1(p); }
    if (step == 4) {
      if (PHM & 32) phase_m2(p);
      if (PHM & 64) phase_attn(p, l);
    }
    if (step == 5) { if (PHM & 128) phase_m3(p, l); }
    xcd_barrier(xb);
  }
  if (PHM & 4) phase_final(p);
}

extern "C" void kernel_launch(void* const* d_in, const int* in_sizes, int n_in, void* d_out, int out_size, void* d_ws,
                              size_t ws_size, hipStream_t stream) {
  static int grid_blocks = 0;
  if (!grid_blocks) {
    int dev = 0, cus = 0, per_cu = 0;
    hipGetDevice(&dev);
    hipDeviceGetAttribute(&cus, hipDeviceAttributeMultiprocessorCount, dev);
    hipFuncSetAttribute((const void*)mega, hipFuncAttributeMaxDynamicSharedMemorySize, SHM_BYTES);
    hipOccupancyMaxActiveBlocksPerMultiprocessor(&per_cu, mega, NTHR, SHM_BYTES);
    if (per_cu < 1) per_cu = 1;
    grid_blocks = cus * per_cu;
  }
  P p{};
  const float** pp = (const float**)&p;
  for (int i = 0; i < 21; ++i) pp[i] = (const float*)d_in[i];
  p.out = (float*)d_out;
  p.ws = (char*)d_ws;
  if (ws_size < O_TOTAL) fprintf(stderr, "workspace too small: %zu < %zu\n", ws_size, (size_t)O_TOTAL);
  void* args[] = {&p};
  hipError_t e = hipLaunchCooperativeKernel((void*)mega, dim3(grid_blocks), dim3(NTHR), args, SHM_BYTES, stream);
  if (e != hipSuccess) fprintf(stderr, "cooperative launch failed: %s (grid %d)\n", hipGetErrorString(e), grid_blocks);
}
```

```cpp
#include <hip/hip_runtime.h>
#include <hip/hip_bf16.h>
#include <hip/hip_cooperative_groups.h>
#include <cstdio>
namespace cg = cooperative_groups;

typedef unsigned short u16;
using bf16x8 = __attribute__((ext_vector_type(8))) short;
using bf16x4 = __attribute__((ext_vector_type(4))) short;
using f32x4 = __attribute__((ext_vector_type(4))) float;
typedef unsigned u32x4 __attribute__((ext_vector_type(4)));
#define DEVI __device__ __forceinline__

constexpr int D = 2048, NBATCH = 4, SEQ = 4096, CTXL = 256, TPB = 4352, NTOK = 17408, DIN = 15440, NP = 7424;
constexpr int C_AQ = 0, C_AK = 512, C_AV = 1024, C_AG = 1536, C_BI = 2048, C_BG = 2560, C_CQ = 3072, C_CKV = 3584,
              C_CKR = 4096, C_CG = 4160, C_DQ = 4672, C_DK = 5184, C_DV = 5696, C_DO = 6208, C_DIF = 6720,
              C_DG = 6736, C_MG = 7248;
constexpr float EPS = 1e-6f;
constexpr int NTHR = 512;
#ifndef PROBE_ZB
#define PROBE_ZB (-1)
#endif
#ifndef PROBE_US
#define PROBE_US 1.f
#endif
#ifndef G8
#define G8 1
#endif
#define BNT (G8 ? 256 : 128)
#ifndef PROBE_DUP
#define PROBE_DUP 0
#endif
#ifndef PHM
#define PHM 0xFFFF
#endif
constexpr int SHM_BYTES = 131072;

constexpr size_t al(size_t x) { return (x + 255) & ~size_t(255); }
constexpr size_t O_WIN = 0;
constexpr size_t O_WBR = O_WIN + al((size_t)DIN * 2048 * 2);
constexpr size_t O_WOUT = O_WBR + al((size_t)4 * 2048 * 512 * 2);
constexpr size_t O_WUQ = O_WOUT + al((size_t)2048 * 2048 * 2);
constexpr size_t O_WUKV = O_WUQ + al((size_t)768 * 512 * 2);
constexpr size_t O_POOL = O_WUKV + al((size_t)1024 * 512 * 2);
constexpr size_t O_MODP = O_POOL + al((size_t)512 * 512 * 2);
constexpr size_t O_MOD = O_MODP + al((size_t)4 * 16 * 5 * 6144 * 4);
constexpr size_t O_ROPE = O_MOD + al((size_t)4 * 5 * 6144 * 4);
constexpr size_t O_XC = O_ROPE + al(64 * 16 * 8);
constexpr size_t O_HN = O_XC + al((size_t)1024 * 2048 * 4);
constexpr size_t O_PROJ = O_HN + al((size_t)NTOK * 2048 * 2);
constexpr size_t O_QH = O_PROJ + al((size_t)NTOK * NP * 2);
constexpr size_t O_KH = O_QH + al((size_t)NTOK * 768 * 2);
constexpr size_t O_VTC = O_KH + al((size_t)NTOK * 768 * 2);
constexpr size_t O_END1 = O_VTC + al((size_t)NTOK * 512 * 2);
constexpr size_t O_YBR = O_PROJ;
static_assert((size_t)NTOK * 8192 * 2 <= O_END1 - O_PROJ, "ybr alias");
constexpr size_t O_VTA = O_END1;
constexpr size_t O_DPOOL = O_VTA + al((size_t)NTOK * 512 * 2);
constexpr size_t O_QKC = O_DPOOL + al((size_t)NTOK * 512 * 2);
constexpr size_t O_GL = O_QKC + al((size_t)NTOK * 1024 * 2);
constexpr size_t O_RINV = O_GL + al((size_t)NTOK * 16 * 4);
constexpr size_t O_YS = O_RINV + al((size_t)NTOK * 2 * 4);
constexpr size_t O_ACC = O_YS + al((size_t)NTOK * 2048 * 2);
constexpr int NITEM = 32 * 68;
constexpr size_t O_KLOC = O_ACC + al((size_t)NTOK * 2048 * 2);
constexpr size_t O_NLOC = O_KLOC + al((size_t)NITEM * 16384 * 4);
constexpr size_t O_SC = O_NLOC + al((size_t)NITEM * 128 * 4);
constexpr size_t O_CIN = O_SC + al((size_t)NITEM * 2 * 4);
constexpr size_t O_NIN = O_CIN + al((size_t)NITEM * 16384 * 2);
constexpr size_t O_MIN = O_NIN + al((size_t)NITEM * 128 * 4);
constexpr size_t O_WINM1 = O_MIN + al((size_t)NITEM * 4);
constexpr size_t O_BAR = O_WINM1 + al((size_t)8192 * 2048 * 2);
constexpr size_t O_TOTAL = O_BAR + al(4096 * 4);
static_assert(O_TOTAL < 1000000000ull, "workspace budget");

struct P {
  const float *x, *c, *ctx, *c_ctx, *norm_g, *w_mod, *b_mod, *w_in, *na_rpb, *pool_w, *pool_scale, *mla_gq, *mla_gkv,
      *w_uq, *w_ukv, *conv_w, *b_if, *ml_gnorm, *w_br, *w_out, *g_final;
  float* out;
  char* ws;
};

extern __shared__ __attribute__((aligned(16))) char shm[];

DEVI u16 f2bf(float f) {
  unsigned u = __float_as_uint(f);
  u += 0x7fffu + ((u >> 16) & 1u);
  return (u16)(u >> 16);
}
typedef __bf16 bf2_t __attribute__((ext_vector_type(2)));
typedef float fl2_t __attribute__((ext_vector_type(2)));
DEVI unsigned pk2(float a, float b) {
  fl2_t v = {a, b};
  bf2_t r = __builtin_convertvector(v, bf2_t);
  return *(unsigned*)&r;
}
DEVI float bf2f(u16 h) { return __uint_as_float(((unsigned)h) << 16); }
DEVI float bfs(short h) { return __uint_as_float(((unsigned)(u16)h) << 16); }
DEVI float silu_f(float x) { return x / (1.f + __expf(-x)); }
DEVI float sigm_f(float x) { return 1.f / (1.f + __expf(-x)); }
DEVI int opqv(int x) { asm volatile("" : "+v"(x)); return x; }
DEVI int opqs(int x) { asm volatile("" : "+s"(x)); return x; }
DEVI size_t opqz() { size_t z = 0; asm volatile("" : "+s"(z)); return z; }
#define opqp(x) ((x) + opqz())
#define SHX(v, m) __int_as_float(__builtin_amdgcn_ds_bpermute(((LANE ^ (m)) << 2), __float_as_int(v)))
#define LDS_BAR() do { asm volatile("s_waitcnt lgkmcnt(0)" ::: "memory"); __builtin_amdgcn_s_barrier(); asm volatile("" ::: "memory"); } while (0)
#define OPQ_IDS const int TIDX = opqv((int)threadIdx.x); const int BIDX = opqs((int)blockIdx.x); const int LANE = TIDX & 63; (void)TIDX; (void)BIDX; (void)LANE;
#define wave_sum(v) wave_sum_l((v), LANE)
DEVI float wave_sum_l(float v, int LANE) {
#pragma unroll
  for (int o = 32; o > 0; o >>= 1) v += SHX(v, o);
  return v;
}

DEVI void ld8(const u16* ptr, float* f) {
  bf16x8 v = *(const bf16x8*)ptr;
#pragma unroll
  for (int i = 0; i < 8; ++i) f[i] = bfs(v[i]);
}
DEVI void st8(u16* ptr, const float* f) {
  bf16x8 v;
#pragma unroll
  for (int i = 0; i < 8; ++i) v[i] = (short)f2bf(f[i]);
  *(bf16x8*)ptr = v;
}
constexpr int BM = 256, BK = 64, HALF = 128, HT = HALF * BK;

DEVI int lds_byte(int r, int c) {
  int st = (r >> 4) * 2 + (c >> 5), rr = r & 15, cc = c & 31, ob = rr * 64 + cc * 2;
  return st * 1024 + (ob ^ (((ob >> 9) & 1) << 5));
}
DEVI void stage_rc(int b, int& R, int& C) {
  int st = b / 1024, sb = b % 1024, swz = sb ^ (((sb >> 9) & 1) << 5);
  R = (st >> 1) * 16 + swz / 64;
  C = (st & 1) * 32 + (swz % 64) / 2;
}

enum { M_G1A = 0, M_G2, M_G3, M_POOL, M_G4, M_G1B, M_G5 };

DEVI void gemm256(const P& p, const u16* A, int lda, const u16* Bt, int ldb, int K, int brow, int bcol, int mode,
                        int aux, int layer, int bmode) {
  OPQ_IDS
  if (!(PHM & 256)) return;
  u16* shmb = (u16*)shm;
#define SA(b, h) (shmb + ((b)*2 + (h)) * HT)
#if G8
#define SB(b, h) (shmb + (4 + (b)*2 + (h)) * HT)
#else
#define SB(b, h) (shmb + (4 + (b)) * HT)
#endif
#define LDSP(x) ((__attribute__((address_space(3))) void*)(x))
#define STAGEA(Pp, br, kt)                                                                                     \
  do {                                                                                                         \
    const int _so = ((br) * lda + (kt)*BK) * 2;                                                                \
    __builtin_amdgcn_raw_ptr_buffer_load_lds(rsA, LDSP((char*)(Pp) + TIDX * 16), 16, offA0, _so, 0, 0);       \
    __builtin_amdgcn_raw_ptr_buffer_load_lds(rsA, LDSP((char*)(Pp) + TIDX * 16 + 8192), 16, offA1, _so, 0, 0);\
  } while (0)
#define STAGEB(Pp, br, kt)                                                                                     \
  do {                                                                                                         \
    const int _so = ((br) * ldb + (kt)*BK) * 2;                                                                \
    __builtin_amdgcn_raw_ptr_buffer_load_lds(rsB, LDSP((char*)(Pp) + TIDX * 16), 16, offB0, _so, 0, 0);       \
    __builtin_amdgcn_raw_ptr_buffer_load_lds(rsB, LDSP((char*)(Pp) + TIDX * 16 + 8192), 16, offB1, _so, 0, 0);\
  } while (0)
#define LDA(dst, b, h)                                                                                         \
  for (int m = 0; m < 4; ++m)                                                                                  \
    for (int k = 0; k < 2; ++k)                                                                                \
  dst[m][k] = *reinterpret_cast<const bf16x8*>((char*)SA(b, h) + lds_byte(wr * 64 + m * 16 + fr, k * 32 + fq * 8))
#define LDB(dst, b, h)                                                                                         \
  for (int n = 0; n < 2; ++n)                                                                                  \
    for (int k = 0; k < 2; ++k)                                                                                \
  dst[n][k] = *reinterpret_cast<const bf16x8*>((char*)SB(b, h) + lds_byte(wc * 32 + n * 16 + fr, k * 32 + fq * 8))
#define MMA(ai, bj, At, Btf)                                                                                   \
  do {                                                                                                         \
    __builtin_amdgcn_s_setprio(1);                                                                             \
    for (int m = 0; m < 4; ++m)                                                                                \
      for (int n = 0; n < 2; ++n)                                                                              \
        for (int k = 0; k < 2; ++k)                                                                            \
          acc[ai][bj][m][n] = __builtin_amdgcn_mfma_f32_16x16x32_bf16(Btf[n][k], At[m][k], acc[ai][bj][m][n], 0, 0, 0); \
    __builtin_amdgcn_s_setprio(0);                                                                             \
  } while (0)
#define WAIT_V(n) asm volatile("s_waitcnt vmcnt(" #n ")" ::: "memory")
#define WAIT_L(n) asm volatile("s_waitcnt lgkmcnt(" #n ")" ::: "memory")
#define BAR __builtin_amdgcn_s_barrier()
#define SCHED __builtin_amdgcn_sched_barrier(0)

  int wid = TIDX >> 6, lane = TIDX & 63, wr = wid >> 2, wc = wid & 3, fr = lane & 15, fq = lane >> 4;
#if G8
  f32x4 acc[2][2][4][2] = {};
  bf16x8 At[4][2], B0[2][2], B1[2][2];
#else
  f32x4 acc[2][1][4][2] = {};
  bf16x8 At[4][2], B0[2][2];
#endif
  int nt = K / BK;
  const int bhalf = bmode ? 4096 : HALF;
  int offA0, offA1, offB0, offB1;
  __amdgpu_buffer_rsrc_t rsA = __builtin_amdgcn_make_buffer_rsrc((void*)A, 0, 0x7fffffff, 0x00020000);
  __amdgpu_buffer_rsrc_t rsB = __builtin_amdgcn_make_buffer_rsrc((void*)Bt, 0, 0x7fffffff, 0x00020000);
  {
    int r0, c0, r1, c1;
    stage_rc(TIDX * 16, r0, c0);
    stage_rc(TIDX * 16 + 8192, r1, c1);
    offA0 = (r0 * lda + c0) * 2; offA1 = (r1 * lda + c1) * 2;
    offB0 = (r0 * ldb + c0) * 2; offB1 = bmode ? offB0 + 2048 * ldb * 2 : (r1 * ldb + c1) * 2;
  }
#if G8
  STAGEB(SB(0, 0), bcol, 0);
  STAGEA(SA(0, 0), brow, 0);
  STAGEB(SB(0, 1), bcol + bhalf, 0);
  STAGEA(SA(0, 1), brow + HALF, 0);
  if (wr == 1) BAR;
  WAIT_V(4);
  BAR;
  STAGEB(SB(1, 0), bcol, 1);
  STAGEA(SA(1, 0), brow, 1);
  STAGEB(SB(1, 1), bcol + bhalf, 1);
  WAIT_V(6);
  BAR;
  for (int t = 0; t < nt - 2; t += 2) {
    LDB(B0, 0, 0); SCHED; LDA(At, 0, 0); STAGEA(SA(1, 1), brow + HALF, t + 1);
    WAIT_L(8); BAR; WAIT_L(0); MMA(0, 0, At, B0); BAR; SCHED;
    LDB(B1, 0, 1); STAGEB(SB(0, 0), bcol, t + 2);
    BAR; WAIT_L(0); MMA(0, 1, At, B1); BAR;
    LDA(At, 0, 1); STAGEA(SA(0, 0), brow, t + 2);
    BAR; WAIT_L(0); MMA(1, 0, At, B0); BAR; SCHED;
    STAGEB(SB(0, 1), bcol + bhalf, t + 2);
    WAIT_V(6); BAR; MMA(1, 1, At, B1); BAR;
    LDB(B0, 1, 0); SCHED; LDA(At, 1, 0); STAGEA(SA(0, 1), brow + HALF, t + 2);
    WAIT_L(8); BAR; WAIT_L(0); MMA(0, 0, At, B0); BAR; SCHED;
    LDB(B1, 1, 1); STAGEB(SB(1, 0), bcol, t + 3);
    BAR; WAIT_L(0); MMA(0, 1, At, B1); BAR;
    LDA(At, 1, 1); STAGEA(SA(1, 0), brow, t + 3);
    BAR; WAIT_L(0); MMA(1, 0, At, B0); BAR; SCHED;
    STAGEB(SB(1, 1), bcol + bhalf, t + 3);
    WAIT_V(6); BAR; MMA(1, 1, At, B1); BAR;
  }
  {
    LDB(B0, 0, 0); LDA(At, 0, 0); STAGEA(SA(1, 1), brow + HALF, nt - 1);
    BAR; WAIT_L(0); MMA(0, 0, At, B0); BAR;
    LDB(B1, 0, 1); BAR; WAIT_L(0); MMA(0, 1, At, B1); BAR;
    LDA(At, 0, 1); WAIT_V(4); BAR; WAIT_L(0); MMA(1, 0, At, B0); MMA(1, 1, At, B1); BAR;
  }
  {
    LDB(B0, 1, 0); LDA(At, 1, 0); WAIT_V(2); BAR; WAIT_L(0); MMA(0, 0, At, B0); BAR;
    LDB(B1, 1, 1); WAIT_V(0); BAR; WAIT_L(0); MMA(0, 1, At, B1); BAR;
    LDA(At, 1, 1); BAR; WAIT_L(0); MMA(1, 0, At, B0); MMA(1, 1, At, B1); BAR;
  }
  if (wr == 0) BAR;
#else
  STAGEB(SB(0, 0), bcol, 0);
  STAGEA(SA(0, 0), brow, 0);
  STAGEA(SA(0, 1), brow + HALF, 0);
  WAIT_V(0);
  BAR;
  for (int t = 0; t < nt; t += 2) {
    STAGEB(SB(1, 0), bcol, t + 1);
    STAGEA(SA(1, 0), brow, t + 1);
    STAGEA(SA(1, 1), brow + HALF, t + 1);
    LDB(B0, 0, 0); LDA(At, 0, 0); WAIT_L(0); MMA(0, 0, At, B0);
    LDA(At, 0, 1); WAIT_L(0); MMA(1, 0, At, B0);
    WAIT_V(0);
    BAR;
    if (t + 2 < nt) {
      STAGEB(SB(0, 0), bcol, t + 2);
      STAGEA(SA(0, 0), brow, t + 2);
      STAGEA(SA(0, 1), brow + HALF, t + 2);
    }
    LDB(B0, 1, 0); LDA(At, 1, 0); WAIT_L(0); MMA(0, 0, At, B0);
    LDA(At, 1, 1); WAIT_L(0); MMA(1, 0, At, B0);
    WAIT_V(0);
    BAR;
  }
#endif
  char* ws = opqp(p.ws);
  const int bb = brow / TPB;
  const int trow = brow - bb * TPB;
  u16* stg = (u16*)shm;
  const int tid = TIDX;
#define SWZ(r, c) ((c) ^ ((r)&15) ^ (((c)&1) << 4))
#pragma unroll
  for (int ai = 0; ai < 2; ++ai)
#pragma unroll
    for (int bj = 0; bj < (G8 ? 2 : 1); ++bj)
#pragma unroll
      for (int m = 0; m < 4; ++m)
#pragma unroll
        for (int n = 0; n < 2; ++n) {
          const int R = ai * HALF + wr * 64 + m * 16 + fr;
          const int chunk = bj * 16 + wc * 4 + n * 2 + (fq >> 1);
          f32x4 v = acc[ai][bj][m][n];
          uint2 pk = make_uint2(pk2(v[0], v[1]), pk2(v[2], v[3]));
          *(uint2*)(stg + R * 256 + SWZ(R, chunk) * 8 + (fq & 1) * 4) = pk;
        }
  LDS_BAR();
  if (mode == M_G1B) {
#pragma unroll 1
    for (int it = 0; it < 4; ++it) {
      const int R = it * 64 + (tid >> 3), co = tid & 7;
      const int row = brow + R, ocol = bcol + co * 8;
      float sum[8] = {0, 0, 0, 0, 0, 0, 0, 0};
#pragma unroll
      for (int br = 0; br < 4; ++br) {
        const int c = br * 8 + co;
        bf16x8 g = *(const bf16x8*)(stg + R * 256 + SWZ(R, c) * 8);
        float yb[8];
        ld8((const u16*)(ws + O_YBR) + (size_t)row * 8192 + br * 2048 + ocol, yb);
#pragma unroll
        for (int e = 0; e < 8; ++e) sum[e] += (br == PROBE_ZB) ? 0.f : sigm_f(bfs(g[e])) * yb[e];
      }
      st8((u16*)(ws + O_ACC) + (size_t)row * 2048 + ocol, sum);
    }
  } else {
    bool tr0 = false, tr1 = false;
    if (mode == M_G1A) { tr0 = bcol >= C_AV && bcol < C_AG; tr1 = bcol + HALF >= C_AV && bcol + HALF < C_AG; }
    else if (mode == M_G3) { tr1 = true; }
#pragma unroll 4
    for (int it = 0; it < 16; ++it) {
      const int R = it * 16 + (tid >> 5), c = tid & 31;
      if ((c < 16) ? tr0 : tr1) continue;
      const int row = brow + R, col = bcol + c * 8;
      bf16x8 raw = *(const bf16x8*)(stg + R * 256 + SWZ(R, c) * 8);
      if (mode == M_G1A) {
        *(bf16x8*)((u16*)(ws + O_PROJ) + (size_t)row * NP + col) = raw;
      } else if (mode == M_G4) {
        *(bf16x8*)((u16*)(ws + O_YBR) + (size_t)row * 8192 + aux * 2048 + col) = raw;
      } else {
        float v[8];
#pragma unroll
        for (int e = 0; e < 8; ++e) v[e] = bfs(raw[e]);
        if (mode == M_G2) {
          float rs = ((const float*)(ws + O_RINV))[row * 2];
#pragma unroll
          for (int e = 0; e < 8; ++e) v[e] *= rs;
          st8((u16*)(ws + O_QH) + (size_t)row * 768 + col, v);
        } else if (mode == M_G3) {
          float rs = ((const float*)(ws + O_RINV))[row * 2 + 1];
#pragma unroll
          for (int e = 0; e < 8; ++e) v[e] *= rs;
          st8((u16*)(ws + O_KH) + ((size_t)(bb * 4 + (col >> 8)) * TPB + (trow + R)) * 192 + (col & 255), v);
        } else if (mode == M_POOL) {
          float g[8];
          ld8((const u16*)(ws + O_PROJ) + (size_t)row * NP + C_BG + col, g);
#pragma unroll
          for (int e = 0; e < 8; ++e) {
            float y = bf2f(f2bf(v[e] * p.pool_scale[layer * 512 + col + e]));
            v[e] = y * silu_f(g[e]);
          }
          st8((u16*)(ws + O_YS) + (size_t)row * 2048 + 512 + col, v);
        } else {
          float* xb;
          const float* gv;
          const float* xs;
          if (trow == 0) {
            xb = (float*)(ws + O_XC) + ((size_t)bb * CTXL + R) * D + col;
            xs = (layer == 0) ? p.ctx + ((size_t)bb * CTXL + R) * D + col : xb;
            gv = (const float*)(ws + O_MOD) + ((size_t)layer * 5 + 4) * 6144 + 4096 + col;
          } else {
            xb = p.out + ((size_t)bb * SEQ + (trow - CTXL) + R) * D + col;
            xs = (layer == 0) ? p.x + ((size_t)bb * SEQ + (trow - CTXL) + R) * D + col : xb;
            gv = (const float*)(ws + O_MOD) + ((size_t)layer * 5 + bb) * 6144 + 4096 + col;
          }
          f32x4 x0 = *(const f32x4*)xs, x1 = *(const f32x4*)(xs + 4);
          f32x4 g0 = *(const f32x4*)gv, g1 = *(const f32x4*)(gv + 4);
#pragma unroll
          for (int e = 0; e < 4; ++e) { x0[e] += PROBE_US * g0[e] * v[e]; x1[e] += PROBE_US * g1[e] * v[4 + e]; }
          *(f32x4*)xb = x0;
          *(f32x4*)(xb + 4) = x1;
        }
      }
    }
#pragma unroll 1
    for (int hj = 0; hj < 2; ++hj) {
      if (!(hj ? tr1 : tr0)) continue;
      const int gc = bcol + hj * HALF;
      u16* tdst;
      if (mode == M_G1A) tdst = (u16*)(ws + O_VTA) + ((size_t)(bb * 512 + (gc - C_AV))) * TPB + trow;
      else tdst = (u16*)(ws + O_VTC) + ((size_t)((bb * 4 + (gc >> 8)) * 128)) * TPB + trow;
      const int cl = tid & 127, rg = tid >> 7;
      const int ct = hj * HALF + cl;
#pragma unroll 1
      for (int i = 0; i < 8; ++i) {
        const int r0 = rg * 64 + i * 8;
        float v[8], rs8[8];
        if (mode == M_G3) {
          const f32x4* rp = (const f32x4*)((const float*)(ws + O_RINV) + (size_t)(brow + r0) * 2);
          const f32x4 q0 = rp[0], q1 = rp[1], q2 = rp[2], q3 = rp[3];
          rs8[0] = q0[1]; rs8[1] = q0[3]; rs8[2] = q1[1]; rs8[3] = q1[3];
          rs8[4] = q2[1]; rs8[5] = q2[3]; rs8[6] = q3[1]; rs8[7] = q3[3];
        } else {
#pragma unroll
          for (int e = 0; e < 8; ++e) rs8[e] = 1.f;
        }
#pragma unroll
        for (int e = 0; e < 8; ++e) {
          const int r = r0 + e;
          v[e] = bf2f(stg[r * 256 + SWZ(r, ct >> 3) * 8 + (ct & 7)]) * rs8[e];
        }
        st8(tdst + (size_t)cl * TPB + r0, v);
      }
    }
  }
  LDS_BAR();
#undef SWZ
}

DEVI int xcd_remap(int t, int bid, int nblk) {
  if (nblk != 256) return t;
  int r = t / 256;
  return r * 256 + (bid & 7) * 32 + (bid >> 3);
}
DEVI void tile_map(int v, int nM, int nN, int& pm, int& pn) {
  int per = 4 * nN, band = v / per, idx = v % per;
  pm = band * 4 + (idx & 3);
  pn = idx >> 2;
}

struct WItem {
  const float* src; const float* kscale; u16* dst;
  int ldsrc, K, N, k0, n0, kind;
};
DEVI WItem wdecode(const P& p, char* ws, int l, int t, int tend, u16* wmerge) {
  constexpr int T_WIN1 = 32 * 114, T_WIN2 = 32 * 128, T_WBR = 4 * 8 * 32, T_WUQ = 8 * 12, T_WUKV = 8 * 16, T_POOL = 64;
  WItem w;
  w.kscale = nullptr; w.kind = 0; w.src = nullptr; w.dst = nullptr; w.ldsrc = 0; w.K = 0; w.N = 0; w.k0 = 0; w.n0 = 0;
  if (t >= tend) { w.kind = -1; return w; }
  int i = t;
  if (i < T_WIN1) {
    w.src = p.w_in + (size_t)l * 2048 * DIN; w.ldsrc = DIN; w.K = 2048; w.N = C_MG; w.dst = (u16*)(ws + O_WIN);
    w.k0 = (i & 31) * 64; w.n0 = (i >> 5) * 64; return w;
  }
  i -= T_WIN1;
  if (i < T_WIN2) {
    w.src = p.w_in + (size_t)l * 2048 * DIN + C_MG; w.ldsrc = DIN; w.K = 2048; w.N = 8192; w.dst = wmerge;
    w.k0 = (i & 31) * 64; w.n0 = (i >> 5) * 64; return w;
  }
  i -= T_WIN2;
  if (i < T_WBR) {
    int br = i >> 8, r = i & 255;
    w.src = p.w_br + ((size_t)l * 4 + br) * 512 * 2048; w.ldsrc = 2048; w.K = 512; w.N = 2048;
    w.dst = (u16*)(ws + O_WBR) + (size_t)br * 2048 * 512; w.k0 = (r & 7) * 64; w.n0 = (r >> 3) * 64; return w;
  }
  i -= T_WBR;
  if (i < T_WUQ) {
    w.src = p.w_uq + (size_t)l * 512 * 768; w.ldsrc = 768; w.K = 512; w.N = 768; w.dst = (u16*)(ws + O_WUQ);
    w.kscale = p.mla_gq + l * 512; w.k0 = (i & 7) * 64; w.n0 = (i >> 3) * 64; return w;
  }
  i -= T_WUQ;
  if (i < T_WUKV) {
    w.src = p.w_ukv + (size_t)l * 512 * 1024; w.ldsrc = 1024; w.K = 512; w.N = 1024; w.dst = (u16*)(ws + O_WUKV);
    w.kscale = p.mla_gkv + l * 512; w.k0 = (i & 7) * 64; w.n0 = (i >> 3) * 64; return w;
  }
  i -= T_WUKV;
  if (i < T_POOL) { w.kind = 1; w.n0 = i; return w; }
  i -= T_POOL;
  w.src = p.w_out + (size_t)l * 2048 * 2048; w.ldsrc = 2048; w.K = 2048; w.N = 2048; w.dst = (u16*)(ws + O_WOUT);
  w.k0 = (i & 31) * 64; w.n0 = (i >> 5) * 64;
  return w;
}
DEVI void wload(const WItem& w, float4 (&v)[2], int tid) {
#pragma unroll
  for (int it = 0; it < 2; ++it) {
    int i = tid + it * NTHR, tr = i >> 4, c4 = (i & 15) * 4;
    float4 x = make_float4(0.f, 0.f, 0.f, 0.f);
    if (w.n0 + c4 < w.N) x = *(const float4*)(w.src + (size_t)(w.k0 + tr) * w.ldsrc + w.n0 + c4);
    if (w.kscale) { float sc = w.kscale[w.k0 + tr]; x.x *= sc; x.y *= sc; x.z *= sc; x.w *= sc; }
    v[it] = x;
  }
}

__device__ void phase_wprep(const P& p, int l, int wmode, int rank, int count, int mod, int lo, int width, int sub_lo,
                            int sub_hi) {
  OPQ_IDS
  char* ws = opqp(p.ws);
  constexpr int T_W1 = 32 * 114, T_W2 = 32 * 128;
  constexpr int T_A = T_W1 + T_W2 + 4 * 8 * 32 + 8 * 12 + 8 * 16 + 64, T_WOUT = 32 * 32;
  const int ubeg = (wmode == 2) ? T_A : (wmode == 3) ? sub_lo : 0;
  const int uend = (wmode == 1) ? T_A - T_W2 : (wmode == 3) ? sub_hi : (wmode == 4) ? T_A : T_A + T_WOUT;
  const int tend = T_A + T_WOUT;
#define WMAP(u) ((u) >= uend ? tend : (wmode == 1) ? ((u) < T_W1 ? (u) : (u) + T_W2) : (wmode == 3) ? T_W1 + (u) : (u))
  u16* wmerge = (l & 1) ? (u16*)(ws + O_WINM1) : (u16*)(ws + O_WIN) + (size_t)C_MG * 2048;
  float* tiles = (float*)shm;
  int g = rank, par = 0;
  WItem cur = wdecode(p, ws, l, WMAP(ubeg + (g / width) * mod + lo + g % width), tend, wmerge);
  float4 v[2] = {make_float4(0.f, 0.f, 0.f, 0.f), make_float4(0.f, 0.f, 0.f, 0.f)};
  __syncthreads();
  if (cur.kind == 0) wload(cur, v, TIDX);
  while (cur.kind >= 0) {
    g += count;
    WItem nxt = wdecode(p, ws, l, WMAP(ubeg + (g / width) * mod + lo + g % width), tend, wmerge);
    float4 vn[2] = {make_float4(0.f, 0.f, 0.f, 0.f), make_float4(0.f, 0.f, 0.f, 0.f)};
    if (nxt.kind == 0) wload(nxt, vn, TIDX);
    if (cur.kind == 0) {
      float* tile = tiles + par * (64 * 65);
      par ^= 1;
#pragma unroll
      for (int it = 0; it < 2; ++it) {
        int i = TIDX + it * NTHR, tr = i >> 4, c4 = (i & 15) * 4;
        float* tp = tile + tr * 65 + c4;
        tp[0] = v[it].x; tp[1] = v[it].y; tp[2] = v[it].z; tp[3] = v[it].w;
      }
      __syncthreads();
      int tn = TIDX & 63, tk = (TIDX >> 6) * 8;
      if (cur.n0 + tn < cur.N) {
        bf16x8 o;
#pragma unroll
        for (int e = 0; e < 8; ++e) o[e] = (short)f2bf(tile[(tk + e) * 65 + tn]);
        *(bf16x8*)(cur.dst + (size_t)(cur.n0 + tn) * cur.K + cur.k0 + tk) = o;
      }
    } else {
      u16* dst = (u16*)(ws + O_POOL);
      for (int e = TIDX; e < 4096; e += NTHR) {
        int idx = cur.n0 * 4096 + e, n = idx >> 9, k = idx & 511;
        int gg = n >> 7, g2 = k >> 7;
        float x = 0.f;
        if (gg == g2) x = p.pool_w[(((size_t)l * 4 + gg) * 128 + (k & 127)) * 128 + (n & 127)];
        dst[idx] = f2bf(x);
      }
    }
    cur = nxt;
    v[0] = vn[0];
    v[1] = vn[1];
  }
  __syncthreads();
}
#undef WMAP

__device__ void phase_mod_partial(const P& p) {
  OPQ_IDS
  float* sl = (float*)shm;
  float* modp = (float*)(p.ws + O_MODP);
  for (int t = BIDX; t < 4 * 24 * 16; t += gridDim.x) {
    int l = t / 384, r = t % 384, nb = r / 16, ks = r % 16;
    __syncthreads();
    for (int i = TIDX; i < 640; i += NTHR) {
      int v = i >> 7, k = i & 127;
      float cv = (v < 4) ? p.c[v * 2048 + ks * 128 + k] : p.c_ctx[ks * 128 + k];
      sl[i] = silu_f(cv);
    }
    __syncthreads();
    int col = TIDX & 255, kh = TIDX >> 8;
    float a[5] = {0, 0, 0, 0, 0};
    const float* w = p.w_mod + ((size_t)l * 2048 + ks * 128 + kh * 64) * 6144 + nb * 256 + col;
#pragma unroll 4
    for (int k = 0; k < 64; ++k) {
      float wv = w[(size_t)k * 6144];
#pragma unroll
      for (int v = 0; v < 5; ++v) a[v] += sl[v * 128 + kh * 64 + k] * wv;
    }
    __syncthreads();
    float* part = sl + 1024;
    if (kh == 1) {
#pragma unroll
      for (int v = 0; v < 5; ++v) part[v * 256 + col] = a[v];
    }
    __syncthreads();
    if (kh == 0) {
#pragma unroll
      for (int v = 0; v < 5; ++v)
        modp[(((size_t)l * 16 + ks) * 5 + v) * 6144 + nb * 256 + col] = a[v] + part[v * 256 + col];
    }
  }
  float2* rt = (float2*)(p.ws + O_ROPE);
  for (int i = BIDX * NTHR + TIDX; i < 1024; i += gridDim.x * NTHR) {
    int pos = i >> 4, j = i & 15;
    float inv = powf(10000.f, -(float)j / 16.f);
    float ang = (float)pos * inv;
    rt[i] = make_float2(cosf(ang), sinf(ang));
  }
}
__device__ void phase_mod_reduce(const P& p) {
  OPQ_IDS
  const float* modp = (const float*)(p.ws + O_MODP);
  float* mod = (float*)(p.ws + O_MOD);
  for (int i = BIDX * NTHR + TIDX; i < 4 * 5 * 6144; i += gridDim.x * NTHR) {
    int l = i / 30720, r = i % 30720, n = r % 6144;
    float s = p.b_mod[l * 6144 + n];
    for (int ks = 0; ks < 16; ++ks) s += modp[((size_t)l * 16 + ks) * 30720 + r];
    mod[i] = s;
  }
}

DEVI float* xrow_ptr(const P& p, int r) {
  int b = r / TPB, t = r - b * TPB;
  return (t < CTXL) ? (float*)(p.ws + O_XC) + ((size_t)b * CTXL + t) * D : p.out + ((size_t)b * SEQ + (t - CTXL)) * D;
}
__device__ void phase_norm(const P& p, int l) {
  OPQ_IDS
  int lane = TIDX & 63, gw = BIDX * 8 + (TIDX >> 6), nw = gridDim.x * 8;
  const float* mod = (const float*)(p.ws + O_MOD);
  u16* hn = (u16*)(p.ws + O_HN);
  float4 g[8];
#pragma unroll
  for (int i = 0; i < 8; ++i) g[i] = *(const float4*)(p.norm_g + l * D + i * 256 + lane * 4);
  for (int r = gw; r < NTOK; r += nw) {
    int b = r / TPB, t = r - b * TPB;
    float* xr = xrow_ptr(p, r);
    const float* src = xr;
    if (l == 0) src = (t < CTXL) ? p.ctx + ((size_t)b * CTXL + t) * D : p.x + ((size_t)b * SEQ + (t - CTXL)) * D;
    const float* mv = mod + ((size_t)l * 5 + (t < CTXL ? 4 : b)) * 6144;
    float4 v[8], sh[8], sc[8];
#pragma unroll
    for (int i = 0; i < 8; ++i) {
      const int c0 = i * 256 + lane * 4;
      v[i] = *(const float4*)(src + c0);
      sh[i] = *(const float4*)(mv + c0);
      sc[i] = *(const float4*)(mv + 2048 + c0);
    }
    float ss = 0.f;
#pragma unroll
    for (int i = 0; i < 8; ++i) ss += v[i].x * v[i].x + v[i].y * v[i].y + v[i].z * v[i].z + v[i].w * v[i].w;
    ss = wave_sum(ss);
    float rs = rsqrtf(ss * (1.f / D) + EPS);
#pragma unroll
    for (int i = 0; i < 8; ++i) {
      int c0 = i * 256 + lane * 4;
      unsigned a0 = f2bf(v[i].x * rs * g[i].x * (1.f + sc[i].x) + sh[i].x), a1 = f2bf(v[i].y * rs * g[i].y * (1.f + sc[i].y) + sh[i].y);
      unsigned a2 = f2bf(v[i].z * rs * g[i].z * (1.f + sc[i].z) + sh[i].z), a3 = f2bf(v[i].w * rs * g[i].w * (1.f + sc[i].w) + sh[i].w);
      uint2 o = make_uint2(a0 | (a1 << 16), a2 | (a3 << 16));
      *(uint2*)(hn + (size_t)r * D + c0) = o;
    }
  }
}
__device__ void phase_final(const P& p) {
  OPQ_IDS
  int lane = TIDX & 63, gw = BIDX * 8 + (TIDX >> 6), nw = gridDim.x * 8;
  float4 g[8];
#pragma unroll
  for (int i = 0; i < 8; ++i) g[i] = *(const float4*)(p.g_final + i * 256 + lane * 4);
  for (int r = gw; r < NBATCH * SEQ; r += nw) {
    float* xr = p.out + (size_t)r * D;
    float4 v[8];
    float ss = 0.f;
#pragma unroll
    for (int i = 0; i < 8; ++i) {
      v[i] = *(const float4*)(xr + i * 256 + lane * 4);
      ss += v[i].x * v[i].x + v[i].y * v[i].y + v[i].z * v[i].z + v[i].w * v[i].w;
    }
    ss = wave_sum(ss);
    float rs = rsqrtf(ss * (1.f / D) + EPS);
#pragma unroll
    for (int i = 0; i < 8; ++i) {
      int c0 = i * 256 + lane * 4;
      *(float4*)(xr + c0) = make_float4(v[i].x * rs * g[i].x, v[i].y * rs * g[i].y, v[i].z * rs * g[i].z, v[i].w * rs * g[i].w);
    }
  }
}

__device__ void phase_p2(const P& p, int l) {
  OPQ_IDS
  int lane = TIDX & 63, gw = xcd_remap(BIDX, BIDX, gridDim.x) * 8 + (TIDX >> 6), nw = gridDim.x * 8;
  char* ws = opqp(p.ws);
  const u16* proj = (const u16*)(ws + O_PROJ);
  float* rinv = (float*)(ws + O_RINV);
  const float2* rt = (const float2*)(ws + O_ROPE);
  float cw[2][4][8];
#pragma unroll
  for (int part = 0; part < 2; ++part)
#pragma unroll
    for (int j = 0; j < 4; ++j) {
      const float* cp = p.conv_w + ((size_t)l * 4 + j) * 1024 + part * 512 + lane * 8;
      f32x4 c0 = *(const f32x4*)cp, c1 = *(const f32x4*)(cp + 4);
#pragma unroll
      for (int i = 0; i < 4; ++i) { cw[part][j][i] = c0[i]; cw[part][j][4 + i] = c1[i]; }
    }
  const float bif = (lane < 16) ? p.b_if[l * 16 + lane] : 0.f;
  const bf16x8 z8 = {0, 0, 0, 0, 0, 0, 0, 0};
  for (int r = gw; r < NTOK; r += nw) {
    int b = r / TPB, t = r - b * TPB;
    const bool isctx = t < CTXL;
    const int pos = isctx ? t : t - CTXL;
    const int n = isctx ? CTXL : SEQ;
    const u16* pr = proj + (size_t)r * NP;
    const bf16x8 vq = *(const bf16x8*)(pr + C_CQ + lane * 8);
    const bf16x8 vkv = *(const bf16x8*)(pr + C_CKV + lane * 8);
    const u16 kro = pr[C_CKR + lane], krp = pr[C_CKR + (lane ^ 16)];
    const u16 dif = pr[C_DIF + (lane & 15)];
    const int g = lane >> 4, w = 2 << g;
    const int lo = max(pos - w / 2, 0), hi = min(pos + (w - 1 - w / 2), n - 1);
    bf16x8 wv[16];
#pragma unroll
    for (int k = 0; k < 16; ++k) {
      int u = pos + k - 8;
      wv[k] = z8;
      if (u >= lo && u <= hi) wv[k] = *(const bf16x8*)(pr + (ptrdiff_t)(k - 8) * NP + C_BI + lane * 8);
    }
    bf16x8 cv[2][4];
#pragma unroll
    for (int part = 0; part < 2; ++part)
#pragma unroll
      for (int j = 0; j < 4; ++j) {
        int u = pos + j - 2;
        cv[part][j] = z8;
        if (u >= 0 && u < n) cv[part][j] = *(const bf16x8*)(pr + (ptrdiff_t)(j - 2) * NP + C_DQ + part * 512 + lane * 8);
      }
    float sq = 0.f, skv = 0.f;
#pragma unroll
    for (int i = 0; i < 8; ++i) { float a = bfs(vq[i]), c = bfs(vkv[i]); sq += a * a; skv += c * c; }
    sq = wave_sum(sq);
    skv = wave_sum(skv);
    if (lane == 0) {
      rinv[r * 2] = rsqrtf(sq * (1.f / 512.f) + EPS);
      rinv[r * 2 + 1] = rsqrtf(skv * (1.f / 512.f) + EPS);
    }
    {
      float own = bf2f(kro);
      float o = own;
      if (!isctx) {
        float par = bf2f(krp);
        int half = lane >> 5, ii = lane & 31, j = ii & 15;
        int pp = half ? (pos & 63) : (pos >> 6);
        float2 cs = rt[pp * 16 + j];
        o = (ii < 16) ? own * cs.x - par * cs.y : own * cs.x + par * cs.y;
      }
      u16 ob = f2bf(o);
      u16* kh = (u16*)(ws + O_KH) + ((size_t)(b * 4) * TPB + t) * 192 + 128 + lane;
#pragma unroll
      for (int h = 0; h < 4; ++h) kh[(size_t)h * TPB * 192] = ob;
    }
    {
      float s[8] = {0, 0, 0, 0, 0, 0, 0, 0};
#pragma unroll
      for (int k = 0; k < 16; ++k)
#pragma unroll
        for (int i = 0; i < 8; ++i) s[i] += bfs(wv[k][i]);
      float ic = 1.f / (float)(hi - lo + 1);
#pragma unroll
      for (int i = 0; i < 8; ++i) s[i] = s[i] * ic - bfs(wv[8][i]);
      st8((u16*)(ws + O_DPOOL) + (size_t)r * 512 + lane * 8, s);
    }
#pragma unroll
    for (int part = 0; part < 2; ++part) {
      float a[8] = {0, 0, 0, 0, 0, 0, 0, 0};
#pragma unroll
      for (int j = 0; j < 4; ++j)
#pragma unroll
        for (int i = 0; i < 8; ++i) a[i] += bfs(cv[part][j][i]) * cw[part][j][i];
      const float ksc = part ? 0.08838834764831845f : 1.f;
#pragma unroll
      for (int i = 0; i < 8; ++i) a[i] = silu_f(a[i]) * ksc;
      st8((u16*)(ws + O_QKC) + (size_t)r * 1024 + part * 512 + lane * 8, a);
    }
    if (lane < 16) {
      float gg = bf2f(dif) + bif;
      if (lane & 4) gg = fminf(gg, 0.f) - __logf(1.f + __expf(-fabsf(gg)));
      ((float*)(ws + O_GL))[(size_t)r * 16 + lane] = gg;
    }
  }
}

struct AttnTile {
  const u16* kp;
  const u16* vp;
  int isctx;
  int kr;
};

template <int DQK, int QT, bool NA>
__device__ void attn_block(const P& p, int layer, int b, int h, int qrow0  , bool q_is_latent,
                           int ntile, int na_r0  , const u16* Kbase, int ldk,
                           const u16* Vtbase  , const u16* Qbase, int ldq, int gatecol,
                           int ycol, float scale) {
  OPQ_IDS
  constexpr int KS = DQK / 32;
  constexpr int KSTR = DQK + 8;
  const float scale2 = scale * 1.4426950408889634f;
  constexpr int KCH = 64 * DQK / 8 / NTHR;
  u16* Ks = (u16*)shm;
  u16* Vs = Ks + 64 * KSTR;
  float* rpb = (float*)(Vs + 128 * 72);
  const int wid = TIDX >> 6, lane = TIDX & 63, l15 = lane & 15, quad = lane >> 4;
  char* ws = opqp(p.ws);
  const float2* rt = (const float2*)(ws + O_ROPE);

  __syncthreads();
  if (NA) {
    for (int i = TIDX; i < 465; i += NTHR) rpb[i] = p.na_rpb[((size_t)layer * 4 + h) * 465 + i];
  }
  bf16x8 qf[QT][KS];
#pragma unroll
  for (int qt = 0; qt < QT; ++qt) {
    int ql = wid * 16 * QT + qt * 16 + l15;
    const u16* qp = Qbase + (size_t)(qrow0 + ql) * ldq;
#pragma unroll
    for (int ks = 0; ks < KS; ++ks) qf[qt][ks] = *(const bf16x8*)(qp + ks * 32 + quad * 8);
  }
  f32x4 o[8][QT];
  float mrun[QT], lrun[QT];
#pragma unroll
  for (int qt = 0; qt < QT; ++qt) {
    mrun[qt] = -1e30f;
    lrun[qt] = 0.f;
#pragma unroll
    for (int dt = 0; dt < 8; ++dt) o[dt][qt] = f32x4{0.f, 0.f, 0.f, 0.f};
  }
  int na_rq = 0, na_cq = 0, na_cs = 0, na_rs = 0;
  if (NA) {
    na_rq = na_r0 + (wid >> 2);
    na_cq = (wid & 3) * 16 + l15;
    na_cs = min(max(na_cq - 8, 0), 48);
    na_rs = min(max(na_rq - 4, 0), 56);
  }
  const int na_rlo = NA ? min(max(na_r0 - 4, 0), 56) : 0;

  bf16x8 kreg[KCH], vreg[2];
  auto tile_ptrs = [&](int ti, const u16*& kp, const u16*& vp, int& isctx, int& kr) {
    int tok0;
    if (ti < 4) {
      tok0 = ti * 64;
      isctx = 1;
      kr = -1;
    } else {
      isctx = 0;
      kr = NA ? (na_rlo + ti - 4) : (ti - 4);
      tok0 = CTXL + kr * 64;
    }
    kp = Kbase + (size_t)tok0 * ldk;
    vp = Vtbase + tok0;
  };
  auto gloadK = [&](int ti) {
    const u16 *kp, *vp;
    int ic, kr;
    tile_ptrs(ti, kp, vp, ic, kr);
#pragma unroll
    for (int i = 0; i < KCH; ++i) {
      int c = TIDX + i * NTHR, key = c / (DQK / 8), part = c % (DQK / 8);
      kreg[i] = *(const bf16x8*)(kp + (size_t)key * ldk + part * 8);
    }
  };
  auto gloadV = [&](int ti) {
    const u16 *kp, *vp;
    int ic, kr;
    tile_ptrs(ti, kp, vp, ic, kr);
#pragma unroll
    for (int i = 0; i < 2; ++i) {
      int c = TIDX + i * NTHR, dv = c >> 3, part = c & 7;
      vreg[i] = *(const bf16x8*)(vp + (size_t)dv * TPB + part * 8);
    }
  };
  auto sstoreK = [&]() {
#pragma unroll
    for (int i = 0; i < KCH; ++i) {
      int c = TIDX + i * NTHR, key = c / (DQK / 8), part = c % (DQK / 8);
      *(bf16x8*)(Ks + key * KSTR + part * 8) = kreg[i];
    }
  };
  auto sstoreV = [&]() {
#pragma unroll
    for (int i = 0; i < 2; ++i) {
      int c = TIDX + i * NTHR, dv = c >> 3, part = c & 7;
      *(bf16x8*)(Vs + dv * 72 + part * 8) = vreg[i];
    }
  };

  gloadK(0);
  gloadV(0);
  __syncthreads();
  sstoreK();
  sstoreV();
  if (ntile > 1) { gloadK(1); gloadV(1); }
  LDS_BAR();
  auto tile_iter = [&](int ti) {
    const int isctx = ti < 4;
    int kr = NA ? (na_rlo + ti - 4) : 0;
    bool active = true;
    if (NA && !isctx) active = (kr >= na_rs) && (kr < na_rs + 8);
    f32x4 s[4][QT];
    if (active) {
#pragma unroll
      for (int kt = 0; kt < 4; ++kt)
#pragma unroll
        for (int qt = 0; qt < QT; ++qt) s[kt][qt] = f32x4{0.f, 0.f, 0.f, 0.f};
#pragma unroll
      for (int ks = 0; ks < KS; ++ks) {
        bf16x8 a[4];
#pragma unroll
        for (int kt = 0; kt < 4; ++kt) a[kt] = *(const bf16x8*)(Ks + (kt * 16 + l15) * KSTR + ks * 32 + quad * 8);
#pragma unroll
        for (int qt = 0; qt < QT; ++qt) {
          bf16x8 q = qf[qt][ks];
#pragma unroll
          for (int kt = 0; kt < 4; ++kt) s[kt][qt] = __builtin_amdgcn_mfma_f32_16x16x32_bf16(a[kt], q, s[kt][qt], 0, 0, 0);
        }
      }
    }
    LDS_BAR();
    if (ti + 1 < ntile) sstoreK();
    if (ti + 2 < ntile) gloadK(ti + 2);
    if (active) {
      bf16x8 pf[QT][2];
#pragma unroll
      for (int qt = 0; qt < QT; ++qt) {
        float mx = -1e30f;
#pragma unroll
        for (int kt = 0; kt < 4; ++kt)
#pragma unroll
          for (int j = 0; j < 4; ++j) {
            float v = s[kt][qt][j] * scale2;
            if (NA && !isctx) {
              int ck = kt * 16 + quad * 4 + j;
              bool valid = (ck >= na_cs) && (ck < na_cs + 16);
              int bidx = (kr - na_rq + 7) * 31 + min(max(ck - na_cq + 15, 0), 30);
              v = valid ? v + rpb[bidx] * 1.4426950408889634f : -1e30f;
            }
            s[kt][qt][j] = v;
            mx = fmaxf(mx, v);
          }
        mx = fmaxf(mx, SHX(mx, 16));
        mx = fmaxf(mx, SHX(mx, 32));
        float mnew = fmaxf(mrun[qt], mx);
        float alpha = __builtin_amdgcn_exp2f(mrun[qt] - mnew);
        mrun[qt] = mnew;
        float ls = 0.f;
#pragma unroll
        for (int kt = 0; kt < 4; ++kt)
#pragma unroll
          for (int j = 0; j < 4; ++j) {
            float pv = __builtin_amdgcn_exp2f(s[kt][qt][j] - mnew);
            ls += pv;
            s[kt][qt][j] = pv;
          }
        lrun[qt] = lrun[qt] * alpha + ls;
        if (__builtin_amdgcn_ballot_w64(alpha != 1.f)) {
#pragma unroll
          for (int dt = 0; dt < 8; ++dt)
#pragma unroll
            for (int j = 0; j < 4; ++j) o[dt][qt][j] *= alpha;
        }
#pragma unroll
        for (int kk = 0; kk < 2; ++kk) {
          union { bf16x8 v; unsigned u[4]; } cv;
          cv.u[0] = pk2(s[2 * kk][qt][0], s[2 * kk][qt][1]);
          cv.u[1] = pk2(s[2 * kk][qt][2], s[2 * kk][qt][3]);
          cv.u[2] = pk2(s[2 * kk + 1][qt][0], s[2 * kk + 1][qt][1]);
          cv.u[3] = pk2(s[2 * kk + 1][qt][2], s[2 * kk + 1][qt][3]);
          pf[qt][kk] = cv.v;
        }
      }
      {
        const u16* vb0 = Vs + l15 * 72 + quad * 4;
        bf16x4 n0 = *(const bf16x4*)vb0, n1 = *(const bf16x4*)(vb0 + 16);
#pragma unroll
        for (int idx = 0; idx < 16; ++idx) {
          const int kk = idx >> 3, dt = idx & 7;
          bf16x8 va = {n0[0], n0[1], n0[2], n0[3], n1[0], n1[1], n1[2], n1[3]};
          if (idx + 1 < 16) {
            const int kk2 = (idx + 1) >> 3, dt2 = (idx + 1) & 7;
            const u16* vb = Vs + (dt2 * 16 + l15) * 72 + kk2 * 32 + quad * 4;
            n0 = *(const bf16x4*)vb;
            n1 = *(const bf16x4*)(vb + 16);
          }
#pragma unroll
          for (int qt = 0; qt < QT; ++qt) o[dt][qt] = __builtin_amdgcn_mfma_f32_16x16x32_bf16(va, pf[qt][kk], o[dt][qt], 0, 0, 0);
        }
      }
    }
    LDS_BAR();
    if (ti + 1 < ntile) sstoreV();
    if (ti + 2 < ntile) gloadV(ti + 2);
  };
  for (int ti = 0; ti < 4; ++ti) tile_iter(ti);
  if (ntile > 4) {
    if (!NA && DQK == 192) {
#pragma unroll
      for (int qt = 0; qt < QT; ++qt) {
        const int ql = wid * 16 * QT + qt * 16 + l15;
        const u16* qp = Qbase + (size_t)(qrow0 + ql) * ldq;
        const int tq = (qrow0 + ql) % TPB - CTXL;
#pragma unroll
        for (int hf = 0; hf < 2; ++hf) {
          bf16x8 own = qf[qt][KS - 2 + hf];
          bf16x8 par = *(const bf16x8*)(qp + 128 + hf * 32 + (quad ^ 2) * 8);
          int pp = hf ? (tq & 63) : (tq >> 6);
          bf16x8 ro;
#pragma unroll
          for (int e = 0; e < 8; ++e) {
            float2 cs = rt[pp * 16 + (quad & 1) * 8 + e];
            float ov = bfs(own[e]), pv = bfs(par[e]);
            float r = (quad < 2) ? ov * cs.x - pv * cs.y : ov * cs.x + pv * cs.y;
            ro[e] = (short)f2bf(r);
          }
          qf[qt][KS - 2 + hf] = ro;
        }
      }
    }
    for (int ti = 4; ti < ntile; ++ti) tile_iter(ti);
  }
  const u16* proj = (const u16*)(ws + O_PROJ);
  u16* ys = (u16*)(ws + O_YS);
#pragma unroll
  for (int qt = 0; qt < QT; ++qt) {
    float lt = lrun[qt];
    lt += SHX(lt, 16);
    lt += SHX(lt, 32);
    float il = 1.f / lt;
    int r = qrow0 + wid * 16 * QT + qt * 16 + l15;
#pragma unroll
    for (int dt = 0; dt < 8; ++dt) {
      int dv = dt * 16 + quad * 4;
      bf16x4 g = *(const bf16x4*)(proj + (size_t)r * NP + gatecol + h * 128 + dv);
      bf16x4 ov;
#pragma unroll
      for (int j = 0; j < 4; ++j) {
        float y = bf2f(f2bf(o[dt][qt][j] * il));
        ov[j] = (short)f2bf(y * silu_f(bfs(g[j])));
      }
      *(bf16x4*)(ys + (size_t)r * 2048 + ycol + h * 128 + dv) = ov;
    }
  }
}

__device__ void phase_attn(const P& p, int l) {
  OPQ_IDS
  char* ws = opqp(p.ws);
  const bool need_ctx = l < 3;
  const int n_mla_lat = 256, n_na_lat = 512;
  const int n_mla_ctx = need_ctx ? 16 : 0, n_na_ctx = need_ctx ? 32 : 0;
  const int total = n_mla_lat + n_na_lat + n_mla_ctx + n_na_ctx;
  const u16* proj = (const u16*)(ws + O_PROJ);
  for (int it0 = BIDX; it0 < (total + 255) / 256 * 256; it0 += gridDim.x) {
    const int it = xcd_remap(it0, BIDX, gridDim.x);
    if (it >= total) continue;
    int i = it;
    if (i < n_mla_lat) {
      int bh = i >> 4, qb = i & 15, b = bh >> 2, h = bh & 3;
      attn_block<192, 2, false>(p, l, b, h, b * TPB + CTXL + qb * 256, true, 68, 0,
                                (const u16*)(ws + O_KH) + (size_t)bh * TPB * 192, 192,
                                (const u16*)(ws + O_VTC) + (size_t)bh * 128 * TPB,
                                (const u16*)(ws + O_QH) + h * 192, 768, C_CG, 1024, 0.07216878364870322f);
      continue;
    }
    i -= n_mla_lat;
    if (i < n_na_lat) {
      int bh = i >> 5, rp = i & 31, b = bh >> 2, h = bh & 3;
      int r0 = rp * 2;
      int rlo = min(max(r0 - 4, 0), 56), rhi = min(max(r0 + 1 - 4, 0), 56) + 7;
      attn_block<128, 1, true>(p, l, b, h, b * TPB + CTXL + r0 * 64, true, 4 + (rhi - rlo + 1), r0,
                               proj + (size_t)b * TPB * NP + C_AK + h * 128, NP,
                               (const u16*)(ws + O_VTA) + (size_t)bh * 128 * TPB, proj + C_AQ + h * 128, NP, C_AG, 0,
                               0.08838834764831845f);
      continue;
    }
    i -= n_na_lat;
    if (i < n_mla_ctx) {
      int bh = i, b = bh >> 2, h = bh & 3;
      attn_block<192, 2, false>(p, l, b, h, b * TPB, false, 4, 0, (const u16*)(ws + O_KH) + (size_t)bh * TPB * 192, 192,
                                (const u16*)(ws + O_VTC) + (size_t)bh * 128 * TPB, (const u16*)(ws + O_QH) + h * 192,
                                768, C_CG, 1024, 0.07216878364870322f);
      continue;
    }
    i -= n_mla_ctx;
    {
      int bh = i >> 1, half = i & 1, b = bh >> 2, h = bh & 3;
      attn_block<128, 1, false>(p, l, b, h, b * TPB + half * 128, false, 4, 0,
                                proj + (size_t)b * TPB * NP + C_AK + h * 128, NP,
                                (const u16*)(ws + O_VTA) + (size_t)bh * 128 * TPB, proj + C_AQ + h * 128, NP, C_AG, 0,
                                0.08838834764831845f);
    }
  }
}

DEVI int chunk_index(int dir, int blk) {
  if (dir == 0) return blk;
  return blk < 4 ? 3 - blk : 4 + 63 - (blk - 4);
}
__device__ void mlstm_gates(const P& p, int b, int h, int blk, float* gs) {
  OPQ_IDS
  const float* gl = (const float*)(opqp(p.ws) + O_GL);
  int R0 = b * TPB + blk * 64;
  if (TIDX < 128) {
    const int dir = TIDX >> 6, L = LANE, t = dir ? 63 - L : L;
    const float li = gl[(size_t)(R0 + t) * 16 + dir * 8 + h];
    const float lf = gl[(size_t)(R0 + t) * 16 + dir * 8 + 4 + h];
    float bc = lf;
#pragma unroll
    for (int o = 1; o < 64; o <<= 1) {
      float n = __int_as_float(__builtin_amdgcn_ds_bpermute(((L - o) & 63) << 2, __float_as_int(bc)));
      if (L >= o) bc += n;
    }
    float pm = li - bc;
#pragma unroll
    for (int o = 1; o < 64; o <<= 1) {
      float n = __int_as_float(__builtin_amdgcn_ds_bpermute(((L - o) & 63) << 2, __float_as_int(pm)));
      if (L >= o) pm = fmaxf(pm, n);
    }
    gs[dir * 64 + t] = li;
    gs[128 + dir * 64 + t] = lf;
    gs[256 + dir * 64 + t] = bc;
    gs[384 + dir * 64 + t] = pm;
    if (L == 63) {
      gs[512 + dir * 4] = bc;
      gs[512 + dir * 4 + 1] = bc + pm;
    }
  }
  __syncthreads();
}

__device__ void phase_m1(const P& p) {
  OPQ_IDS
  char* ws = opqp(p.ws);
  u16* kwT = (u16*)shm;
  u16* vT = kwT + 2 * 128 * 72;
  float* gs = (float*)(vT + 128 * 72);
  const u16* qkc = (const u16*)(ws + O_QKC);
  const u16* proj = (const u16*)(ws + O_PROJ);
  const int wid = TIDX >> 6, lane = TIDX & 63, l15 = lane & 15, quad = lane >> 4;
  for (int it = BIDX; it < 16 * 68; it += gridDim.x) {
    int bh = it / 68, blk = it % 68, b = bh >> 2, h = bh & 3;
    int R0 = b * TPB + blk * 64;
    __syncthreads();
    mlstm_gates(p, b, h, blk, gs);
#pragma unroll
    for (int i = 0; i < 2; ++i) {
      int c = TIDX + i * NTHR, s = c & 63, part = c >> 6;
      float kf[8];
      ld8(qkc + (size_t)(R0 + s) * 1024 + 512 + h * 128 + part * 8, kf);
      bf16x8 vv = *(const bf16x8*)(proj + (size_t)(R0 + s) * NP + C_DV + h * 128 + part * 8);
#pragma unroll
      for (int dir = 0; dir < 2; ++dir) {
        float bl = gs[512 + dir * 4], ml = gs[512 + dir * 4 + 1];
        float w = __expf(bl - gs[256 + dir * 64 + s] + gs[dir * 64 + s] - ml);
#pragma unroll
        for (int e = 0; e < 8; ++e) kwT[(dir * 128 + part * 8 + e) * 72 + s] = f2bf(kf[e] * w);
      }
#pragma unroll
      for (int e = 0; e < 8; ++e) vT[(part * 8 + e) * 72 + s] = (u16)vv[e];
    }
    __syncthreads();
    int dir = wid >> 2;
    int item = (bh * 2 + dir) * 68 + chunk_index(dir, blk);
    f32x4 acc[2][8];
#pragma unroll
    for (int a = 0; a < 2; ++a)
#pragma unroll
      for (int e = 0; e < 8; ++e) acc[a][e] = f32x4{0.f, 0.f, 0.f, 0.f};
#pragma unroll
    for (int kk = 0; kk < 2; ++kk) {
      bf16x8 af[2];
#pragma unroll
      for (int a = 0; a < 2; ++a) {
        const u16* ab = kwT + (dir * 128 + ((wid & 3) * 2 + a) * 16 + l15) * 72 + kk * 32 + quad * 4;
        bf16x4 v0 = *(const bf16x4*)ab, v1 = *(const bf16x4*)(ab + 16);
        af[a] = bf16x8{v0[0], v0[1], v0[2], v0[3], v1[0], v1[1], v1[2], v1[3]};
      }
#pragma unroll
      for (int e = 0; e < 8; ++e) {
        const u16* bb = vT + (e * 16 + l15) * 72 + kk * 32 + quad * 4;
        bf16x4 v0 = *(const bf16x4*)bb, v1 = *(const bf16x4*)(bb + 16);
        bf16x8 bf = bf16x8{v0[0], v0[1], v0[2], v0[3], v1[0], v1[1], v1[2], v1[3]};
#pragma unroll
        for (int a = 0; a < 2; ++a) acc[a][e] = __builtin_amdgcn_mfma_f32_16x16x32_bf16(af[a], bf, acc[a][e], 0, 0, 0);
      }
    }
    float* kl = (float*)(ws + O_KLOC) + (size_t)item * 16384;
#pragma unroll
    for (int a = 0; a < 2; ++a)
#pragma unroll
      for (int e = 0; e < 8; ++e) {
        int d0 = ((wid & 3) * 2 + a) * 16 + quad * 4, ee = e * 16 + l15;
        *(f32x4*)(kl + ee * 128 + d0) = acc[a][e];
      }
    if (TIDX < 256) {
      int dr = TIDX >> 7, d = TIDX & 127;
      float s = 0.f;
      for (int u = 0; u < 64; ++u) s += bf2f(kwT[(dr * 128 + d) * 72 + u]);
      int itm = (bh * 2 + dr) * 68 + chunk_index(dr, blk);
      ((float*)(ws + O_NLOC))[(size_t)itm * 128 + d] = s;
      if (d < 2) ((float*)(ws + O_SC))[itm * 2 + d] = gs[512 + dr * 4 + d];
    }
  }
}

__device__ void phase_m2(const P& p) {
  OPQ_IDS
  char* ws = opqp(p.ws);
  const float* kloc = (const float*)(ws + O_KLOC);
  const float* nloc = (const float*)(ws + O_NLOC);
  const float* sc = (const float*)(ws + O_SC);
  u16* cin = (u16*)(ws + O_CIN);
  float* nin = (float*)(ws + O_NIN);
  float* minp = (float*)(ws + O_MIN);
  const int per = 4096 + 32;
  for (int idx = BIDX * NTHR + TIDX; idx < 32 * per; idx += gridDim.x * NTHR) {
    int seq = idx / per, q4 = idx % per;
    f32x4 C = {0.f, 0.f, 0.f, 0.f};
    float m = 0.f;
    const bool isn = q4 >= 4096;
    f32x4 kvA[4], kvB[4];
    float blA[4], mlA[4], blB[4], mlB[4];
#define M2_LOAD(KV, BL, ML, j0_)                                                              \
  _Pragma("unroll") for (int u = 0; u < 4; ++u) {                                             \
    const int item = seq * 68 + (j0_) + u;                                                    \
    KV[u] = isn ? *(const f32x4*)(nloc + (size_t)item * 128 + (q4 - 4096) * 4)                \
                : *(const f32x4*)(kloc + (size_t)item * 16384 + q4 * 4);                      \
    BL[u] = sc[item * 2];                                                                     \
    ML[u] = sc[item * 2 + 1];                                                                 \
  }
#define M2_PROC(KV, BL, ML, j0_)                                                              \
  _Pragma("unroll") for (int u = 0; u < 4; ++u) {                                             \
    const int item = seq * 68 + (j0_) + u;                                                    \
    if (isn) {                                                                                \
      *(f32x4*)(nin + (size_t)item * 128 + (q4 - 4096) * 4) = C;                              \
      if (q4 == 4096) minp[item] = m;                                                         \
    } else {                                                                                  \
      bf16x4 o;                                                                               \
      _Pragma("unroll") for (int e = 0; e < 4; ++e) o[e] = (short)f2bf(C[e]);                 \
      *(bf16x4*)(cin + (size_t)item * 16384 + q4 * 4) = o;                                    \
    }                                                                                         \
    const float mn = fmaxf(BL[u] + m, ML[u]);                                                 \
    const float dec = __expf(BL[u] + m - mn), wl = __expf(ML[u] - mn);                        \
    _Pragma("unroll") for (int e = 0; e < 4; ++e) C[e] = dec * C[e] + wl * KV[u][e];          \
    m = mn;                                                                                   \
  }
    M2_LOAD(kvA, blA, mlA, 0)
    for (int j0 = 0; j0 < 64; j0 += 8) {
      M2_LOAD(kvB, blB, mlB, j0 + 4)
      M2_PROC(kvA, blA, mlA, j0)
      M2_LOAD(kvA, blA, mlA, j0 + 8)
      M2_PROC(kvB, blB, mlB, j0 + 4)
    }
    M2_PROC(kvA, blA, mlA, 64)
#undef M2_LOAD
#undef M2_PROC
  }
}

__device__ void phase_m3(const P& p, int l) {
  OPQ_IDS
  char* ws = opqp(p.ws);
  u16* Qs = (u16*)shm;
  u16* Ks = Qs + 64 * 136;
  u16* vT = Ks + 64 * 136;
  float* gs = (float*)(vT + 128 * 72);
  float* qn = gs + 528;
  float* ninl = qn + 128;
  float* hbuf = ninl + 256;
  const u16* qkc = (const u16*)(ws + O_QKC);
  const u16* proj = (const u16*)(ws + O_PROJ);
  const int wid = TIDX >> 6, lane = TIDX & 63, l15 = lane & 15, quad = lane >> 4;
  const bool need_ctx = l < 3;
  for (int it = BIDX; it < 16 * 68; it += gridDim.x) {
    int bh = it / 68, blk = it % 68, b = bh >> 2, h = bh & 3;
    if (!need_ctx && blk < 4) continue;
    int R0 = b * TPB + blk * 64;
    int itemd[2];
    itemd[0] = (bh * 2 + 0) * 68 + chunk_index(0, blk);
    itemd[1] = (bh * 2 + 1) * 68 + chunk_index(1, blk);
    bf16x8 lq[2], lk[2], lv[2];
#pragma unroll
    for (int i = 0; i < 2; ++i) {
      int c = TIDX + i * NTHR, s = c >> 4, part = c & 15;
      lq[i] = *(const bf16x8*)(qkc + (size_t)(R0 + s) * 1024 + h * 128 + part * 8);
      lk[i] = *(const bf16x8*)(qkc + (size_t)(R0 + s) * 1024 + 512 + h * 128 + part * 8);
      int c2s = c & 63, c2p = c >> 6;
      lv[i] = *(const bf16x8*)(proj + (size_t)(R0 + c2s) * NP + C_DV + h * 128 + c2p * 8);
    }
    float lnin = 0.f;
    if (TIDX < 256) lnin = ((const float*)(ws + O_NIN))[(size_t)itemd[TIDX >> 7] * 128 + (TIDX & 127)];
    const float m_in = ((const float*)(ws + O_MIN))[itemd[wid >> 2]];
    bf16x8 ldo[2], ldg[2];
    f32x4 lgn[4];
    {
      const int tt = TIDX >> 3, ch0 = h * 128 + (TIDX & 7) * 16;
      const u16* pr = proj + (size_t)(R0 + tt) * NP;
      ldo[0] = *(const bf16x8*)(pr + C_DO + ch0);
      ldo[1] = *(const bf16x8*)(pr + C_DO + ch0 + 8);
      ldg[0] = *(const bf16x8*)(pr + C_DG + ch0);
      ldg[1] = *(const bf16x8*)(pr + C_DG + ch0 + 8);
#pragma unroll
      for (int e4 = 0; e4 < 4; ++e4) lgn[e4] = *(const f32x4*)(p.ml_gnorm + l * 512 + ch0 + e4 * 4);
    }
    __syncthreads();
    mlstm_gates(p, b, h, blk, gs);
#pragma unroll
    for (int i = 0; i < 2; ++i) {
      int c = TIDX + i * NTHR, s = c >> 4, part = c & 15;
      *(bf16x8*)(Qs + s * 136 + part * 8) = lq[i];
      *(bf16x8*)(Ks + s * 136 + part * 8) = lk[i];
      int c2s = c & 63, c2p = c >> 6;
#pragma unroll
      for (int e = 0; e < 8; ++e) vT[(c2p * 8 + e) * 72 + c2s] = (u16)lv[i][e];
    }
    if (TIDX < 256) ninl[TIDX] = lnin;
    __syncthreads();
    {
      const int dr = TIDX >> 8, t = (TIDX >> 2) & 63, pq = TIDX & 3;
      float s = 0.f;
#pragma unroll 8
      for (int d = pq * 32; d < pq * 32 + 32; ++d) s += bf2f(Qs[t * 136 + d]) * ninl[dr * 128 + d];
      s += SHX(s, 1);
      s += SHX(s, 2);
      if (pq == 0) qn[dr * 64 + t] = s;
    }
    __syncthreads();
    {
      const int dir = wid >> 2, tt = wid & 3;
      const int t = tt * 16 + l15;
      const float* li = gs + dir * 64;
      const float* bc = gs + 256 + dir * 64;
      const float bct = bc[t];
      const float mt = fmaxf(bct + m_in, bct + gs[384 + dir * 64 + t]);
      bf16x8 qf[4];
#pragma unroll
      for (int ks = 0; ks < 4; ++ks) qf[ks] = *(const bf16x8*)(Qs + t * 136 + ks * 32 + quad * 8);
      f32x4 s[4];
#pragma unroll
      for (int st = 0; st < 4; ++st) s[st] = f32x4{0.f, 0.f, 0.f, 0.f};
#pragma unroll
      for (int ks = 0; ks < 4; ++ks)
#pragma unroll
        for (int st = 0; st < 4; ++st) {
          bf16x8 a = *(const bf16x8*)(Ks + (st * 16 + l15) * 136 + ks * 32 + quad * 8);
          s[st] = __builtin_amdgcn_mfma_f32_16x16x32_bf16(a, qf[ks], s[st], 0, 0, 0);
        }
      float dsum = 0.f;
      bf16x8 pf[2];
#pragma unroll
      for (int st = 0; st < 4; ++st)
#pragma unroll
        for (int j = 0; j < 4; ++j) {
          int sp = st * 16 + quad * 4 + j;
          bool valid = dir == 0 ? (sp <= t) : (sp >= t);
          float dm = bct - bc[sp] + li[sp] - mt;
          float v = valid ? s[st][j] * __expf(dm) : 0.f;
          dsum += v;
          pf[st >> 1][(st & 1) * 4 + j] = (short)f2bf(v);
        }
      dsum += SHX(dsum, 16);
      dsum += SHX(dsum, 32);
      f32x4 hi[8], hx[8];
#pragma unroll
      for (int e = 0; e < 8; ++e) { hi[e] = f32x4{0.f, 0.f, 0.f, 0.f}; hx[e] = f32x4{0.f, 0.f, 0.f, 0.f}; }
#pragma unroll
      for (int kk = 0; kk < 2; ++kk)
#pragma unroll
        for (int e = 0; e < 8; ++e) {
          const u16* vb = vT + (e * 16 + l15) * 72 + kk * 32 + quad * 4;
          bf16x4 v0 = *(const bf16x4*)vb, v1 = *(const bf16x4*)(vb + 16);
          bf16x8 va = {v0[0], v0[1], v0[2], v0[3], v1[0], v1[1], v1[2], v1[3]};
          hi[e] = __builtin_amdgcn_mfma_f32_16x16x32_bf16(va, pf[kk], hi[e], 0, 0, 0);
        }
      const u16* cin = (const u16*)(ws + O_CIN) + (size_t)itemd[dir] * 16384;
      {
        bf16x8 cn[8];
#pragma unroll
        for (int e = 0; e < 8; ++e) cn[e] = *(const bf16x8*)(cin + (e * 16 + l15) * 128 + quad * 8);
#pragma unroll
        for (int ks = 0; ks < 4; ++ks) {
          bf16x8 ca[8];
#pragma unroll
          for (int e = 0; e < 8; ++e) ca[e] = cn[e];
          if (ks + 1 < 4) {
#pragma unroll
            for (int e = 0; e < 8; ++e) cn[e] = *(const bf16x8*)(cin + (e * 16 + l15) * 128 + (ks + 1) * 32 + quad * 8);
          }
#pragma unroll
          for (int e = 0; e < 8; ++e) hx[e] = __builtin_amdgcn_mfma_f32_16x16x32_bf16(ca[e], qf[ks], hx[e], 0, 0, 0);
        }
      }
      float a = __expf(bct + m_in - mt);
      float den = a * qn[dir * 64 + t] + dsum;
      float idn = 1.f / fmaxf(fabsf(den), __expf(-mt));
#pragma unroll
      for (int e = 0; e < 8; ++e)
#pragma unroll
        for (int j = 0; j < 4; ++j) hbuf[(dir * 64 + t) * 129 + e * 16 + quad * 4 + j] = (a * hx[e][j] + hi[e][j]) * idn;
    }
    __syncthreads();
    {
      int t = TIDX >> 3, part = TIDX & 7;
      float hv[16], ss = 0.f;
#pragma unroll
      for (int e = 0; e < 16; ++e) {
        hv[e] = hbuf[t * 129 + part * 16 + e] + hbuf[(64 + t) * 129 + part * 16 + e];
        ss += hv[e] * hv[e];
      }
      ss += SHX(ss, 1);
      ss += SHX(ss, 2);
      ss += SHX(ss, 4);
      float rs = rsqrtf(ss * (1.f / 128.f) + EPS);
      int r = R0 + t;
      const u16* pr = proj + (size_t)r * NP;
      u16* ys = (u16*)(ws + O_YS) + (size_t)r * 2048 + 1536 + h * 128 + part * 16;
      const int ch0 = h * 128 + part * 16;
      float dox[16], dgx[16], gn[16];
#pragma unroll
      for (int e = 0; e < 8; ++e) {
        dox[e] = bfs(ldo[0][e]); dox[8 + e] = bfs(ldo[1][e]);
        dgx[e] = bfs(ldg[0][e]); dgx[8 + e] = bfs(ldg[1][e]);
      }
#pragma unroll
      for (int e4 = 0; e4 < 4; ++e4)
#pragma unroll
        for (int e = 0; e < 4; ++e) gn[e4 * 4 + e] = lgn[e4][e];
      float yo[16];
#pragma unroll
      for (int e = 0; e < 16; ++e) {
        float y = hv[e] * rs * gn[e] * sigm_f(dox[e]);
        yo[e] = bf2f(f2bf(y)) * silu_f(dgx[e]);
      }
      st8(ys, yo);
      st8(ys + 8, yo + 8);
    }
  }
}

__device__ void gemm_step(const P& p, int step, int l) {
  OPQ_IDS
  char* ws = opqp(p.ws);
  const int nM = NTOK / 256;
  const bool need_ctx = l < 3;
  int ntiles;
  const int nbr = 1;
  if (step == 1) ntiles = nM * (NP / BNT);
  else if (step == 3) ntiles = nM * (2304 / BNT);
  else if (step == 6) ntiles = 4 * nM * (2048 / BNT);
  else if (step == 7) ntiles = nM * 32;
  else ntiles = nM * (2048 / BNT);
  for (int t0 = BIDX; t0 < (ntiles + 255) / 256 * 256; t0 += gridDim.x) {
    const int t = xcd_remap(t0, BIDX, gridDim.x);
    if (t >= ntiles) continue;
    for (int br = 0; br < nbr; ++br) {
      const u16 *A, *Bt;
      int lda, ldb, K, pm, pn, mode, aux = 0, bmode = 0, ncol = BNT;
      if (step == 1) {
        tile_map(t, nM, NP / BNT, pm, pn);
        A = (const u16*)(ws + O_HN); lda = 2048; Bt = (const u16*)(ws + O_WIN); ldb = 2048; K = 2048; mode = M_G1A;
      } else if (step == 3) {
        const int c2 = 768 / BNT, c3 = 1024 / BNT, c4 = 512 / BNT; const int n2 = nM * c2, n3 = nM * c3;
        K = 512; ldb = 512;
        if (t < n2) {
          pm = t / c2; pn = t % c2; A = (const u16*)(ws + O_PROJ) + C_CQ; lda = NP; Bt = (const u16*)(ws + O_WUQ); mode = M_G2;
        } else if (t < n2 + n3) {
          int tt = t - n2; pm = tt / c3; pn = tt % c3; A = (const u16*)(ws + O_PROJ) + C_CKV; lda = NP; Bt = (const u16*)(ws + O_WUKV); mode = M_G3;
        } else {
          int tt = t - n2 - n3; pm = tt / c4; pn = tt % c4; A = (const u16*)(ws + O_DPOOL); lda = 512; Bt = (const u16*)(ws + O_POOL); mode = M_POOL;
        }
      } else if (step == 6) {
        aux = t / (nM * (2048 / BNT));
        tile_map(t % (nM * (2048 / BNT)), nM, 2048 / BNT, pm, pn);
        A = (const u16*)(ws + O_YS) + aux * 512; lda = 2048; Bt = (const u16*)(ws + O_WBR) + (size_t)aux * 2048 * 512; ldb = 512; K = 512; mode = M_G4;
      } else if (step == 7) {
        tile_map(t, nM, 32, pm, pn);
        A = (const u16*)(ws + O_HN); lda = 2048;
        Bt = (l & 1) ? (const u16*)(ws + O_WINM1) : (const u16*)(ws + O_WIN) + (size_t)C_MG * 2048;
        ldb = 2048; K = 2048; mode = M_G1B; bmode = 1; ncol = 64;
      } else {
        tile_map(t, nM, 2048 / BNT, pm, pn);
        A = (const u16*)(ws + O_ACC); lda = 2048; Bt = (const u16*)(ws + O_WOUT); ldb = 2048; K = 2048; mode = M_G5;
      }
      if (step >= 6 && !need_ctx && (pm % 17) == 0) continue;
      gemm256(p, A, lda, Bt, ldb, K, pm * 256, pn * ncol, mode, aux, l, bmode);
    }
  }
}


#define XB_TMO      128
#define XB_XCNT(j)  (256  + 64 * (j))
#define XB_XSUB(j)  (1280 + 64 * (j))
#define XB_XGEN(j)  (2304 + 64 * (j))
#define XB_TOP      3328
#define XB_TOPGEN   3392
#define XCD_BAR_WORDS 3456
#define XB_SPIN_CAP (1u << 18)
#define LAS __attribute__((address_space(3)))
DEVI unsigned xb_ld(unsigned* p) { return __hip_atomic_load(p, __ATOMIC_RELAXED, __HIP_MEMORY_SCOPE_AGENT); }
DEVI unsigned xb_add(unsigned* p, unsigned v) { return __hip_atomic_fetch_add(p, v, __ATOMIC_RELAXED, __HIP_MEMORY_SCOPE_AGENT); }
DEVI unsigned xb_xcc_id() { return (unsigned)__builtin_amdgcn_s_getreg((3 << 11) | 20) & 0xFu; }
#define XB_SPIN(cond, bar) do { unsigned _sp = 0; while (cond) { __builtin_amdgcn_s_sleep(1); \
    if ((++_sp & 255u) == 0u) { if (xb_ld(&(bar)[XB_TMO])) break; if (_sp > XB_SPIN_CAP) { atomicAdd(&(bar)[XB_TMO], 1u); break; } } } } while (0)
struct XcdBarrier { unsigned* bar; unsigned x; volatile LAS unsigned* st; };
DEVI XcdBarrier xcd_barrier_post(unsigned* bar, volatile LAS unsigned* st) {
  XcdBarrier b; b.bar = bar; b.x = xb_xcc_id(); b.st = st;
  if (threadIdx.x == 0) (void)xb_add(&bar[XB_XCNT(b.x)], 1u);
  return b;
}
DEVI void xcd_barrier_complete(unsigned* bar, unsigned x, unsigned& nloc, unsigned& nx) {
  const unsigned G = gridDim.x * gridDim.y * gridDim.z;
  unsigned sum, cnt, mine, sp = 0u;
  for (;;) {
    sum = 0u; cnt = 0u; mine = 0u;
#pragma unroll
    for (unsigned j = 0; j < 16; ++j) { const unsigned c = xb_ld(&bar[XB_XCNT(j)]); sum += c; cnt += (c > 0u) ? 1u : 0u; mine = (j == x) ? c : mine; }
    if (sum == G) break;
    __builtin_amdgcn_s_sleep(1);
    if ((++sp & 255u) == 0u) { if (xb_ld(&bar[XB_TMO])) break; if (sp > XB_SPIN_CAP) { atomicAdd(&bar[XB_TMO], 1u); break; } }
  }
  nloc = mine > 0u ? mine : 1u; nx = cnt > 0u ? cnt : 1u;
}
DEVI void xcd_barrier(const XcdBarrier& b) {
  asm volatile("s_waitcnt vmcnt(0)" ::: "memory");
  __syncthreads();
  if (threadIdx.x == 0) {
    unsigned* bar = b.bar;
    __builtin_amdgcn_s_waitcnt(0);
    unsigned nloc = b.st[0], nx = b.st[1];
    if (nloc == 0u) { xcd_barrier_complete(bar, b.x, nloc, nx); b.st[0] = nloc; b.st[1] = nx; }
    const unsigned old = xb_add(&bar[XB_XSUB(b.x)], 1u);
    const unsigned gen = old / nloc;
    if (old + 1u == (gen + 1u) * nloc) {
      __builtin_amdgcn_fence(__ATOMIC_RELEASE, "agent");
      asm volatile("s_waitcnt vmcnt(0)" ::: "memory");
      const unsigned og = xb_add(&bar[XB_TOP], 1u);
      const unsigned tg = og / nx;
      if (og + 1u == (tg + 1u) * nx) xb_add(&bar[XB_TOPGEN], 1u);
      else XB_SPIN(xb_ld(&bar[XB_TOPGEN]) == tg, bar);
      __builtin_amdgcn_fence(__ATOMIC_ACQUIRE, "agent");
      xb_add(&bar[XB_XGEN(b.x)], 1u);
      asm volatile("s_waitcnt vmcnt(0)" ::: "memory");
    } else {
      XB_SPIN(xb_ld(&bar[XB_XGEN(b.x)]) == gen, bar);
      __builtin_amdgcn_fence(__ATOMIC_ACQUIRE, "agent");
      asm volatile("s_waitcnt vmcnt(0)" ::: "memory");
    }
  }
  __syncthreads();
}

__global__ void __launch_bounds__(NTHR) mega(P p) {
  cg::grid_group grid = cg::this_grid();
  __shared__ uint4 xb_words;
  unsigned* bar = (unsigned*)(p.ws + O_BAR);
  if (threadIdx.x == 0) xb_words = make_uint4(0u, 0u, 0u, 0u);
  if (blockIdx.x == 0) {
    for (int i = threadIdx.x; i < 4096; i += NTHR) bar[i] = 0u;
  }
  __syncthreads();
  if (PHM & 1) phase_mod_partial(p);
  grid.sync();
  XcdBarrier xb = xcd_barrier_post(bar, (volatile LAS unsigned*)&xb_words);
  if (PHM & 1) phase_mod_reduce(p);
  grid.sync();
  for (int ls2 = 0; ls2 < 36 * 2; ++ls2) {
    const int ls = ls2 >> 1;
    const int l = ls / 9, step = ls % 9;
    if ((ls2 & 1) && !((PROBE_DUP >> step) & 1)) continue;
    if (step == 0) { if (PHM & 4) phase_norm(p, l); }
    if (step == 2) { if (PHM & 8) phase_p2(p, l); }
    if (step == 1 || step == 3 || step >= 6) gemm_step(p, step, l);
    {
      const int bid = blockIdx.x, nb = gridDim.x;
      int wl = -1, wmode = 0, rank = bid, count = nb, mod = 1, lo = 0, width = 1, sub_lo = 0, sub_hi = 0;
      if (!(ls2 & 1)) {
        if (step == 0) { wl = l; wmode = (l == 0) ? 0 : 2; }
        else if ((step == 1 || step == 3 || step == 6) && l < 3 && nb == 256) {
          const int ntl = (step == 1) ? 68 * 29 : (step == 3) ? 68 * 9 : 4 * 68 * 8;
          const int rem = ntl - ((ntl + 255) / 256 - 1) * 256;
          const int pos = (bid & 7) * 32 + (bid >> 3);
          if (pos >= rem) {
            wl = l + 1; wmode = 3; rank = pos - rem; count = 256 - rem;
            sub_lo = (step == 1) ? 0 : (step == 3) ? 1660 : 3000;
            sub_hi = (step == 1) ? 1660 : (step == 3) ? 3000 : 4096;
          }
        }
        else if (step == 7 && l < 3) {
          wl = l + 1; wmode = (nb == 256) ? 1 : 4;
          if (nb == 256) {
            count = 128; mod = 5;
            if ((bid & 7) >= 4) { rank = (bid >> 3) * 4 + (bid & 7) - 4; lo = 4; width = 1; }
            else wl = -1;
          }
        } else if (step == 8 && l < 3 && nb == 256 && (bid & 7) != 0) {
          wl = l + 1; wmode = 1; rank = (bid >> 3) * 7 + (bid & 7) - 1; count = 224; mod = 5; lo = 0; width = 4;
        }
      }
      if (wl >= 0 && (PHM & 2)) phase_wprep(p, wl, wmode, rank, count, mod, lo, width, sub_lo, sub_hi);
    }
    if (step == 3) { if (PHM & 16) phase_m1(p); }
    if (step == 4) {
      if (PHM & 32) phase_m2(p);
      if (PHM & 64) phase_attn(p, l);
    }
    if (step == 5) { if (PHM & 128) phase_m3(p, l); }
    xcd_barrier(xb);
  }
  if (PHM & 4) phase_final(p);
}

extern "C" void kernel_launch(void* const* d_in, const int* in_sizes, int n_in, void* d_out, int out_size, void* d_ws,
                              size_t ws_size, hipStream_t stream) {
  static int grid_blocks = 0;
  if (!grid_blocks) {
    int dev = 0, cus = 0, per_cu = 0;
    hipGetDevice(&dev);
    hipDeviceGetAttribute(&cus, hipDeviceAttributeMultiprocessorCount, dev);
    hipFuncSetAttribute((const void*)mega, hipFuncAttributeMaxDynamicSharedMemorySize, SHM_BYTES);
    hipOccupancyMaxActiveBlocksPerMultiprocessor(&per_cu, mega, NTHR, SHM_BYTES);
    if (per_cu < 1) per_cu = 1;
    grid_blocks = cus * per_cu;
  }
  P p{};
  const float** pp = (const float**)&p;
  for (int i = 0; i < 21; ++i) pp[i] = (const float*)d_in[i];
  p.out = (float*)d_out;
  p.ws = (char*)d_ws;
  if (ws_size < O_TOTAL) fprintf(stderr, "workspace too small: %zu < %zu\n", ws_size, (size_t)O_TOTAL);
  void* args[] = {&p};
  hipError_t e = hipLaunchCooperativeKernel((void*)mega, dim3(grid_blocks), dim3(NTHR), args, SHM_BYTES, stream);
  if (e != hipSuccess) fprintf(stderr, "cooperative launch failed: %s (grid %d)\n", hipGetErrorString(e), grid_blocks);
}
```
